# Optimizing an MI355X kernel written in HIP

```python
import math
import jax, jax.numpy as jnp
from jax import lax
import numpy as np

D_MODEL = 1024
BATCH = 16
SEQ = 2048
DEPTH = 2
DEC_BATCH = 8
DEC_SEQ = 64
PAST_LEN = 1024

CHUNK = 64
N_MIXERS = 2
N_CONV = (DEPTH + 1) // 2
N_ATTN = DEPTH // 2
CONV_EXPAND = 2
CONV_WIDTH = CONV_EXPAND * D_MODEL
CONV_W = 3
N_HEADS = 16
HEAD_DIM = 64
ATT_WIDTH = N_HEADS * HEAD_DIM
Q_BLOCK = 128
RMS_EPS = 1e-6
FORGET_BIAS_INIT = 3.0
NEG_INF = -1e30

kernel_name = "hybrid_shortconv_fox_stream_step"


def rms_norm(x, g):
    x32 = x.astype(jnp.float32)
    y = x32 * lax.rsqrt(jnp.mean(x32 * x32, axis=-1, keepdims=True) + RMS_EPS)
    return (y * g.astype(jnp.float32)).astype(x.dtype)


def ada_norm(x, c, g, w_ada, b_ada):
    mod = jax.nn.silu(c) @ w_ada + b_ada
    shift, scale, gate = jnp.split(mod, 3, axis=-1)
    h = rms_norm(x, g) * (1.0 + scale[:, None, :]) + shift[:, None, :]
    return h, gate


def conv_mixer(h, hist, w_in, conv_k, w_out):
    bg, cg, xv, z = jnp.split(h @ w_in, 4, axis=-1)
    u = cg * xv
    T = u.shape[1]
    full = jnp.concatenate([hist, u], axis=1)
    conv = (conv_k[0] * full[:, 0:T] + conv_k[1] * full[:, 1:T + 1]
            + conv_k[2] * full[:, 2:T + 2])
    y = bg * conv * jax.nn.silu(z)
    return y @ w_out, full[:, -(CONV_W - 1):]


def attn_proj(h, w_in, b_f):
    B, T, _ = h.shape
    proj = h @ w_in
    q, k, v, z = [proj[..., i * ATT_WIDTH:(i + 1) * ATT_WIDTH] for i in range(4)]
    f_logit = proj[..., 4 * ATT_WIDTH:] + b_f
    logf = jax.nn.log_sigmoid(f_logit.astype(jnp.float32)).astype(h.dtype)
    shp = (B, T, N_HEADS, HEAD_DIM)
    return q.reshape(shp), k.reshape(shp), v.reshape(shp), z, logf


def fox_block(q, cq, qpos, k, v, ck, kpos):
    s = jnp.einsum('bqhd,bkhd->bhqk', q.astype(jnp.float32), k.astype(jnp.float32)) / math.sqrt(HEAD_DIM)
    s = s + jnp.transpose(cq, (0, 2, 1))[..., :, None] - jnp.transpose(ck, (0, 2, 1))[..., None, :]
    mask = kpos[None, :] <= qpos[:, None]
    s = jnp.where(mask[None, None], s, jnp.float32(NEG_INF))
    p = jax.nn.softmax(s, axis=-1)
    o = jnp.einsum('bhqk,bkhd->bqhd', p, v.astype(jnp.float32))
    return o.astype(v.dtype)


def fox_prompt(q, k, v, logf):
    B, S = q.shape[0], q.shape[1]
    nb = S // Q_BLOCK
    cum = jnp.cumsum(logf.astype(jnp.float32), axis=1)
    pos = jnp.arange(S)
    qs = q.reshape(B, nb, Q_BLOCK, N_HEADS, HEAD_DIM).swapaxes(0, 1)
    cqs = cum.reshape(B, nb, Q_BLOCK, N_HEADS).swapaxes(0, 1)
    ps = pos.reshape(nb, Q_BLOCK)

    def body(args):
        qb, cqb, pb = args
        return fox_block(qb, cqb, pb, k, v, cum, pos)

    o = lax.map(body, (qs, cqs, ps))
    return o.swapaxes(0, 1).reshape(B, S, N_HEADS, HEAD_DIM)


def fox_sample(q, k_new, v_new, logf_new, cache_k, cache_v, cache_logf):
    P = cache_k.shape[1]
    T = q.shape[1]
    k_all = jnp.concatenate([cache_k, k_new], axis=1)
    v_all = jnp.concatenate([cache_v, v_new], axis=1)
    cum = jnp.cumsum(jnp.concatenate([cache_logf, logf_new], axis=1).astype(jnp.float32), axis=1)
    kpos = jnp.arange(P + T)
    qpos = P + jnp.arange(T)
    return fox_block(q, cum[:, P:], qpos, k_all, v_all, cum, kpos)


def setup_inputs(seed: int = 0) -> dict:
    key = jax.random.key(seed)
    ks = jax.random.split(key, 20)
    f32 = jnp.float32
    nrm = lambda k, shp, s=1.0: (jax.random.normal(k, shp, f32) * s).astype(f32)
    D, E, A, H = D_MODEL, CONV_WIDTH, ATT_WIDTH, N_HEADS
    return {
        "x_prompt": nrm(ks[0], (BATCH, SEQ, D)),
        "x_sample": nrm(ks[1], (DEC_BATCH, DEC_SEQ, D)),
        "c_prompt": nrm(ks[2], (BATCH, D)),
        "c_sample": nrm(ks[3], (DEC_BATCH, D)),
        "state_conv": nrm(ks[4], (N_CONV, DEC_BATCH, CONV_W - 1, E)),
        "cache_k": nrm(ks[5], (N_ATTN, DEC_BATCH, PAST_LEN, H, HEAD_DIM)),
        "cache_v": nrm(ks[6], (N_ATTN, DEC_BATCH, PAST_LEN, H, HEAD_DIM)),
        "cache_logf": jax.nn.log_sigmoid(FORGET_BIAS_INIT + nrm(ks[7], (N_ATTN, DEC_BATCH, PAST_LEN, H))),
        "norm_g": 1.0 + nrm(ks[8], (DEPTH, D), 0.02),
        "ada_w": nrm(ks[9], (DEPTH, D, 3 * D), D ** -0.5),
        "ada_b": nrm(ks[10], (DEPTH, 3 * D), 0.01),
        "conv_w_in": nrm(ks[11], (N_CONV, D, 4 * E), D ** -0.5),
        "conv_k": nrm(ks[12], (N_CONV, CONV_W, E), CONV_W ** -0.5),
        "conv_w_out": nrm(ks[13], (N_CONV, E, D), E ** -0.5),
        "attn_w_in": nrm(ks[14], (N_ATTN, D, 4 * A + H), D ** -0.5),
        "attn_b_f": FORGET_BIAS_INIT + nrm(ks[15], (N_ATTN, H), 0.1),
        "attn_w_out": nrm(ks[16], (N_ATTN, A, D), A ** -0.5),
        "final_g": 1.0 + nrm(ks[17], (D,), 0.02),
    }


def reference(x_prompt, x_sample, c_prompt, c_sample, state_conv, cache_k, cache_v, cache_logf,
              norm_g, ada_w, ada_b, conv_w_in, conv_k, conv_w_out, attn_w_in, attn_b_f, attn_w_out, final_g):
    xp, xs = x_prompt, x_sample
    Bp, Bs = xp.shape[0], xs.shape[0]
    conv_p, conv_s = [], []
    kp_l, vp_l, fp_l, ks_l, vs_l, fs_l = [], [], [], [], [], []
    for i in range(DEPTH):
        j = i // N_MIXERS
        hp, gp = ada_norm(xp, c_prompt, norm_g[i], ada_w[i], ada_b[i])
        hs, gs = ada_norm(xs, c_sample, norm_g[i], ada_w[i], ada_b[i])
        if i % N_MIXERS == 0:
            zero_hist = jnp.zeros((Bp, CONV_W - 1, CONV_WIDTH), hp.dtype)
            op, hist_p = conv_mixer(hp, zero_hist, conv_w_in[j], conv_k[j], conv_w_out[j])
            os_, hist_s = conv_mixer(hs, state_conv[j].astype(hs.dtype), conv_w_in[j], conv_k[j], conv_w_out[j])
            conv_p.append(hist_p)
            conv_s.append(hist_s)
        else:
            qp, kp, vp, zp, lfp = attn_proj(hp, attn_w_in[j], attn_b_f[j])
            ap = fox_prompt(qp, kp, vp, lfp).reshape(Bp, -1, ATT_WIDTH)
            op = (ap * jax.nn.silu(zp)) @ attn_w_out[j]
            qs, ks_, vs_, zs, lfs = attn_proj(hs, attn_w_in[j], attn_b_f[j])
            as_ = fox_sample(qs, ks_, vs_, lfs, cache_k[j], cache_v[j], cache_logf[j]).reshape(Bs, -1, ATT_WIDTH)
            os_ = (as_ * jax.nn.silu(zs)) @ attn_w_out[j]
            kp_l.append(kp); vp_l.append(vp); fp_l.append(lfp)
            ks_l.append(ks_); vs_l.append(vs_); fs_l.append(lfs)
        xp = xp + gp[:, None, :] * op
        xs = xs + gs[:, None, :] * os_
    y_prompt = rms_norm(xp, final_g)
    y_sample = rms_norm(xs, final_g)
    new_conv_prompt = jnp.stack(conv_p)
    new_k_prompt = jnp.stack(kp_l)
    new_v_prompt = jnp.stack(vp_l)
    new_logf_prompt = jnp.stack(fp_l)
    new_conv_sample = jnp.stack(conv_s)
    new_k_sample = jnp.stack(ks_l)
    new_v_sample = jnp.stack(vs_l)
    new_logf_sample = jnp.stack(fs_l)
    return (y_prompt, y_sample, new_conv_prompt, new_k_prompt, new_v_prompt, new_logf_prompt,
            new_conv_sample, new_k_sample, new_v_sample, new_logf_sample)
```

```cpp
#include <hip/hip_runtime.h>
#include <hip/hip_cooperative_groups.h>
#include <hip/hip_bf16.h>
#include <cstdio>
#include <cstdint>
#include <cmath>
namespace cg = cooperative_groups;

namespace pg8 {
#define PG8_LAS __attribute__((address_space(3)))
typedef unsigned short bf16_t;
typedef short bf16x8 __attribute__((ext_vector_type(8)));
typedef float f32x4 __attribute__((ext_vector_type(4)));
typedef unsigned u32x4 __attribute__((ext_vector_type(4)));
typedef unsigned u32x2 __attribute__((ext_vector_type(2)));
constexpr int BM = 256, BK = 64, HALF = 128, HTB = HALF * BK * 2  , STAGE_BYTES = 8 * HTB, NXCD = 8, WGM = 8;

__host__ __device__ __forceinline__ int lds_byte(int r, int c) { const int st = (r >> 4) * 2 + (c >> 5), rr = r & 15, cc = c & 31, ob = rr * 64 + cc * 2; return st * 1024 + (ob ^ (((ob >> 9) & 1) << 5)); }
__host__ __device__ __forceinline__ void stage_rc(int b, int& R, int& C) { const int st = b / 1024, sb = b % 1024, swz = sb ^ (((sb >> 9) & 1) << 5); R = (st >> 1) * 16 + swz / 64; C = (st & 1) * 32 + (swz % 64) / 2; }
__host__ __device__ __forceinline__ int perm32(int rho) { const int n = rho >> 4, i = rho & 15; return 8 * (i >> 2) + 4 * n + (i & 3); }

struct Unit { int pm, pn, k0, nt, split; };
struct Gemm { const bf16_t* A; const bf16_t* Bt; int M, N, K; };

struct StaticOrder {
    int nM, nN, nwg, G, c, ntk;
    __host__ __device__ void init(int M, int N, int K, int G_, int c_) { nM = M / BM; nN = N / BM; nwg = nM * nN; G = G_; c = c_; ntk = K / BK; }
    __host__ __device__ bool next(int i, Unit& u) const {
        const long L = (long)i * G + c; if (L >= nwg) return false;
        int wgid = (int)L; { const int q = nwg / NXCD, r = nwg % NXCD, xcd = wgid % NXCD, off = wgid / NXCD; wgid = (xcd < r ? xcd * (q + 1) : r * (q + 1) + (xcd - r) * q) + off; }
        const int nig = WGM * nN, gid = wgid / nig, fm = gid * WGM, gsz = (nM - fm) < WGM ? (nM - fm) : WGM;
        u.pm = fm + ((wgid % nig) % gsz); u.pn = (wgid % nig) / gsz; u.k0 = 0; u.nt = ntk; u.split = 0; return true;
    }
};
struct ConvOrder {
    int vcu, G, nsup;
    __device__ void init(int G_, int vcu_) { G = G_; vcu = vcu_; nsup = vcu < 512 ? (512 - vcu + G - 1) / G : 0; }
    __device__ bool next(int i, Unit& u) const {
        u.k0 = 0; u.nt = 16; u.split = 0;
        if (i < 8 * nsup) { const int s = vcu + G * (i >> 3), j = i & 7, combo = s >> 5, y = s & 31; const int b = (combo >> 2) * 4 + (y >> 3); u.pn = (combo & 3) * 8 + (y & 7); u.pm = b * 8 + j; return true; }
        const int su = vcu + G * (i - 8 * nsup); if (su >= 64) return false;
        u.pm = 128 + (su >> 5); u.pn = su & 31; return true;
    }
};

constexpr int NSPLIT = 8;
struct PanelOrder {
    int vcu, G, npr, ntk;
    __device__ void init(int K, int G_, int vcu_) { G = G_; vcu = vcu_; ntk = K / BK; npr = vcu < 512 ? (512 - vcu + G - 1) / G : 0; }
    __device__ bool next(int i, Unit& u) const {
        if (i < npr) { const int L = vcu + G * i; u.pm = L >> 2; u.pn = L & 3; u.k0 = 0; u.nt = ntk; u.split = 0; return true; }
        const int s = vcu + G * (i - npr); if (s >= 8 * NSPLIT) return false;
        const int tile = s / NSPLIT, ch = s % NSPLIT; u.pm = 128 + (tile >> 2); u.pn = tile & 3; u.nt = ntk / NSPLIT; u.k0 = ch * u.nt * BK; u.split = ch + 1; return true;
    }
};

__device__ __forceinline__ unsigned cvt_pk_bf16(float lo, float hi) { unsigned r; asm volatile("v_cvt_pk_bf16_f32 %0, %1, %2" : "=v"(r) : "v"(lo), "v"(hi)); return r; }
__device__ __forceinline__ float silu_f(float z) { return z * __builtin_amdgcn_rcpf(1.0f + __builtin_amdgcn_exp2f(-1.4426950408889634f * z)); }
__device__ __forceinline__ float shfl_i(float v, int srcb) { return __builtin_bit_cast(float, __builtin_amdgcn_ds_bpermute(srcb, __builtin_bit_cast(int, v))); }

constexpr int NPROMPT_TILES = 128, PROMPT_ROWS = 32768;

struct EpiConv {
    static constexpr bool PERM = false;
    bf16_t* Y; const float* convk; const float* state; float* outp; float* outs;
    __device__ __forceinline__ void operator()(f32x4 (&acc)[2][2][4][2], const Unit& u, int wr, int wc, int fr, int fq, PG8_LAS unsigned char* xl, int ui) const {
        const int lane = threadIdx.x & 63;
        const int chl = wc * 16 + fq * 4, e0 = u.pn * 64 + chl;
        const bool samp = u.pm >= NPROMPT_TILES;
        PG8_LAS float* tail = (PG8_LAS float*)xl + (ui & 1) * 512;
        PG8_LAS float* tailp = (PG8_LAS float*)xl + ((ui & 1) ^ 1) * 512;
#pragma unroll
        for (int ai = 0; ai < 2; ++ai)
#pragma unroll
            for (int m = 0; m < 4; ++m) acc[ai][0][m][1] = acc[ai][0][m][1] * acc[ai][1][m][0];
        if (fr >= 14) {
#pragma unroll
            for (int ai = 0; ai < 2; ++ai) *(PG8_LAS f32x4*)(tail + ((2 * ai + wr) * 2 + (fr - 14)) * 64 + chl) = acc[ai][0][3][1];
        }
        asm volatile("s_waitcnt lgkmcnt(0)" ::: "memory"); __builtin_amdgcn_s_barrier(); asm volatile("" ::: "memory");
        const f32x4 k0 = *(const f32x4*)(convk + e0), k1 = *(const f32x4*)(convk + 2048 + e0), k2 = *(const f32x4*)(convk + 4096 + e0);
        const int src1 = ((lane & 48) | ((lane - 1) & 15)) << 2, src2 = ((lane & 48) | ((lane - 2) & 15)) << 2;
#pragma unroll
        for (int ai = 0; ai < 2; ++ai) {
            const int g = 2 * ai + wr;
            f32x4 p1, p2;
            if (samp) { const int bs = (u.pm - NPROMPT_TILES) * 4 + g; p2 = *(const f32x4*)(state + (size_t)(bs * 2 + 0) * 2048 + e0); p1 = *(const f32x4*)(state + (size_t)(bs * 2 + 1) * 2048 + e0); }
            else if (g == 0) { if ((u.pm & 7) == 0) { p1 = (f32x4){0.f, 0.f, 0.f, 0.f}; p2 = p1; } else { p2 = *(PG8_LAS f32x4*)(tailp + (3 * 2 + 0) * 64 + chl); p1 = *(PG8_LAS f32x4*)(tailp + (3 * 2 + 1) * 64 + chl); } }
            else { p2 = *(PG8_LAS f32x4*)(tail + ((g - 1) * 2 + 0) * 64 + chl); p1 = *(PG8_LAS f32x4*)(tail + ((g - 1) * 2 + 1) * 64 + chl); }
            f32x4 r1p = p1, r2p = (fr == 0) ? p2 : p1;
#pragma unroll
            for (int m = 0; m < 4; ++m) {
                const f32x4 uu = acc[ai][0][m][1];
                f32x4 r1, r2;
#pragma unroll
                for (int i = 0; i < 4; ++i) { r1[i] = shfl_i(uu[i], src1); r2[i] = shfl_i(uu[i], src2); }
                const f32x4 um1 = (fr >= 1) ? r1 : r1p, um2 = (fr >= 2) ? r2 : r2p;
                const f32x4 cv = k2 * uu + k1 * um1 + k0 * um2;
                const f32x4 bg = acc[ai][0][m][0], z = acc[ai][1][m][1];
                f32x4 y;
#pragma unroll
                for (int i = 0; i < 4; ++i) y[i] = bg[i] * cv[i] * silu_f(z[i]);
                const size_t row = (size_t)u.pm * BM + ai * HALF + wr * 64 + m * 16 + fr;
                u32x2 w; w.x = cvt_pk_bf16(y[0], y[1]); w.y = cvt_pk_bf16(y[2], y[3]);
                *(u32x2*)(Y + row * 2048 + e0) = w;
                r1p = r1; r2p = r2;
            }
            if (fr >= 14) {
                if (samp) { const int bs = (u.pm - NPROMPT_TILES) * 4 + g; *(f32x4*)(outs + (size_t)(bs * 2 + (fr - 14)) * 2048 + e0) = acc[ai][0][3][1]; }
                else if ((u.pm & 7) == 7 && g == 3) { *(f32x4*)(outp + (size_t)((u.pm >> 3) * 2 + (fr - 14)) * 2048 + e0) = acc[ai][0][3][1]; }
            }
        }
    }
};

struct EpiRes {
    static constexpr bool PERM = false;
    const float* xp; const float* xs; float* out; const float* gate; float* slab;
    __device__ __forceinline__ void operator()(f32x4 (&acc)[2][2][4][2], const Unit& u, int wr, int wc, int fr, int fq, PG8_LAS unsigned char*, int) const {
        const bool samp = u.pm >= NPROMPT_TILES;
        const float* xb = samp ? xs : xp;
        const int col0 = u.pn * BM + wc * 32 + 4 * fq;
        if (u.split) {
            float* sb = slab + (size_t)(u.split - 1) * 512 * 1024;
#pragma unroll
            for (int ai = 0; ai < 2; ++ai)
#pragma unroll
                for (int m = 0; m < 4; ++m) { const size_t off = ((size_t)(u.pm - NPROMPT_TILES) * BM + ai * HALF + wr * 64 + m * 16 + fr) * 1024 + col0;
#pragma unroll
                    for (int bj = 0; bj < 2; ++bj)
#pragma unroll
                        for (int n = 0; n < 2; ++n) *(f32x4*)(sb + off + bj * HALF + n * 16) = acc[ai][bj][m][n]; }
            return;
        }
#pragma unroll
        for (int ai = 0; ai < 2; ++ai) {
            const int bb = samp ? 16 + (u.pm - NPROMPT_TILES) * 4 + 2 * ai + wr : (u.pm >> 3);
            f32x4 gv[2][2];
#pragma unroll
            for (int bj = 0; bj < 2; ++bj)
#pragma unroll
                for (int n = 0; n < 2; ++n) gv[bj][n] = *(const f32x4*)(gate + (size_t)bb * 3072 + col0 + bj * HALF + n * 16);
#pragma unroll
            for (int m = 0; m < 4; ++m) {
                const size_t off = ((size_t)u.pm * BM + ai * HALF + wr * 64 + m * 16 + fr) * 1024 + col0;
#pragma unroll
                for (int bj = 0; bj < 2; ++bj)
#pragma unroll
                    for (int n = 0; n < 2; ++n) { const f32x4 xv = *(const f32x4*)(xb + off + bj * HALF + n * 16); *(f32x4*)(out + off + bj * HALF + n * 16) = xv + gv[bj][n] * acc[ai][bj][m][n]; }
                if (m & 1) asm volatile("" ::: "memory");
            }
        }
    }
};

template <int MODE> struct EpiResNorm {
    static constexpr bool PERM = true;
    const float* xin; float* out; const float* gate; float* slab; bf16_t* hb; const float* g; const float* modn; float* xbuf; unsigned* cnt; bf16_t* x1b;
    __device__ __forceinline__ void operator()(f32x4 (&acc)[2][2][4][2], const Unit& u, int wr, int wc, int fr, int fq, PG8_LAS unsigned char* xl, int) const {
        const int col0 = u.pn * BM + wc * 32 + 8 * fq;
        if (u.split) {
            float* sb = slab + (size_t)(u.split - 1) * 512 * 1024;
#pragma unroll
            for (int ai = 0; ai < 2; ++ai)
#pragma unroll
                for (int m = 0; m < 4; ++m) { const size_t off = ((size_t)(u.pm - NPROMPT_TILES) * BM + ai * HALF + wr * 64 + m * 16 + fr) * 1024 + col0;
#pragma unroll
                    for (int bj = 0; bj < 2; ++bj)
#pragma unroll
                        for (int n = 0; n < 2; ++n) *(f32x4*)(sb + off + bj * HALF + n * 4) = acc[ai][bj][m][n]; }
            return;
        }
        const int lane = threadIdx.x & 63, wid = wr * 4 + wc, bb = u.pm >> 3;
        PG8_LAS float* P = (PG8_LAS float*)(xl + 4096);
        PG8_LAS float* S = P + 1024;
        {   f32x4 gv[2][2];
#pragma unroll
            for (int bj = 0; bj < 2; ++bj)
#pragma unroll
                for (int n = 0; n < 2; ++n) gv[bj][n] = *(const f32x4*)(gate + (size_t)bb * 3072 + col0 + bj * HALF + n * 4);
#pragma unroll
            for (int ai = 0; ai < 2; ++ai)
#pragma unroll
                for (int m = 0; m < 4; ++m) { const size_t off = ((size_t)u.pm * BM + ai * HALF + wr * 64 + m * 16 + fr) * 1024 + col0; float s = 0.f;
#pragma unroll
                    for (int bj = 0; bj < 2; ++bj) { f32x4 xv[2];
                        if (MODE == 0) { xv[0] = __builtin_nontemporal_load((const f32x4*)(xin + off + bj * HALF)); xv[1] = __builtin_nontemporal_load((const f32x4*)(xin + off + bj * HALF + 4)); }
                        else { const u32x4 xw = __builtin_nontemporal_load((const u32x4*)(x1b + off + bj * HALF));
                            xv[0] = (f32x4){__builtin_bit_cast(float, xw.x << 16), __builtin_bit_cast(float, xw.x & 0xffff0000u), __builtin_bit_cast(float, xw.y << 16), __builtin_bit_cast(float, xw.y & 0xffff0000u)};
                            xv[1] = (f32x4){__builtin_bit_cast(float, xw.z << 16), __builtin_bit_cast(float, xw.z & 0xffff0000u), __builtin_bit_cast(float, xw.w << 16), __builtin_bit_cast(float, xw.w & 0xffff0000u)}; }
#pragma unroll
                        for (int n = 0; n < 2; ++n) { const f32x4 a = xv[n] + gv[bj][n] * acc[ai][bj][m][n]; acc[ai][bj][m][n] = a; s += (a[0] * a[0] + a[1] * a[1]) + (a[2] * a[2] + a[3] * a[3]); } }
                    s += __shfl_xor(s, 16); s += __shfl_xor(s, 32);
                    if (fq == 0) P[(ai * HALF + wr * 64 + m * 16 + fr) * 4 + wc] = s;
                    if (m & 1) asm volatile("" ::: "memory"); } }
        asm volatile("s_waitcnt lgkmcnt(0)" ::: "memory"); __builtin_amdgcn_s_barrier(); asm volatile("" ::: "memory");
        const int row = wid * 32 + (lane & 31);
        if (lane < 32) { const float tot = (P[row * 4 + 0] + P[row * 4 + 1]) + (P[row * 4 + 2] + P[row * 4 + 3]);
            __hip_atomic_store(xbuf + ((size_t)u.pm * BM + row) * 4 + u.pn, tot, __ATOMIC_RELAXED, __HIP_MEMORY_SCOPE_AGENT); }
        asm volatile("s_waitcnt vmcnt(0)" ::: "memory");
        if (lane == 0) __hip_atomic_fetch_add(cnt + 64 * u.pm, 1u, __ATOMIC_RELAXED, __HIP_MEMORY_SCOPE_AGENT);
        if (wid == 0) { unsigned sp = 0;
            while ((unsigned)__builtin_amdgcn_readfirstlane((int)__hip_atomic_load(cnt + 64 * u.pm, __ATOMIC_RELAXED, __HIP_MEMORY_SCOPE_AGENT)) < 32u) { __builtin_amdgcn_s_sleep(2); if (++sp > (1u << 20)) break; }
            __builtin_amdgcn_fence(__ATOMIC_ACQUIRE, "agent"); }
        asm volatile("s_waitcnt vmcnt(0) lgkmcnt(0)" ::: "memory"); __builtin_amdgcn_s_barrier(); asm volatile("" ::: "memory");
        if (lane < 32) { const float* sl = xbuf + ((size_t)u.pm * BM + row) * 4; float t = 0.f;
#pragma unroll
            for (int q = 0; q < 4; ++q) t += __hip_atomic_load(sl + q, __ATOMIC_RELAXED, __HIP_MEMORY_SCOPE_AGENT);
            S[row] = 1.0f / sqrtf(t * (1.0f / 1024.0f) + 1e-6f); }
        asm volatile("s_waitcnt lgkmcnt(0)" ::: "memory"); __builtin_amdgcn_s_barrier(); asm volatile("" ::: "memory");
#pragma unroll
        for (int bj = 0; bj < 2; ++bj) { const int col = col0 + bj * HALF;
            f32x4 gm[2], sh[2];
#pragma unroll
            for (int n = 0; n < 2; ++n) { gm[n] = *(const f32x4*)(g + col + 4 * n); sh[n] = (f32x4){0.f, 0.f, 0.f, 0.f};
                if (MODE == 0) { gm[n] = gm[n] * (*(const f32x4*)(modn + (size_t)bb * 3072 + 1024 + col + 4 * n) + 1.0f); sh[n] = *(const f32x4*)(modn + (size_t)bb * 3072 + col + 4 * n); } }
#pragma unroll
            for (int ai = 0; ai < 2; ++ai)
#pragma unroll
                for (int m = 0; m < 4; ++m) { const int r = ai * HALF + wr * 64 + m * 16 + fr; const float rs = S[r]; const size_t off = ((size_t)u.pm * BM + r) * 1024 + col; const f32x4 a0 = acc[ai][bj][m][0], a1 = acc[ai][bj][m][1];
                    if (MODE == 0) { u32x4 xw; xw.x = cvt_pk_bf16(a0[0], a0[1]); xw.y = cvt_pk_bf16(a0[2], a0[3]); xw.z = cvt_pk_bf16(a1[0], a1[1]); xw.w = cvt_pk_bf16(a1[2], a1[3]); __builtin_nontemporal_store(xw, (u32x4*)(x1b + off));
                        const f32x4 h0 = a0 * rs * gm[0] + sh[0], h1 = a1 * rs * gm[1] + sh[1]; u32x4 w; w.x = cvt_pk_bf16(h0[0], h0[1]); w.y = cvt_pk_bf16(h0[2], h0[3]); w.z = cvt_pk_bf16(h1[0], h1[1]); w.w = cvt_pk_bf16(h1[2], h1[3]); *(u32x4*)(hb + off) = w; }
                    else { __builtin_nontemporal_store(a0 * rs * gm[0], (f32x4*)(out + off)); __builtin_nontemporal_store(a1 * rs * gm[1], (f32x4*)(out + off + 4)); } } }
    }
};

struct EpiQKV {
    static constexpr bool PERM = true;
    bf16_t *Qb, *Kb, *Vb, *Zb; float *okp, *oks, *ovp, *ovs, *olp, *ols; const float* bf; float c2;
    __device__ __forceinline__ void operator()(f32x4 (&acc)[2][2][4][2], const Unit& u, int wr, int wc, int fr, int fq, PG8_LAS unsigned char*, int) const {
        const int t = u.pn >> 2; const bool samp = u.pm >= NPROMPT_TILES;
        const size_t row0 = (size_t)u.pm * BM + wr * 64 + fr;
        if (t == 4) {
            if (wc == 0 && fq < 2) {
                float* ob = samp ? ols - (size_t)PROMPT_ROWS * 16 : olp;
#pragma unroll
                for (int n = 0; n < 2; ++n) { const f32x4 bv = *(const f32x4*)(bf + 8 * fq + 4 * n);
#pragma unroll
                    for (int ai = 0; ai < 2; ++ai)
#pragma unroll
                        for (int m = 0; m < 4; ++m) { const f32x4 a = acc[ai][0][m][n] + bv; f32x4 lf;
#pragma unroll
                            for (int i = 0; i < 4; ++i) lf[i] = fminf(a[i], 0.f) - log1pf(expf(-fabsf(a[i])));
                            *(f32x4*)(ob + (row0 + ai * HALF + m * 16) * 16 + 8 * fq + 4 * n) = lf; } }
            }
            return;
        }
        const int col0 = (u.pn & 3) * BM + wc * 32 + 8 * fq;
        bf16_t* bo = t == 0 ? Qb : t == 1 ? Kb : t == 2 ? Vb : Zb;
        float* fo = t == 1 ? (samp ? oks - (size_t)PROMPT_ROWS * 1024 : okp) : (samp ? ovs - (size_t)PROMPT_ROWS * 1024 : ovp);
#pragma unroll
        for (int ai = 0; ai < 2; ++ai)
#pragma unroll
            for (int m = 0; m < 4; ++m) { const size_t off = (row0 + ai * HALF + m * 16) * 1024 + col0;
#pragma unroll
                for (int bj = 0; bj < 2; ++bj) { f32x4 v0 = acc[ai][bj][m][0], v1 = acc[ai][bj][m][1];
                    if ((t == 1 || t == 2) && samp) { __builtin_nontemporal_store(v0, (f32x4*)(fo + off + bj * HALF)); __builtin_nontemporal_store(v1, (f32x4*)(fo + off + bj * HALF + 4)); }
                    if (t == 0) { v0 = v0 * c2; v1 = v1 * c2; }
                    if (t == 3) {
#pragma unroll
                        for (int i = 0; i < 4; ++i) { v0[i] = silu_f(v0[i]); v1[i] = silu_f(v1[i]); } }
                    u32x4 w; w.x = cvt_pk_bf16(v0[0], v0[1]); w.y = cvt_pk_bf16(v0[2], v0[3]); w.z = cvt_pk_bf16(v1[0], v1[1]); w.w = cvt_pk_bf16(v1[2], v1[3]);
                    *(u32x4*)(bo + off + bj * HALF) = w; } }
    }
};
template <class Epi, class Sched, bool ALIGN_EPI = false, bool SP2 = false>
__device__ __forceinline__ void gemm_phase(PG8_LAS unsigned char* lds, PG8_LAS unsigned char* xlds, const Gemm g, const Sched& S, const Epi& E) {
    const int tid = threadIdx.x, wid = __builtin_amdgcn_readfirstlane(tid >> 6), lane = tid & 63, wr = wid >> 2, wc = wid & 3, fr = lane & 15, fq = lane >> 4;
    const int K = g.K; int nt;
    unsigned voffA[2], voffB[2];
#pragma unroll
    for (int i = 0; i < 2; ++i) { int R, C; stage_rc(tid * 16 + i * 8192, R, C); const int Rb = Epi::PERM ? ((R & ~31) + perm32(R & 31)) : R;
        voffA[i] = (unsigned)(R * K + C) * 2u; voffB[i] = (unsigned)(Rb * K + C) * 2u; }
    const size_t kstep = (size_t)(BK * 2);
    const size_t hstep = (size_t)HALF * K * 2;
    const size_t tstep = 2 * hstep;
    const unsigned ldsw = (unsigned)wid * 1024u;
    const int aoff = lds_byte(wr * 64 + fr, fq * 8), boff = lds_byte(wc * 32 + fr, fq * 8);
#define PG8_SA(b, h) (((b) * 2 + (h)) * HTB)
#define PG8_SB(b, h) ((4 + (b) * 2 + (h)) * HTB)
#define PG8_STAGE(bufoff, gbase, voff) do { _Pragma("unroll") for (int _i = 0; _i < 2; ++_i) \
        __builtin_amdgcn_global_load_lds((const unsigned*)((const char*)(gbase) + (voff)[_i]), (PG8_LAS unsigned*)(lds + (bufoff) + ldsw + _i * 8192), 16, 0, 0); } while (0)
#define PG8_LDA(dst, b, h) do { _Pragma("unroll") for (int m = 0; m < 4; ++m) _Pragma("unroll") for (int k = 0; k < 2; ++k) dst[m][k] = *(const PG8_LAS bf16x8*)(lds + PG8_SA(b, h) + aoff + m * 2048 + k * 1024); } while (0)
#define PG8_LDB(dst, b, h) do { _Pragma("unroll") for (int n = 0; n < 2; ++n) _Pragma("unroll") for (int k = 0; k < 2; ++k) dst[n][k] = *(const PG8_LAS bf16x8*)(lds + PG8_SB(b, h) + boff + n * 2048 + k * 1024); } while (0)
#define PG8_MMA(ai, bj, At, Bt) do { __builtin_amdgcn_s_setprio(1); _Pragma("unroll") for (int m = 0; m < 4; ++m) _Pragma("unroll") for (int n = 0; n < 2; ++n) _Pragma("unroll") for (int k = 0; k < 2; ++k) \
        acc[ai][bj][m][n] = __builtin_amdgcn_mfma_f32_16x16x32_bf16(Bt[n][k], At[m][k], acc[ai][bj][m][n], 0, 0, 0); __builtin_amdgcn_s_setprio(0); } while (0)
#define PG8_WAIT_V(n) asm volatile("s_waitcnt vmcnt(" #n ")" ::: "memory")
#define PG8_WAIT_L(n) asm volatile("s_waitcnt lgkmcnt(" #n ")" ::: "memory")
#define PG8_BAR __builtin_amdgcn_s_barrier()
#define PG8_SCHED __builtin_amdgcn_sched_barrier(0)
    Unit cur, nxt; int ui = 0;
    if (!S.next(0, cur)) return;
    nt = cur.nt;
    f32x4 acc[2][2][4][2];
#pragma unroll
    for (int a = 0; a < 2; ++a)
#pragma unroll
        for (int b = 0; b < 2; ++b)
#pragma unroll
            for (int m = 0; m < 4; ++m)
#pragma unroll
                for (int n = 0; n < 2; ++n) acc[a][b][m][n] = (f32x4){0.f, 0.f, 0.f, 0.f};
    bf16x8 At[4][2], B0[2][2], B1[2][2];
    const char* cA = (const char*)g.A + (size_t)cur.pm * tstep + (size_t)cur.k0 * 2; const char* cB = (const char*)g.Bt + (size_t)cur.pn * tstep + (size_t)cur.k0 * 2;
    if constexpr (SP2) {
        PG8_STAGE(PG8_SB(0, 0), cB, voffB); PG8_STAGE(PG8_SB(0, 1), cB + hstep, voffB); PG8_STAGE(PG8_SA(0, 0), cA, voffA); PG8_STAGE(PG8_SA(0, 1), cA + hstep, voffA);
        if (wr == 1) PG8_BAR;
        PG8_WAIT_V(2); PG8_BAR;
        PG8_STAGE(PG8_SB(1, 0), cB + kstep, voffB); PG8_STAGE(PG8_SA(1, 0), cA + kstep, voffA); PG8_STAGE(PG8_SB(1, 1), cB + hstep + kstep, voffB);
        PG8_WAIT_V(6); PG8_BAR;
    } else {
        PG8_STAGE(PG8_SB(0, 0), cB, voffB); PG8_STAGE(PG8_SA(0, 0), cA, voffA); PG8_STAGE(PG8_SB(0, 1), cB + hstep, voffB); PG8_STAGE(PG8_SA(0, 1), cA + hstep, voffA);
        if (wr == 1) PG8_BAR;
        PG8_WAIT_V(4); PG8_BAR;
        PG8_STAGE(PG8_SB(1, 0), cB + kstep, voffB); PG8_STAGE(PG8_SA(1, 0), cA + kstep, voffA); PG8_STAGE(PG8_SB(1, 1), cB + hstep + kstep, voffB);
        PG8_WAIT_V(6); PG8_BAR;
    }
    for (;;) {
        const bool has_next = S.next(ui + 1, nxt);
        const char* nA = has_next ? (const char*)g.A + (size_t)nxt.pm * tstep + (size_t)nxt.k0 * 2 : cA; const char* nB = has_next ? (const char*)g.Bt + (size_t)nxt.pn * tstep + (size_t)nxt.k0 * 2 : cB;
        for (int t = 0; t < nt; t += 2) {
            const bool last = (t == nt - 2);
            const char* a1 = cA + (size_t)(t + 1) * kstep;
            const char* a2 = last ? nA : cA + (size_t)(t + 2) * kstep; const char* b2 = last ? nB : cB + (size_t)(t + 2) * kstep;
            const char* a3 = a2 + kstep; const char* b3 = b2 + kstep;
            if constexpr (SP2) {
            PG8_LDB(B0, 0, 0); PG8_LDB(B1, 0, 1); PG8_SCHED; PG8_LDA(At, 0, 0); PG8_STAGE(PG8_SA(1, 1), a1 + hstep, voffA);
            PG8_WAIT_V(8); PG8_WAIT_L(0); PG8_BAR; PG8_MMA(0, 0, At, B0); PG8_MMA(0, 1, At, B1); PG8_BAR; PG8_SCHED;
            PG8_LDA(At, 0, 1); PG8_STAGE(PG8_SB(0, 0), b2, voffB); PG8_STAGE(PG8_SB(0, 1), b2 + hstep, voffB); PG8_STAGE(PG8_SA(0, 0), a2, voffA);
            PG8_WAIT_V(8); PG8_WAIT_L(0); PG8_BAR; PG8_MMA(1, 0, At, B0); PG8_MMA(1, 1, At, B1); PG8_BAR; PG8_SCHED;
            PG8_LDB(B0, 1, 0); PG8_LDB(B1, 1, 1); PG8_SCHED; PG8_LDA(At, 1, 0); PG8_STAGE(PG8_SA(0, 1), a2 + hstep, voffA);
            PG8_WAIT_V(8); PG8_WAIT_L(0); PG8_BAR; PG8_MMA(0, 0, At, B0); PG8_MMA(0, 1, At, B1); PG8_BAR; PG8_SCHED;
            PG8_LDA(At, 1, 1); PG8_STAGE(PG8_SB(1, 0), b3, voffB); PG8_STAGE(PG8_SB(1, 1), b3 + hstep, voffB); PG8_STAGE(PG8_SA(1, 0), a3, voffA);
            PG8_WAIT_V(8); PG8_WAIT_L(0); PG8_BAR; PG8_MMA(1, 0, At, B0); PG8_MMA(1, 1, At, B1); PG8_BAR; PG8_SCHED;
            } else {
            PG8_LDB(B0, 0, 0); PG8_SCHED; PG8_LDA(At, 0, 0); PG8_STAGE(PG8_SA(1, 1), a1 + hstep, voffA);
            PG8_WAIT_L(8); PG8_BAR; PG8_WAIT_L(0); PG8_MMA(0, 0, At, B0); PG8_BAR; PG8_SCHED;
            PG8_LDB(B1, 0, 1); PG8_STAGE(PG8_SB(0, 0), b2, voffB);
            PG8_BAR; PG8_WAIT_L(0); PG8_MMA(0, 1, At, B1); PG8_BAR;
            PG8_LDA(At, 0, 1); PG8_STAGE(PG8_SA(0, 0), a2, voffA);
            PG8_BAR; PG8_WAIT_L(0); PG8_MMA(1, 0, At, B0); PG8_BAR; PG8_SCHED;
            PG8_STAGE(PG8_SB(0, 1), b2 + hstep, voffB);
            PG8_WAIT_V(6); PG8_BAR; PG8_MMA(1, 1, At, B1); PG8_BAR;
            PG8_LDB(B0, 1, 0); PG8_SCHED; PG8_LDA(At, 1, 0); PG8_STAGE(PG8_SA(0, 1), a2 + hstep, voffA);
            PG8_WAIT_L(8); PG8_BAR; PG8_WAIT_L(0); PG8_MMA(0, 0, At, B0); PG8_BAR; PG8_SCHED;
            PG8_LDB(B1, 1, 1); PG8_STAGE(PG8_SB(1, 0), b3, voffB);
            PG8_BAR; PG8_WAIT_L(0); PG8_MMA(0, 1, At, B1); PG8_BAR;
            PG8_LDA(At, 1, 1); PG8_STAGE(PG8_SA(1, 0), a3, voffA);
            PG8_BAR; PG8_WAIT_L(0); PG8_MMA(1, 0, At, B0); PG8_BAR; PG8_SCHED;
            PG8_STAGE(PG8_SB(1, 1), b3 + hstep, voffB);
            PG8_WAIT_V(6); PG8_BAR; PG8_MMA(1, 1, At, B1); PG8_BAR;
            }
        }
        if constexpr (ALIGN_EPI) { if (wr == 0) PG8_BAR; }
        E(acc, cur, wr, wc, fr, fq, xlds, ui);
        if (!has_next) break;
#pragma unroll
        for (int a = 0; a < 2; ++a)
#pragma unroll
            for (int b = 0; b < 2; ++b)
#pragma unroll
                for (int m = 0; m < 4; ++m)
#pragma unroll
                    for (int n = 0; n < 2; ++n) acc[a][b][m][n] = (f32x4){0.f, 0.f, 0.f, 0.f};
        cur = nxt; cA = nA; cB = nB; ++ui; nt = cur.nt;
        if constexpr (ALIGN_EPI) { if (wr == 1) PG8_BAR; }
    }
    PG8_WAIT_V(0);
    if constexpr (!ALIGN_EPI) { if (wr == 0) PG8_BAR; }
    PG8_BAR;
#undef PG8_SA
#undef PG8_SB
#undef PG8_STAGE
#undef PG8_LDA
#undef PG8_LDB
#undef PG8_MMA
#undef PG8_WAIT_V
#undef PG8_WAIT_L
#undef PG8_BAR
#undef PG8_SCHED
}
}
constexpr int NWAVES = 8;
constexpr int DM = 1024, NB_P = 16, SEQ = 2048, NB_S = 8, TS = 64, PAST = 1024, NH = 16, HD = 64, EW = 2048;
constexpr int MP = NB_P * SEQ, MS = NB_S * TS, MT = MP + MS;
constexpr int N1 = 4 * EW, N3 = 4352;
constexpr float RMS_EPS = 1e-6f, LOG2E = 1.4426950408889634f;
constexpr size_t O_Y = 0, O_CONVP = (size_t)MT * DM, O_KP = O_CONVP + (size_t)NB_P * 2 * EW, O_VP = O_KP + (size_t)MP * DM, O_LP = O_VP + (size_t)MP * DM,
                 O_CONVS = O_LP + (size_t)MP * NH, O_KS = O_CONVS + (size_t)NB_S * 2 * EW, O_VS = O_KS + (size_t)MS * DM, O_LS = O_VS + (size_t)MS * DM, O_END = O_LS + (size_t)MS * NH;
static_assert(O_END == 102866944, "output size");
constexpr size_t MiB = 1u << 20;
constexpr size_t WS_CTL = 0, CTL_ZERO_BYTES = 1 * MiB;
constexpr size_t WS_MOD = 128 * 1024, WS_CNT = 16 * 1024;
constexpr size_t WS_W1 = 1 * MiB, WS_W2 = 17 * MiB, WS_W3 = 21 * MiB, WS_W4 = 30 * MiB;
constexpr size_t WS_H = 32 * MiB;
constexpr size_t WS_Y = 98 * MiB;
constexpr size_t WS_Q = WS_Y, WS_K = WS_Y + 65 * MiB, WS_V = 228 * MiB, WS_Z = 293 * MiB, WS_SLAB = 358 * MiB  , WS_AO = 374 * MiB  , WS_X = 439 * MiB  , WS_X1 = 440 * MiB  , WS_END = 504 * MiB;
static_assert((size_t)MT * DM * 2 == 65 * MiB && WS_W3 + (size_t)N3 * DM * 2 <= WS_W4 && WS_W4 + 2 * MiB <= WS_H, "ws map");
constexpr int RING_BYTES = 131072, XL_OFF = RING_BYTES, LDS_BYTES = 155648;
#define LAS __attribute__((address_space(3)))
typedef unsigned short bf16;
typedef unsigned v4u __attribute__((ext_vector_type(4)));
typedef unsigned v2u __attribute__((ext_vector_type(2)));
typedef float f32x4 __attribute__((ext_vector_type(4)));
typedef short bf16x8 __attribute__((ext_vector_type(8)));
#define LDS_WAIT() asm volatile("s_waitcnt lgkmcnt(0)" ::: "memory")
__device__ __forceinline__ unsigned f2bf(float f) { unsigned u = __builtin_bit_cast(unsigned, f); return (u + 0x7fffu + ((u >> 16) & 1u)) >> 16; }
__device__ __forceinline__ unsigned pk2(float lo, float hi) { return f2bf(lo) | (f2bf(hi) << 16); }
__device__ __forceinline__ float wave_sum(float v) {
#pragma unroll
    for (int o = 1; o < 64; o <<= 1) v += __shfl_xor(v, o);
    return v;
}

template <int MODE> __device__ __forceinline__ void p0_transpose_item(const float* W, int K, int N, bf16* WT, LAS float* scr, int item, int lane) {
    const int nblk = (N + 63) / 64, kb = item / nblk, nb = item % nblk, k0 = 64 * kb, n0 = 64 * nb;
    const int ks = lane >> 4, n4 = (lane & 15) * 4, ncol = min(n0 + n4, N - 4);
    f32x4 v[16];
#pragma unroll
    for (int i = 0; i < 16; ++i) v[i] = __builtin_nontemporal_load((const f32x4*)(W + (size_t)(k0 + 4 * i + ks) * N + ncol));
#pragma unroll
    for (int i = 0; i < 16; ++i) { LAS float* d = scr + (4 * i + ks) * 65 + n4; d[0] = v[i].x; d[1] = v[i].y; d[2] = v[i].z; d[3] = v[i].w; }
    LDS_WAIT(); asm volatile("" ::: "memory");
    const int c = lane & 7;
#pragma unroll
    for (int j = 0; j < 8; ++j) { const int n = (lane >> 3) + 8 * j; const LAS float* s = scr + (8 * c) * 65 + n;
        v4u o; o.x = pk2(s[0 * 65], s[1 * 65]); o.y = pk2(s[2 * 65], s[3 * 65]); o.z = pk2(s[4 * 65], s[5 * 65]); o.w = pk2(s[6 * 65], s[7 * 65]);
        int drow = n0 + n;
        if (MODE == 1) { const int g = drow >> 11, e = drow & 2047, pn = e >> 6, ch = e & 63; drow = pn * 256 + (g >> 1) * 128 + (ch >> 4) * 32 + (g & 1) * 16 + (ch & 15); }
        *(v4u*)(WT + (size_t)drow * K + k0 + 8 * c) = o; }
    LDS_WAIT(); asm volatile("" ::: "memory");
}
__device__ __forceinline__ void ada_norm_row(const float* xrow, bf16* orow, const float* g, const float* mod, int lane, const float* slab = nullptr, const float* gate = nullptr, float* xst = nullptr) {
    const f32x4* xr = (const f32x4*)xrow + lane;
    f32x4 v[4]; float s = 0.f;
#pragma unroll
    for (int j = 0; j < 4; ++j) { v[j] = xr[64 * j];
        if (slab) { f32x4 p = __builtin_nontemporal_load((const f32x4*)slab + 64 * j + lane);
#pragma unroll
            for (int q = 1; q < 8; ++q) p += __builtin_nontemporal_load((const f32x4*)(slab + (size_t)q * 512 * 1024) + 64 * j + lane);
            v[j] += ((const f32x4*)gate)[64 * j + lane] * p; ((f32x4*)xst)[64 * j + lane] = v[j]; }
        s += (v[j].x * v[j].x + v[j].y * v[j].y) + (v[j].z * v[j].z + v[j].w * v[j].w); }
    const float rstd = 1.f / sqrtf(wave_sum(s) * (1.f / DM) + RMS_EPS);
    unsigned long long* o8 = (unsigned long long*)orow + lane;
#pragma unroll
    for (int j = 0; j < 4; ++j) { const f32x4 gg = ((const f32x4*)g)[64 * j + lane], sh = ((const f32x4*)mod)[64 * j + lane], sc = ((const f32x4*)(mod + DM))[64 * j + lane];
        const f32x4 h = v[j] * rstd * gg * (sc + 1.0f) + sh;
        o8[64 * j] = (unsigned long long)pk2(h.x, h.y) | ((unsigned long long)pk2(h.z, h.w) << 32); }
}
__device__ __forceinline__ void ada_norm_rows(const float* x0, bf16* o0, int nrows, const float* g, const float* mod, int lane) {
    f32x4 gm[4], sh[4];
#pragma unroll
    for (int j = 0; j < 4; ++j) { gm[j] = ((const f32x4*)g)[64 * j + lane] * (((const f32x4*)(mod + DM))[64 * j + lane] + 1.0f); sh[j] = ((const f32x4*)mod)[64 * j + lane]; }
    f32x4 v[4], w[4];
#pragma unroll
    for (int j = 0; j < 4; ++j) v[j] = __builtin_nontemporal_load((const f32x4*)x0 + 64 * j + lane);
    for (int r = 0; r < nrows; ++r) {
        const float* xn = x0 + (size_t)(r + 1 < nrows ? r + 1 : r) * DM;
#pragma unroll
        for (int j = 0; j < 4; ++j) w[j] = __builtin_nontemporal_load((const f32x4*)xn + 64 * j + lane);
        float s = 0.f;
#pragma unroll
        for (int j = 0; j < 4; ++j) s += (v[j].x * v[j].x + v[j].y * v[j].y) + (v[j].z * v[j].z + v[j].w * v[j].w);
        const float rstd = 1.f / sqrtf(wave_sum(s) * (1.f / DM) + RMS_EPS);
        unsigned long long* o8 = (unsigned long long*)(o0 + (size_t)r * DM) + lane;
#pragma unroll
        for (int j = 0; j < 4; ++j) { const f32x4 h = v[j] * rstd * gm[j] + sh[j]; o8[64 * j] = (unsigned long long)pk2(h.x, h.y) | ((unsigned long long)pk2(h.z, h.w) << 32); v[j] = w[j]; }
    }
}
__device__ __forceinline__ void final_norm_row(float* xrow, const float* g, int lane, const float* slab = nullptr, const float* gate = nullptr) {
    f32x4* xr = (f32x4*)xrow + lane;
    f32x4 v[4]; float s = 0.f;
#pragma unroll
    for (int j = 0; j < 4; ++j) { v[j] = xr[64 * j];
        if (slab) { f32x4 p = __builtin_nontemporal_load((const f32x4*)slab + 64 * j + lane);
#pragma unroll
            for (int q = 1; q < 8; ++q) p += __builtin_nontemporal_load((const f32x4*)(slab + (size_t)q * 512 * 1024) + 64 * j + lane);
            v[j] += ((const f32x4*)gate)[64 * j + lane] * p; }
        s += (v[j].x * v[j].x + v[j].y * v[j].y) + (v[j].z * v[j].z + v[j].w * v[j].w); }
    const float rstd = 1.f / sqrtf(wave_sum(s) * (1.f / DM) + RMS_EPS);
#pragma unroll
    for (int j = 0; j < 4; ++j) xr[64 * j] = v[j] * rstd * ((const f32x4*)g)[64 * j + lane];
}
__device__ __forceinline__ void block_scan4(f32x4 v, float* dst, LAS float* wtot, int tid, int nthr) {
    const int lane = tid & 63, wave = tid >> 6;
    v.y += v.x; v.z += v.y; v.w += v.z;
    float incl = v.w;
#pragma unroll
    for (int o = 1; o < 64; o <<= 1) { const float t = __builtin_bit_cast(float, __builtin_amdgcn_ds_bpermute((lane - o) << 2, __builtin_bit_cast(int, incl))); if (lane >= o) incl += t; }
    if (lane == 63) wtot[wave] = incl;
    LDS_WAIT(); __builtin_amdgcn_s_barrier(); asm volatile("" ::: "memory");
    float base = incl - v.w;
    for (int w = 0; w < wave; ++w) base += wtot[w];
    if (tid < nthr) *(f32x4*)(dst + 4 * tid) = (v + base) * (-LOG2E);
    LDS_WAIT(); __builtin_amdgcn_s_barrier(); asm volatile("" ::: "memory");
}
namespace attn_body {
using bf16=__hip_bfloat16;
using bf16x8=__attribute__((ext_vector_type(8)))short;
using s16x4=__attribute__((ext_vector_type(4)))short;
using f32x16=__attribute__((ext_vector_type(16)))float;
using u32x4=__attribute__((ext_vector_type(4)))unsigned;
using f32x4=__attribute__((ext_vector_type(4)))float;
constexpr int BATCH=16,NHEAD=16,SEQ=2048,D=64,DM=NHEAD*D;
constexpr int NW=8,QBLK=32,QB=QBLK*NW,KVBLK=64,NQB=SEQ/QB;
constexpr int ATTN_PITCH=DM, ATTN_UNIT_ROWS=QB;
__device__ __forceinline__ int crow(int r,int hi){return (r&3)+8*(r>>2)+4*hi;}
#define SBAR() __builtin_amdgcn_sched_barrier(0)
__device__ __forceinline__ void cmask(f32x16&p0,f32x16&p1,int jb,int qrel,int hi){
  const float NEG=-INFINITY; int kb=64*jb+4*hi;
  #pragma unroll
  for(int r=0;r<16;++r){int kv=kb+(r&3)+8*(r>>2); if(kv>qrel)p0[r]=NEG; if(kv+32>qrel)p1[r]=NEG;}
}

constexpr int NSLOT=3, SLOTB=8192;
constexpr int LDS_K=0, LDS_V=NSLOT*SLOTB, LDS_WS=2*NSLOT*SLOTB, LDS_OST=LDS_WS+NW*64*4, LDS_BYTES=LDS_OST+NW*4096;
constexpr float C2=0.125f*1.4426950408889634f;
__device__ __forceinline__ void glds16(const void*gsrc,unsigned lds_dst){unsigned keep;
  asm volatile("s_mov_b32 %0, m0\n\ts_mov_b32 m0, %2\n\ts_nop 0\n\tglobal_load_lds_dwordx4 %1, off\n\ts_mov_b32 m0, %0":"=&s"(keep):"v"(gsrc),"s"(lds_dst):"memory");}
__device__ __forceinline__ float max3f(float a,float b,float c){float r;asm("v_max3_f32 %0, %1, %2, %3":"=v"(r):"v"(a),"v"(b),"v"(c));return r;}
__device__ __forceinline__ float max2f(float a,float b){float r;asm("v_max_f32_e32 %0, %1, %2":"=v"(r):"v"(a),"v"(b));return r;}
__device__ __forceinline__ float fadd_s(float a,float b){float r;asm("v_add_f32_e32 %0, %1, %2":"=v"(r):"v"(a),"v"(b));return r;}
__device__ __forceinline__ float fsub_s(float a,float b){float r;asm("v_sub_f32_e32 %0, %1, %2":"=v"(r):"v"(a),"v"(b));return r;}
typedef float f32x2_t __attribute__((ext_vector_type(2))); typedef __bf16 bf16x2_t __attribute__((ext_vector_type(2)));
__device__ __forceinline__ unsigned cvtpk_s(float lo,float hi){f32x2_t v={lo,hi};bf16x2_t b=__builtin_convertvector(v,bf16x2_t);return __builtin_bit_cast(unsigned,b);}
#define WAIT_BAR(N) asm volatile("s_waitcnt vmcnt(" #N ") lgkmcnt(0)\n\ts_barrier":::"memory")

__device__ __forceinline__ void qkt(f32x16&p0,f32x16&p1,const char*Kslot,const bf16x8*qr,int r32,int hi){
  const char*kb=Kslot+hi*1024+r32*16;
  #pragma unroll
  for(int d0=0;d0<4;++d0){
    const bf16x8 b0=*reinterpret_cast<const bf16x8*>(kb+d0*2048);
    const bf16x8 b1=*reinterpret_cast<const bf16x8*>(kb+d0*2048+512);
    {p0=__builtin_amdgcn_mfma_f32_32x32x16_bf16(b0,qr[d0],p0,0,0,0);p1=__builtin_amdgcn_mfma_f32_32x32x16_bf16(b1,qr[d0],p1,0,0,0);}}
}
typedef __attribute__((address_space(3))) const char* lds_cptr;
typedef short v4i16_t __attribute__((ext_vector_type(4)));
__device__ __forceinline__ void kload8(bf16x8*kf,lds_cptr kp){
  kf[0]=*(const __attribute__((address_space(3))) bf16x8*)(kp);      kf[1]=*(const __attribute__((address_space(3))) bf16x8*)(kp+512);
  kf[2]=*(const __attribute__((address_space(3))) bf16x8*)(kp+2048); kf[3]=*(const __attribute__((address_space(3))) bf16x8*)(kp+2560);
  kf[4]=*(const __attribute__((address_space(3))) bf16x8*)(kp+4096); kf[5]=*(const __attribute__((address_space(3))) bf16x8*)(kp+4608);
  kf[6]=*(const __attribute__((address_space(3))) bf16x8*)(kp+6144); kf[7]=*(const __attribute__((address_space(3))) bf16x8*)(kp+6656);
}
__device__ __forceinline__ void kload2(bf16x8*kf,lds_cptr kp,int j){ kf[2*j]=*(const __attribute__((address_space(3))) bf16x8*)(kp+j*2048); kf[2*j+1]=*(const __attribute__((address_space(3))) bf16x8*)(kp+j*2048+512); }
__device__ __forceinline__ s16x4 vtr(lds_cptr p){ return __builtin_bit_cast(s16x4,__builtin_amdgcn_ds_read_tr16_b64_v4i16((__attribute__((address_space(3))) v4i16_t*)p)); }
__device__ __forceinline__ float rowmax(const f32x16&p0,const f32x16&p1){
  float a=max3f(p0[0],p0[1],p1[0]),b=max3f(p0[2],p0[3],p1[1]);a=max3f(a,p1[2],p1[3]);
  #pragma unroll
  for(int r=4;r<16;r+=4){a=max3f(a,p0[r],p0[r+1]);b=max3f(b,p0[r+2],p0[r+3]);a=max3f(a,p1[r],p1[r+1]);b=max3f(b,p1[r+2],p1[r+3]);}
  const float m=max2f(a,b);
  auto rr=__builtin_amdgcn_permlane32_swap(__float_as_uint(m),__float_as_uint(m),false,false);
  return max2f(__uint_as_float(rr[0]),__uint_as_float(rr[1]));
}
__device__ __forceinline__ void pv(f32x16*o,int vb,bf16x8 pa0,bf16x8 pa1,bf16x8 pa2,bf16x8 pa3){
  #pragma unroll
  for(int d0=0;d0<2;++d0){s16x4 lo[4],hi[4];
    #pragma unroll
    for(int ks=0;ks<4;++ks){
      asm volatile("ds_read_b64_tr_b16 %0,%1 offset:%c2":"=&v"(lo[ks]):"v"(vb),"i"(d0*4096+ks*1024):"memory");
      asm volatile("ds_read_b64_tr_b16 %0,%1 offset:%c2":"=&v"(hi[ks]):"v"(vb),"i"(d0*4096+ks*1024+512):"memory");}
    asm volatile("s_waitcnt lgkmcnt(0)":::"memory");SBAR();
    #define PK(k) (bf16x8){lo[k][0],lo[k][1],lo[k][2],lo[k][3],hi[k][0],hi[k][1],hi[k][2],hi[k][3]}
    o[d0]=__builtin_amdgcn_mfma_f32_32x32x16_bf16(pa0,PK(0),o[d0],0,0,0);
    o[d0]=__builtin_amdgcn_mfma_f32_32x32x16_bf16(pa1,PK(1),o[d0],0,0,0);
    o[d0]=__builtin_amdgcn_mfma_f32_32x32x16_bf16(pa2,PK(2),o[d0],0,0,0);
    o[d0]=__builtin_amdgcn_mfma_f32_32x32x16_bf16(pa3,PK(3),o[d0],0,0,0);
    #undef PK
  }
}

#ifndef ATTN_STORE16
#define ATTN_STORE16(p,v) (*(u32x4*)(p)=(v))
#endif
template<int THRL> __device__ __forceinline__ void attn_unit(int b,int h,int qb,const bf16*Q,const bf16*__restrict__ K,const bf16*__restrict__ V,const bf16*__restrict__ Zs,bf16*O,char*shm,const float*biasL,float*Kf,float*Vf){
  int tid=threadIdx.x; asm volatile("":"+v"(tid)); const int lane=tid&63,r32=lane&31,hi=lane>>5; const int wid=__builtin_amdgcn_readfirstlane(tid>>6);
  const long rowbase=(long)b*SEQ; const int q0=qb*QB;
  const bf16*Qw=Q+(rowbase+q0+wid*QBLK)*DM+h*D;
  const bf16*Kh=K+rowbase*DM+h*D,*Vh=V+rowbase*DM+h*D;
  const unsigned lds0=(unsigned)(uintptr_t)shm;
  float*wsf=(float*)(shm+LDS_WS)+wid*64;
  const bf16*ksrc=Kh+(long)lane*DM+wid*8;
  const bf16*vsrc=Vh+(long)(16*(wid&3)+(lane>>2))*DM+(wid>>2)*32+(lane&3)*8;
  const unsigned kdst=lds0+LDS_K+wid*1024, vdst=lds0+LDS_V+wid*1024;
  #define DMA_K(t,slot) glds16(ksrc+(long)(t)*KVBLK*DM,(unsigned)__builtin_amdgcn_readfirstlane(kdst+(slot)))
  #define DMA_V(t,slot) glds16(vsrc+(long)(t)*KVBLK*DM,(unsigned)__builtin_amdgcn_readfirstlane(vdst+(slot)))
  const int vb0=(int)(lds0+LDS_V)+((lane>>4)&1)*32+(lane&3)*8+(4*hi+((lane&15)>>2))*64;
  const char*Kbase=shm+LDS_K; bf16x8 kf[8];
  const lds_cptr shm3=(lds_cptr)shm; const lds_cptr kp0=shm3+LDS_K+hi*1024+r32*16; const lds_cptr vp0=shm3+LDS_V+((lane>>4)&1)*32+(lane&3)*8+(4*hi+((lane&15)>>2))*64;
  const int NT=(q0+QB)/KVBLK;
  DMA_K(0,0);DMA_V(0,0);DMA_K(1,SLOTB);
  bf16x8 qr[4];
  #pragma unroll
  for(int d0=0;d0<4;++d0)qr[d0]=__builtin_nontemporal_load(reinterpret_cast<const bf16x8*>(&Qw[(long)r32*DM+d0*16+hi*8]));
  float mhat=0.f,l_reg=0.f;f32x16 o[2];o[0]=f32x16{};o[1]=f32x16{};
  const int qrel=wid*QBLK+r32;
  #define BINITH(X,t,off) do{ const float*bp_=biasL+(t)*KVBLK+4*hi+(off); \
    _Pragma("unroll") for(int j_=0;j_<4;++j_){ const f32x4 a_=*(const f32x4*)(bp_+8*j_); \
      _Pragma("unroll") for(int i_=0;i_<4;++i_){ X[4*j_+i_]=a_[i_]-mhat; } } }while(0)
  #define BINIT(X0,X1,t) do{ BINITH(X0,t,0); BINITH(X1,t,32); }while(0)
  #define CMASK(P0,P1,t) do{int jb_=(t)-(NT-4); if(jb_>=0)cmask(P0,P1,jb_,qrel,hi);}while(0)
  bool resc=false;
  #define START(P0,P1) do{ const float rm=rowmax(P0,P1); resc=false; \
    { const float dl=rm; mhat=fadd_s(mhat,dl); \
      _Pragma("unroll") for(int r=0;r<16;++r){P0[r]=fsub_s(P0[r],dl);P1[r]=fsub_s(P1[r],dl);} \
      } \
    _Pragma("unroll") for(int r=0;r<16;++r)P0[r]=__builtin_amdgcn_exp2f(P0[r]); }while(0)
  #define RESC() do{ if(resc){ asm volatile("s_waitcnt lgkmcnt(0)":::"memory"); \
      _Pragma("unroll") for(int d_=0;d_<2;++d_) _Pragma("unroll") for(int r=0;r<16;++r)o[d_][r]*=wsf[crow(r,hi)]; } }while(0)
  f32x16 pA0,pA1,pB0,pB1;
  int sl_prev=0,sl_cur=0,sl_next=SLOTB;
  #define ROT() do{sl_prev=sl_cur;sl_cur=sl_next;sl_next=(sl_next==(NSLOT-1)*SLOTB)?0:sl_next+SLOTB;}while(0)
  DMA_K(2,2*SLOTB);
  WAIT_BAR(3);
  BINIT(pA0,pA1,0); qkt(pA0,pA1,Kbase,qr,r32,hi);asm volatile("s_nop 15\n\ts_nop 7":"+v"(pA0),"+v"(pA1));CMASK(pA0,pA1,0);
  START(pA0,pA1);
  BINIT(pB0,pB1,1);
  _Pragma("unroll") for(int r=0;r<16;++r)pA1[r]=__builtin_amdgcn_exp2f(pA1[r]);
  WAIT_BAR(0);
  DMA_K(3,0);DMA_V(1,SLOTB);
  ROT();
  kload8(kf,kp0+sl_cur);
  WAIT_BAR(2);
  s16x4 vlo[8],vhi[8]; u32x4 pw0,pw1,pw2,pw3;
  #define PKW(P,B) cvtpk_s(P[B],P[B+1])
  #define PAF(k) __builtin_bit_cast(bf16x8,pw##k)
  #define VFR(i) (bf16x8){vlo[i][0],vlo[i][1],vlo[i][2],vlo[i][3],vhi[i][0],vhi[i][1],vhi[i][2],vhi[i][3]}
  #define PIN(x) asm volatile("":"+v"(x))
  #define MX3(a,b,c) __builtin_fmaxf(__builtin_fmaxf((a),(b)),(c))
  #define GAPA(MF,A0,A1,A2,A3,W0,W1,PW) do{ MF; sacc+=A0; sacc+=A1; sacc+=A2; sacc+=A3; PIN(sacc); W0; W1; PIN(PW); SBAR(); }while(0)
  #define EX(v) __builtin_amdgcn_exp2f(v)
  #define GAPB(MF,X,B,GN,Y) do{ MF; X[B]=EX(X[B]); X[B+1]=EX(X[B+1]); X[B+2]=EX(X[B+2]); X[B+3]=EX(X[B+3]); PIN(X); if(GN){ Y[B]-=mhat; Y[B+1]-=mhat; Y[B+2]-=mhat; Y[B+3]-=mhat; PIN(Y); } SBAR(); }while(0)
  #define BLOAD(X0,X1,t) do{ const float*bp_=biasL+(t)*KVBLK+4*hi; \
    _Pragma("unroll") for(int j_=0;j_<4;++j_){ const f32x4 a_=*(const f32x4*)(bp_+8*j_), b_=*(const f32x4*)(bp_+32+8*j_); \
      _Pragma("unroll") for(int i_=0;i_<4;++i_){ X0[4*j_+i_]=a_[i_]; X1[4*j_+i_]=b_[i_]; } } }while(0)
  #define VRD(i) do{ vlo[i]=vtr(vp_+(((i)>>2)*4096+((i)&3)*1024)); vhi[i]=vtr(vp_+(((i)>>2)*4096+((i)&3)*1024+512)); }while(0)
  #define KRD(G,j) do{ if(G){ kload2(kf,kp0+sl_next,j); SBAR(); } }while(0)
  #define STEP(C0,C1,P0,P1,t,GK,GV,GL) do{ SBAR(); \
    const lds_cptr vp_=vp0+sl_prev; \
    VRD(0); SBAR(); float sacc=(P0[0]+P0[1]); \
    GAPA(C0=__builtin_amdgcn_mfma_f32_32x32x16_bf16(kf[0],qr[0],C0,0,0,0), P0[2],P0[3],P0[4],P0[5],     pw0[0]=PKW(P0,0), pw0[1]=PKW(P0,2), pw0); \
    VRD(4); SBAR(); GAPA(C1=__builtin_amdgcn_mfma_f32_32x32x16_bf16(kf[1],qr[0],C1,0,0,0), P0[6],P0[7],P0[8],P0[9],     pw0[2]=PKW(P0,4), pw0[3]=PKW(P0,6), pw0); \
    VRD(1); SBAR(); GAPA(C0=__builtin_amdgcn_mfma_f32_32x32x16_bf16(kf[2],qr[1],C0,0,0,0),   P0[10],P0[11],P0[12],P0[13], pw1[0]=PKW(P0,8), pw1[1]=PKW(P0,10), pw1); \
    VRD(5); SBAR(); GAPA(C1=__builtin_amdgcn_mfma_f32_32x32x16_bf16(kf[3],qr[1],C1,0,0,0),   P0[14],P0[15],P1[0],P1[1],   pw1[2]=PKW(P0,12),pw1[3]=PKW(P0,14), pw1); \
    VRD(2); SBAR(); GAPA(C0=__builtin_amdgcn_mfma_f32_32x32x16_bf16(kf[4],qr[2],C0,0,0,0),   P1[2],P1[3],P1[4],P1[5],     pw2[0]=PKW(P1,0), pw2[1]=PKW(P1,2), pw2); \
    VRD(6); SBAR(); GAPA(C1=__builtin_amdgcn_mfma_f32_32x32x16_bf16(kf[5],qr[2],C1,0,0,0),   P1[6],P1[7],P1[8],P1[9],     pw2[2]=PKW(P1,4), pw2[3]=PKW(P1,6), pw2); \
    VRD(3); SBAR(); GAPA(C0=__builtin_amdgcn_mfma_f32_32x32x16_bf16(kf[6],qr[3],C0,0,0,0),   P1[10],P1[11],P1[12],P1[13], pw3[0]=PKW(P1,8), pw3[1]=PKW(P1,10), pw3); \
    VRD(7); SBAR(); GAPA(C1=__builtin_amdgcn_mfma_f32_32x32x16_bf16(kf[7],qr[3],C1,0,0,0),   P1[14],P1[15],0.f,0.f,       pw3[2]=PKW(P1,12),pw3[3]=PKW(P1,14), pw3); \
    l_reg+=sacc; \
    if(GK){DMA_K((t)+3,sl_cur);} if(GV){DMA_V((t)+1,sl_next);} \
    CMASK(C0,C1,t); \
    { float a=MX3(C0[0],C0[1],C1[0]),b=MX3(C0[2],C0[3],C1[1]); a=MX3(a,C1[2],C1[3]); \
      _Pragma("unroll") for(int r=4;r<16;r+=4){a=MX3(a,C0[r],C0[r+1]);b=MX3(b,C0[r+2],C0[r+3]);a=MX3(a,C1[r],C1[r+1]);b=MX3(b,C1[r+2],C1[r+3]);} \
      float rm=__builtin_fmaxf(a,b); { auto rr=__builtin_amdgcn_permlane32_swap(__float_as_uint(rm),__float_as_uint(rm),false,false); rm=__builtin_fmaxf(__uint_as_float(rr[0]),__uint_as_float(rr[1])); } \
      resc=false; \
      if(__builtin_expect(__any(rm>(float)THRL),0)){ const float dl=__builtin_fmaxf(rm,0.f); mhat+=dl; \
        _Pragma("unroll") for(int r=0;r<16;++r){C0[r]-=dl;C1[r]-=dl;} \
        const float f=__builtin_amdgcn_exp2f(-dl); l_reg*=f; if(hi==0)wsf[r32]=f; resc=true; } } \
    SBAR(); if(GL){ BLOAD(P0,P1,(t)+1); } SBAR(); \
    GAPB(o[0]=__builtin_amdgcn_mfma_f32_32x32x16_bf16(PAF(0),VFR(0),o[0],0,0,0), C0,0,GL,P0); \
    GAPB(o[1]=__builtin_amdgcn_mfma_f32_32x32x16_bf16(PAF(0),VFR(4),o[1],0,0,0), C0,4,GL,P0); \
    KRD(GL,0); GAPB(o[0]=__builtin_amdgcn_mfma_f32_32x32x16_bf16(PAF(1),VFR(1),o[0],0,0,0), C0,8,GL,P0); \
    KRD(GL,1); GAPB(o[1]=__builtin_amdgcn_mfma_f32_32x32x16_bf16(PAF(1),VFR(5),o[1],0,0,0), C0,12,GL,P0); \
    KRD(GL,2); GAPB(o[0]=__builtin_amdgcn_mfma_f32_32x32x16_bf16(PAF(2),VFR(2),o[0],0,0,0), C1,0,GL,P1); \
    KRD(GL,3); GAPB(o[1]=__builtin_amdgcn_mfma_f32_32x32x16_bf16(PAF(2),VFR(6),o[1],0,0,0), C1,4,GL,P1); \
    GAPB(o[0]=__builtin_amdgcn_mfma_f32_32x32x16_bf16(PAF(3),VFR(3),o[0],0,0,0), C1,8,GL,P1); \
    GAPB(o[1]=__builtin_amdgcn_mfma_f32_32x32x16_bf16(PAF(3),VFR(7),o[1],0,0,0), C1,12,GL,P1); \
    }while(0)
  int t=1;
  #undef CMASK
  #define CMASK(P0,P1,t) do{}while(0)
  for(;t+5<NT;t+=2){
    STEP(pB0,pB1,pA0,pA1,t,true,true,true);     WAIT_BAR(2); RESC(); ROT();
    STEP(pA0,pA1,pB0,pB1,t+1,true,true,true);   WAIT_BAR(2); RESC(); ROT();
  }
  #undef CMASK
  #define CMASK(P0,P1,t) do{int jb_=(t)-(NT-4); if(jb_>=0)cmask(P0,P1,jb_,qrel,hi);}while(0)
  #define ENDW(tt) do{ if((tt)+3<NT){WAIT_BAR(2);} else if((tt)+2<NT){WAIT_BAR(1);} else {WAIT_BAR(0);} }while(0)
  for(;t+1<NT;t+=2){
    STEP(pB0,pB1,pA0,pA1,t,(t+3<NT),(t+1<NT),(t+1<NT));       ENDW(t);   RESC(); ROT();
    STEP(pA0,pA1,pB0,pB1,t+1,(t+4<NT),(t+2<NT),(t+2<NT));     ENDW(t+1); RESC(); ROT();
  }
  STEP(pB0,pB1,pA0,pA1,NT-1,false,false,false); RESC();
  u32x4 kcv[4],vcv[4]; { const bf16*Kw=K+(rowbase+q0+wid*QBLK)*DM+h*D; const bf16*Vw=V+(rowbase+q0+wid*QBLK)*DM+h*D;
    _Pragma("unroll") for(int i=0;i<4;++i){ const int row=i*8+(lane>>3),ch=lane&7; kcv[i]=*(const u32x4*)(Kw+(long)row*DM+ch*8); vcv[i]=*(const u32x4*)(Vw+(long)row*DM+ch*8); } }
  u32x4 zpre[4]; { const bf16*Zw=Zs+(rowbase+q0+wid*QBLK)*DM+h*D;
    _Pragma("unroll") for(int i=0;i<4;++i){ const int row=i*8+(lane>>3),ch=lane&7; zpre[i]=__builtin_nontemporal_load((const u32x4*)(Zw+(long)row*DM+ch*8)); } }
  { float sacc=pB0[0]+pB0[1]; _Pragma("unroll") for(int r=2;r<16;++r)sacc+=pB0[r]; _Pragma("unroll") for(int r=0;r<16;++r)sacc+=pB1[r]; l_reg+=sacc;
    pw0=(u32x4){PKW(pB0,0),PKW(pB0,2),PKW(pB0,4),PKW(pB0,6)};pw1=(u32x4){PKW(pB0,8),PKW(pB0,10),PKW(pB0,12),PKW(pB0,14)};pw2=(u32x4){PKW(pB1,0),PKW(pB1,2),PKW(pB1,4),PKW(pB1,6)};pw3=(u32x4){PKW(pB1,8),PKW(pB1,10),PKW(pB1,12),PKW(pB1,14)};
    SBAR(); pv(o,vb0+sl_cur,PAF(0),PAF(1),PAF(2),PAF(3)); }
  #undef PKW
  #undef PAF
  #undef VFR
  #undef PIN
  #undef MX3
  #undef GAPA
  #undef GAPB
  #undef BLOAD
  #undef EX
  #undef VRD
  #undef KRD
  #undef STEP
  #undef ENDW
  {auto rr=__builtin_amdgcn_permlane32_swap(__float_as_uint(l_reg),__float_as_uint(l_reg),false,false);l_reg=__uint_as_float(rr[0])+__uint_as_float(rr[1]);}
  if(hi==0)wsf[32+r32]=l_reg;asm volatile("s_waitcnt lgkmcnt(0)":::"memory");
  float rli[16];
  #pragma unroll
  for(int r=0;r<16;++r)rli[r]=__builtin_amdgcn_rcpf(wsf[32+crow(r,hi)]);
  bf16*Ow=O+(rowbase+q0+wid*QBLK)*DM+h*D;
  { bf16*stg=(bf16*)(shm+LDS_OST)+wid*2048;
    #pragma unroll
    for(int r=0;r<16;++r){const int orow=crow(r,hi);
      #pragma unroll
      for(int d0=0;d0<2;++d0)stg[orow*64+d0*32+r32]=__float2bfloat16(o[d0][r]*rli[r]);}
    asm volatile("s_waitcnt lgkmcnt(0)":::"memory");
    int lane_e=lane; asm volatile("":"+v"(lane_e));
    #pragma unroll
    for(int i=0;i<4;++i){const int lane=lane_e; const bf16*Zw=Zs+(rowbase+q0+wid*QBLK)*DM+h*D; const int row=i*8+(lane>>3),ch=lane&7; const u32x4 v=*(const u32x4*)(stg+row*64+ch*8); const u32x4 z=zpre[i]; u32x4 w;
      _Pragma("unroll") for(int e=0;e<4;++e){ const float a0=__uint_as_float(v[e]<<16)*__uint_as_float(z[e]<<16), a1=__uint_as_float(v[e]&0xffff0000u)*__uint_as_float(z[e]&0xffff0000u); w[e]=cvtpk_s(a0,a1); }
      ATTN_STORE16(Ow+(long)row*DM+ch*8,w);
      { float*kd=Kf+(rowbase+q0+wid*QBLK+row)*DM+h*D+ch*8; float*vd=Vf+(rowbase+q0+wid*QBLK+row)*DM+h*D+ch*8; const u32x4 kw=kcv[i],vw=vcv[i];
        __builtin_nontemporal_store((f32x4){__uint_as_float(kw[0]<<16),__uint_as_float(kw[0]&0xffff0000u),__uint_as_float(kw[1]<<16),__uint_as_float(kw[1]&0xffff0000u)},(f32x4*)kd);
        __builtin_nontemporal_store((f32x4){__uint_as_float(kw[2]<<16),__uint_as_float(kw[2]&0xffff0000u),__uint_as_float(kw[3]<<16),__uint_as_float(kw[3]&0xffff0000u)},(f32x4*)(kd+4));
        __builtin_nontemporal_store((f32x4){__uint_as_float(vw[0]<<16),__uint_as_float(vw[0]&0xffff0000u),__uint_as_float(vw[1]<<16),__uint_as_float(vw[1]&0xffff0000u)},(f32x4*)vd);
        __builtin_nontemporal_store((f32x4){__uint_as_float(vw[2]<<16),__uint_as_float(vw[2]&0xffff0000u),__uint_as_float(vw[3]<<16),__uint_as_float(vw[3]&0xffff0000u)},(f32x4*)(vd+4)); } } }
  asm volatile("s_waitcnt lgkmcnt(0)\n\ts_barrier":::"memory");
  #undef DMA_K
  #undef DMA_V
  #undef CMASK
  #undef START
  #undef RESC
  #undef BINIT
  #undef BINITH
  #undef ROT
}
constexpr int ATTN_LDS_BYTES=LDS_BYTES;
__device__ __forceinline__ void sample_unit(int b,int h,int qblk,const bf16*Q,const bf16*Kb,const bf16*Vb,const bf16*Zs,bf16*O,
    const float*__restrict__ ck,const float*__restrict__ cv,const float*__restrict__ clf,const float*__restrict__ lfs,char*shm){
  int tid=threadIdx.x; asm volatile("":"+v"(tid)); const int lane=tid&63,r32=lane&31,hi=lane>>5; const int wid=__builtin_amdgcn_readfirstlane(tid>>6);
  constexpr int S_V=0,S_O=65536,S_ML=131072,S_BIAS=133120,S_WT=137728; constexpr long SROW0=32768;
  float*biasS=(float*)(shm+S_BIAS);
  { f32x4 v=(f32x4){0.f,0.f,0.f,0.f};
    if(tid<272){
      #pragma unroll
      for(int i=0;i<4;++i){const int p=4*tid+i; v[i]= p<1024 ? clf[((size_t)b*1024+p)*16+h] : lfs[((size_t)b*64+(p-1024))*16+h];} }
    block_scan4(v,biasS,(LAS float*)(shm+S_WT),tid,272); }
  const bf16*Qw=Q+(SROW0+b*64+qblk*32)*DM+h*D;
  bf16x8 qr[4];
  #pragma unroll
  for(int d0=0;d0<4;++d0)qr[d0]=*reinterpret_cast<const bf16x8*>(&Qw[(long)r32*DM+d0*16+hi*8]);
  f32x16 P[3][2];
  #define SU_BIAS(acc,t,hf) do{ const float*bp=biasS+64*(t)+32*(hf)+4*hi; \
      _Pragma("unroll") for(int j=0;j<4;++j){ const f32x4 a=*(const f32x4*)(bp+8*j); _Pragma("unroll") for(int e=0;e<4;++e)acc[4*j+e]=a[e]; } }while(0)
  #pragma unroll
  for(int i=0;i<2;++i){ const int t=wid+8*i;
    #pragma unroll
    for(int hf=0;hf<2;++hf){
      bf16x8 kf[4];
      const float*kp=ck+(((size_t)b*1024+64*t+32*hf+r32)*16+h)*64+hi*8;
      #pragma unroll
      for(int d0=0;d0<4;++d0){ const f32x4 a=*(const f32x4*)(kp+d0*16),c=*(const f32x4*)(kp+d0*16+4);
        u32x4 w; w[0]=cvtpk_s(a[0],a[1]); w[1]=cvtpk_s(a[2],a[3]); w[2]=cvtpk_s(c[0],c[1]); w[3]=cvtpk_s(c[2],c[3]); kf[d0]=__builtin_bit_cast(bf16x8,w);}
      f32x16 acc; SU_BIAS(acc,t,hf);
      #pragma unroll
      for(int d0=0;d0<4;++d0)acc=__builtin_amdgcn_mfma_f32_32x32x16_bf16(kf[d0],qr[d0],acc,0,0,0);
      P[i][hf]=acc; } }
  if(wid==0){
    #pragma unroll
    for(int hf=0;hf<2;++hf){
      bf16x8 kf[4]; const bf16*kp=Kb+(SROW0+b*64+32*hf+r32)*DM+h*D+hi*8;
      #pragma unroll
      for(int d0=0;d0<4;++d0)kf[d0]=*reinterpret_cast<const bf16x8*>(kp+d0*16);
      f32x16 acc; SU_BIAS(acc,16,hf);
      #pragma unroll
      for(int d0=0;d0<4;++d0)acc=__builtin_amdgcn_mfma_f32_32x32x16_bf16(kf[d0],qr[d0],acc,0,0,0);
      #pragma unroll
      for(int r=0;r<16;++r){ if(crow(r,hi)+32*hf>32*qblk+r32)acc[r]=-INFINITY; }
      P[2][hf]=acc; }
  } else {
    #pragma unroll
    for(int hf=0;hf<2;++hf){
      #pragma unroll
      for(int r=0;r<16;++r)P[2][hf][r]=-INFINITY; }
  }
  #undef SU_BIAS
  float m=-INFINITY;
  #pragma unroll
  for(int i=0;i<3;++i){
    #pragma unroll
    for(int hf=0;hf<2;++hf){
      #pragma unroll
      for(int r=0;r<16;++r)m=fmaxf(m,P[i][hf][r]); } }
  m=fmaxf(m,__shfl_xor(m,32));
  float l=0.f;
  #pragma unroll
  for(int i=0;i<3;++i){
    #pragma unroll
    for(int hf=0;hf<2;++hf){
      #pragma unroll
      for(int r=0;r<16;++r){ const float p=__builtin_amdgcn_exp2f(P[i][hf][r]-m); P[i][hf][r]=p; l+=p; } } }
  l+=__shfl_xor(l,32);
  f32x16 o[2]; o[0]=f32x16{}; o[1]=f32x16{};
  const unsigned lds0=(unsigned)(uintptr_t)shm;
  char*vslot=shm+S_V+wid*8192;
  const int vb=(int)(lds0+S_V+wid*8192)+((lane>>4)&1)*32+(lane&3)*8+(4*hi+((lane&15)>>2))*64;
  #pragma unroll
  for(int i=0;i<3;++i){ const int t=wid+8*i;
    if(i<2||wid==0){
      #pragma unroll
      for(int j=0;j<8;++j){ const int k=8*j+(lane>>3),c8=lane&7; u32x4 w;
        if(i<2){ const float*vp=cv+(((size_t)b*1024+64*t+k)*16+h)*64+c8*8; const f32x4 a=*(const f32x4*)vp,c=*(const f32x4*)(vp+4);
          w[0]=cvtpk_s(a[0],a[1]); w[1]=cvtpk_s(a[2],a[3]); w[2]=cvtpk_s(c[0],c[1]); w[3]=cvtpk_s(c[2],c[3]); }
        else{ w=*reinterpret_cast<const u32x4*>(Vb+(SROW0+b*64+k)*DM+h*D+c8*8); }
        *reinterpret_cast<u32x4*>(vslot+(((c8>>2)*4+(k>>4))*1024+(k&15)*64+(c8&3)*16))=w; }
      asm volatile("s_waitcnt lgkmcnt(0)":::"memory");
      u32x4 pw0,pw1,pw2,pw3;
      #define PKW(X,B) cvtpk_s(X[B],X[B+1])
      pw0=(u32x4){PKW(P[i][0],0),PKW(P[i][0],2),PKW(P[i][0],4),PKW(P[i][0],6)}; pw1=(u32x4){PKW(P[i][0],8),PKW(P[i][0],10),PKW(P[i][0],12),PKW(P[i][0],14)};
      pw2=(u32x4){PKW(P[i][1],0),PKW(P[i][1],2),PKW(P[i][1],4),PKW(P[i][1],6)}; pw3=(u32x4){PKW(P[i][1],8),PKW(P[i][1],10),PKW(P[i][1],12),PKW(P[i][1],14)};
      #undef PKW
      SBAR(); pv(o,vb,__builtin_bit_cast(bf16x8,pw0),__builtin_bit_cast(bf16x8,pw1),__builtin_bit_cast(bf16x8,pw2),__builtin_bit_cast(bf16x8,pw3)); SBAR();
    }
  }
  { float*Op=(float*)(shm+S_O)+wid*2048;
    #pragma unroll
    for(int d0=0;d0<2;++d0){
      #pragma unroll
      for(int r=0;r<16;++r)Op[crow(r,hi)*64+d0*32+r32]=o[d0][r]; }
    float*ml=(float*)(shm+S_ML)+wid*64; if(hi==0){ml[r32]=m;ml[32+r32]=l;} }
  asm volatile("s_waitcnt lgkmcnt(0)\n\ts_barrier":::"memory");
  { const int q=tid>>4,d4=(tid&15)*4; const float*mlb=(const float*)(shm+S_ML); const float*Ob=(const float*)(shm+S_O);
    float M=-INFINITY;
    #pragma unroll
    for(int w=0;w<8;++w)M=fmaxf(M,mlb[w*64+q]);
    f32x4 num=(f32x4){0.f,0.f,0.f,0.f}; float den=0.f;
    #pragma unroll
    for(int w=0;w<8;++w){ const float f=__builtin_amdgcn_exp2f(mlb[w*64+q]-M); den+=f*mlb[w*64+32+q]; num+=*(const f32x4*)(Ob+w*2048+q*64+d4)*f; }
    const float inv=1.0f/den; const long row=SROW0+b*64+qblk*32+q;
    typedef unsigned u32x2_t __attribute__((ext_vector_type(2)));
    const u32x2_t z=*reinterpret_cast<const u32x2_t*>(Zs+row*DM+h*D+d4); u32x2_t w;
    w[0]=cvtpk_s(num[0]*inv*__uint_as_float(z[0]<<16),num[1]*inv*__uint_as_float(z[0]&0xffff0000u));
    w[1]=cvtpk_s(num[2]*inv*__uint_as_float(z[1]<<16),num[3]*inv*__uint_as_float(z[1]&0xffff0000u));
    *reinterpret_cast<u32x2_t*>(O+row*DM+h*D+d4)=w; }
  asm volatile("s_waitcnt lgkmcnt(0)\n\ts_barrier":::"memory");
}
#undef SBAR
#undef WAIT_BAR
}
typedef __attribute__((address_space(1))) unsigned gu32;
#define XB_TMO      128
#define XB_XCNT(j)  (256  + 64 * (j))
#define XB_XSUB(j)  (1280 + 64 * (j))
#define XB_XGEN(j)  (2304 + 64 * (j))
#define XB_TOP      3328
#define XB_TOPGEN   3392
#define XCD_BAR_WORDS 3456
#define XB_SPIN_CAP (1u << 18)

__device__ __forceinline__ unsigned xb_ld(unsigned* p)              { return __hip_atomic_load(p, __ATOMIC_RELAXED, __HIP_MEMORY_SCOPE_AGENT); }
__device__ __forceinline__ unsigned xb_add(unsigned* p, unsigned v) { return __hip_atomic_fetch_add(p, v, __ATOMIC_RELAXED, __HIP_MEMORY_SCOPE_AGENT); }
__device__ __forceinline__ unsigned xb_xcc_id() { return (unsigned)__builtin_amdgcn_s_getreg((3 << 11) | 20) & 0xFu; }
#define XB_SPIN(cond, bar) do { unsigned _sp = 0; while (cond) { __builtin_amdgcn_s_sleep(1); \
    if ((++_sp & 255u) == 0u) { if (xb_ld(&(bar)[XB_TMO])) break; if (_sp > XB_SPIN_CAP) { atomicAdd(&(bar)[XB_TMO], 1u); break; } } } } while (0)

struct XcdBarrier {
    unsigned* bar; unsigned x;
    volatile LAS unsigned* st;
};

__device__ __forceinline__ XcdBarrier xcd_barrier_post(unsigned* bar, volatile LAS unsigned* st) {
    XcdBarrier b; b.bar = bar; b.x = xb_xcc_id(); b.st = st;
    if (threadIdx.x == 0) (void)xb_add(&bar[XB_XCNT(b.x)], 1u);
    return b;
}
__device__ __forceinline__ void xcd_barrier_complete(unsigned* bar, unsigned x, unsigned& nloc, unsigned& nx) {
    const unsigned G = gridDim.x * gridDim.y * gridDim.z;
    unsigned sum, cnt, mine, sp = 0u;
    for (;;) {
        sum = 0u; cnt = 0u; mine = 0u;
#pragma unroll
        for (unsigned j = 0; j < 16; ++j) { const unsigned c = xb_ld(&bar[XB_XCNT(j)]); sum += c; cnt += (c > 0u) ? 1u : 0u; mine = (j == x) ? c : mine; }
        if (sum == G) break;
        __builtin_amdgcn_s_sleep(1);
        if ((++sp & 255u) == 0u) { if (xb_ld(&bar[XB_TMO])) break; if (sp > XB_SPIN_CAP) { atomicAdd(&bar[XB_TMO], 1u); break; } }
    }
    nloc = mine > 0u ? mine : 1u; nx = cnt > 0u ? cnt : 1u;
}

__device__ __forceinline__ void xcd_barrier(const XcdBarrier& b) {
    asm volatile("s_waitcnt vmcnt(0)" ::: "memory");
    __syncthreads();
    if (threadIdx.x == 0) {
        unsigned* bar = b.bar;
        __builtin_amdgcn_s_waitcnt(0);
        unsigned nloc = b.st[0], nx = b.st[1];
        if (nloc == 0u) { xcd_barrier_complete(bar, b.x, nloc, nx); b.st[0] = nloc; b.st[1] = nx; }
        const unsigned old = xb_add(&bar[XB_XSUB(b.x)], 1u);
        const unsigned gen = old / nloc;
        if (old + 1u == (gen + 1u) * nloc) {
            __builtin_amdgcn_fence(__ATOMIC_RELEASE, "agent");
            asm volatile("s_waitcnt vmcnt(0)" ::: "memory");
            const unsigned og = xb_add(&bar[XB_TOP], 1u);
            const unsigned tg = og / nx;
            if (og + 1u == (tg + 1u) * nx) xb_add(&bar[XB_TOPGEN], 1u);
            else XB_SPIN(xb_ld(&bar[XB_TOPGEN]) == tg, bar);
            __builtin_amdgcn_fence(__ATOMIC_ACQUIRE, "agent");
            xb_add(&bar[XB_XGEN(b.x)], 1u);
            asm volatile("s_waitcnt vmcnt(0)" ::: "memory");
        } else {
            XB_SPIN(xb_ld(&bar[XB_XGEN(b.x)]) == gen, bar);
            __builtin_amdgcn_fence(__ATOMIC_ACQUIRE, "agent");
            asm volatile("s_waitcnt vmcnt(0)" ::: "memory");
        }
    }
    __syncthreads();
}

#ifndef SKIPMASK
#define SKIPMASK 0
#endif
#ifndef MK_N_LAUNCHES
#define MK_N_LAUNCHES 1
#endif
constexpr int N_PHASES = 9;
struct Args { const float* in[18]; float* out; unsigned char* ws; int ph_lo, ph_hi; };
enum { I_XP = 0, I_XS, I_CP, I_CS, I_STATE, I_CK, I_CV, I_CLF, I_NORMG, I_ADAW, I_ADAB, I_W1, I_CONVK, I_W2, I_W3, I_BF, I_W4, I_FG };

__global__ void __launch_bounds__(NWAVES * 64, 2) hybrid_fwd(Args args) {
    extern __shared__ __attribute__((aligned(16))) unsigned char lds[];
    LAS unsigned char* L = (LAS unsigned char*)lds;
    const int tid0 = threadIdx.x, wave = __builtin_amdgcn_readfirstlane(tid0 >> 6);
#define PHASE_TID() int tid = tid0; asm volatile("" : "+v"(tid)); const int lane = tid & 63; (void)lane
    const int G = gridDim.x; const int bx = blockIdx.x; const int vcu = (G % 8 == 0) ? (bx % 8) * (G / 8) + bx / 8 : bx;
    const int gw = vcu * NWAVES + wave, NGW = G * NWAVES;
    unsigned char* ws = args.ws; float* out = args.out;
    float* mod = (float*)(ws + WS_MOD);
    bf16* W1t = (bf16*)(ws + WS_W1); bf16* W2t = (bf16*)(ws + WS_W2); bf16* W3t = (bf16*)(ws + WS_W3); bf16* W4t = (bf16*)(ws + WS_W4);
    float* slab = (float*)(ws + WS_SLAB); bf16* AOb = (bf16*)(ws + WS_AO);
    bf16* Hb = (bf16*)(ws + WS_H); bf16* Yb = (bf16*)(ws + WS_Y); bf16* Qb = (bf16*)(ws + WS_Q); bf16* Kb = (bf16*)(ws + WS_K); bf16* Vb = (bf16*)(ws + WS_V); bf16* Zb = (bf16*)(ws + WS_Z);
    const int lo = args.ph_lo, hi = args.ph_hi;
#define IN(k) (lo <= (k) && (k) < hi)
#define SEAM(k) do { if (IN(k) && IN((k) + 1)) { xcd_barrier(bar); } } while (0)
    volatile LAS unsigned* MISC = (volatile LAS unsigned*)(L + XL_OFF + 12288);
    if (tid0 < 64) MISC[tid0] = 0u;
    __syncthreads();
    XcdBarrier bar = xcd_barrier_post((unsigned*)(ws + WS_CTL), MISC + 8);
    if (args.ph_lo < 0) cg::this_grid().sync();

    if (IN(0) && !(SKIPMASK & (1 << 0))) { PHASE_TID();
        LAS float* scr = (LAS float*)(L + wave * 16640);
        const int it = wave * G + vcu;
        if (it < 1536) {
            const int l = it / 768, rem = it % 768, cb = rem >> 4, kc = rem & 15, k0 = 64 * kc;
#pragma unroll
            for (int bb = 0; bb < 24; ++bb) { const float c = bb < 16 ? args.in[I_CP][bb * 1024 + k0 + lane] : args.in[I_CS][(bb - 16) * 1024 + k0 + lane]; scr[bb * 64 + lane] = c / (1.0f + expf(-c)); }
            const float* W = args.in[I_ADAW] + (size_t)l * 1024 * 3072 + (size_t)k0 * 3072 + cb * 64 + lane;
            float a[24];
#pragma unroll
            for (int bb = 0; bb < 24; ++bb) a[bb] = 0.f;
            LDS_WAIT(); asm volatile("" ::: "memory");
#pragma unroll 4
            for (int k4 = 0; k4 < 16; ++k4) { const int k = 4 * k4;
                const float w0 = __builtin_nontemporal_load(W + (size_t)k * 3072), w1 = __builtin_nontemporal_load(W + (size_t)(k + 1) * 3072), w2 = __builtin_nontemporal_load(W + (size_t)(k + 2) * 3072), w3 = __builtin_nontemporal_load(W + (size_t)(k + 3) * 3072);
#pragma unroll
                for (int bb = 0; bb < 24; ++bb) { const f32x4 s = *(const LAS f32x4*)(scr + bb * 64 + k); a[bb] += (s.x * w0 + s.y * w1) + (s.z * w2 + s.w * w3); } }
            float* mo = mod + (size_t)l * 24 * 3072 + cb * 64 + lane;
            const float bias = kc == 0 ? args.in[I_ADAB][l * 3072 + cb * 64 + lane] : 0.f;
#pragma unroll
            for (int bb = 0; bb < 24; ++bb) __hip_atomic_fetch_add(mo + (size_t)bb * 3072, a[bb] + bias, __ATOMIC_RELAXED, __HIP_MEMORY_SCOPE_AGENT);
            LDS_WAIT(); asm volatile("" ::: "memory");
        }
        for (int t = gw; t < 16 * 128; t += NGW) p0_transpose_item<1>(args.in[I_W1], 1024, N1, W1t, scr, t, lane);
    }
    SEAM(0);
    if (IN(1) && !(SKIPMASK & (1 << 1))) { PHASE_TID();
        for (int c = gw; c < MP / 16; c += NGW) ada_norm_rows(args.in[I_XP] + (size_t)c * 16 * DM, Hb + (size_t)c * 16 * DM, 16, args.in[I_NORMG], mod + (size_t)(c >> 7) * 3072, lane);
        for (int m = gw; m < MS; m += NGW) ada_norm_row(args.in[I_XS] + (size_t)m * DM, Hb + (size_t)(MP + m) * DM, args.in[I_NORMG], mod + (size_t)(16 + (m >> 6)) * 3072, lane);
    }
    SEAM(1);
    if (IN(2) && !(SKIPMASK & (1 << 2))) { PHASE_TID();
        pg8::Gemm g{Hb, W1t, MT, N1, DM}; pg8::ConvOrder S; S.init(G, vcu);
        pg8::EpiConv E{Yb, args.in[I_CONVK], args.in[I_STATE], out + O_CONVP, out + O_CONVS};
        pg8::gemm_phase<pg8::EpiConv, pg8::ConvOrder, true, true>(L, L + XL_OFF, g, S, E);
        {
            const bool part = (G == 256);
            if (!part || vcu >= 64) {
                LAS float* scr = (LAS float*)(L + wave * 16640);
                constexpr int I2 = 32 * 16, I3 = 16 * 65, I4 = 16 * 16;
                const int w0 = part ? (vcu - 64) * NWAVES + wave : gw, nw = part ? (G - 64) * NWAVES : NGW;
                for (int t = w0; t < I2 + I3 + I4; t += nw) {
                    int r = t;
                    if (r < I2) { p0_transpose_item<0>(args.in[I_W2], 2048, 1024, W2t, scr, r, lane); continue; } r -= I2;
                    if (r < I3) { p0_transpose_item<0>(args.in[I_W3], 1024, 4112, W3t, scr, r, lane); continue; } r -= I3;
                    p0_transpose_item<0>(args.in[I_W4], 1024, 1024, W4t, scr, r, lane);
                }
            }
        }
    }
    SEAM(2);
    if (IN(3) && !(SKIPMASK & (1 << 3))) { PHASE_TID();
        pg8::Gemm g{Yb, W2t, MT, DM, EW}; pg8::PanelOrder S; S.init(EW, G, vcu);
        pg8::EpiResNorm<0> E{args.in[I_XP], out + O_Y, mod + 2048, slab, Hb, args.in[I_NORMG] + DM, mod + (size_t)24 * 3072, (float*)(ws + WS_X), (unsigned*)(ws + WS_CNT), (bf16*)(ws + WS_X1)};
        pg8::gemm_phase<pg8::EpiResNorm<0>, pg8::PanelOrder, true, true>(L, L + XL_OFF, g, S, E);
    }
    SEAM(3);
    if (IN(4) && !(SKIPMASK & (1 << 4))) { PHASE_TID();
        for (int m = MP + gw; m < MT; m += NGW) { const int bb = 16 + ((m - MP) >> 6);
            ada_norm_row(args.in[I_XS] + (size_t)(m - MP) * DM, Hb + (size_t)m * DM, args.in[I_NORMG] + DM, mod + (size_t)(24 + bb) * 3072, lane, slab + (size_t)(m - MP) * DM, mod + (size_t)bb * 3072 + 2048, out + O_Y + (size_t)m * DM); }
    }
    SEAM(4);
    if (IN(5) && !(SKIPMASK & (1 << 5))) { PHASE_TID();
        pg8::Gemm g{Hb, W3t, MT, N3, DM}; pg8::StaticOrder S; S.init(MT, N3, DM, G, bx);
        pg8::EpiQKV E{Qb, Kb, Vb, Zb, out + O_KP, out + O_KS, out + O_VP, out + O_VS, out + O_LP, out + O_LS, args.in[I_BF], attn_body::C2};
        pg8::gemm_phase<pg8::EpiQKV, pg8::StaticOrder, true, true>(L, L + XL_OFF, g, S, E);
    }
    SEAM(5);
    if (IN(6) && !(SKIPMASK & (1 << 6))) { PHASE_TID();
        char* shm = (char*)lds; float* biasL = (float*)(shm + 86016);
        typedef attn_body::bf16 abf;
        for (int bh = vcu; bh < NB_P * NH; bh += G) { const int b = bh >> 4, h = bh & 15;
            f32x4 v; int tq = tid; asm volatile("" : "+v"(tq));
#pragma unroll
            for (int i = 0; i < 4; ++i) v[i] = out[O_LP + ((size_t)b * SEQ + 4 * tq + i) * NH + h];
            block_scan4(v, biasL, (LAS float*)(L + 96 * 1024), tq, 512);
#ifndef NO_PROMPT_ATT
            for (int i = 0; i < SEQ / 256; ++i) { const int qb = (vcu + 8 - i) & 7;
                attn_body::attn_unit<8>(b, h, qb, (const abf*)Qb, (const abf*)Kb, (const abf*)Vb, (const abf*)Zb, (abf*)AOb, shm, biasL, out + O_KP, out + O_VP); }
#endif
        }
#ifndef NO_SAMPLE_ATT
        for (int su = vcu; su < NB_S * NH * 2; su += G)
            attn_body::sample_unit(su >> 5, (su >> 1) & 15, su & 1, (const abf*)Qb, (const abf*)Kb, (const abf*)Vb, (const abf*)Zb, (abf*)AOb, args.in[I_CK], args.in[I_CV], args.in[I_CLF], out + O_LS, shm);
#endif
    }
    SEAM(6);
    if (IN(7) && !(SKIPMASK & (1 << 7))) { PHASE_TID();
        pg8::Gemm g{AOb, W4t, MT, DM, DM}; pg8::PanelOrder S; S.init(DM, G, vcu);
        pg8::EpiResNorm<1> E{out + O_Y, out + O_Y, mod + (size_t)24 * 3072 + 2048, slab, nullptr, args.in[I_FG], nullptr, (float*)(ws + WS_X + 512 * 1024), (unsigned*)(ws + WS_CNT + 32 * 1024), (bf16*)(ws + WS_X1)};
        pg8::gemm_phase<pg8::EpiResNorm<1>, pg8::PanelOrder, true, true>(L, L + XL_OFF, g, S, E);
    }
    SEAM(7);
    if (IN(8) && !(SKIPMASK & (1 << 8))) { PHASE_TID();
        for (int m = MP + gw; m < MT; m += NGW) final_norm_row(out + O_Y + (size_t)m * DM, args.in[I_FG], lane, slab + (size_t)(m - MP) * DM, mod + (size_t)(24 + 16 + ((m - MP) >> 6)) * 3072 + 2048);
    }
#undef IN
#undef SEAM
}

extern "C" void kernel_launch(void* const* d_in, const int* in_sizes, int n_in, void* d_out, int out_size, void* d_ws, size_t ws_size, hipStream_t stream) {
    static int grid = 0;
    if (grid == 0) {
        if (n_in != 18 || (size_t)out_size != O_END || ws_size < WS_END) { fprintf(stderr, "kernel_launch: unexpected shapes (n_in %d out %d ws %zu)\n", n_in, out_size, ws_size); grid = -1; return; }
        int dev = 0, cus = 0, per_cu = 0;
        if (hipGetDevice(&dev) != hipSuccess || hipDeviceGetAttribute(&cus, hipDeviceAttributeMultiprocessorCount, dev) != hipSuccess) { grid = -1; return; }
        if (hipFuncSetAttribute((const void*)hybrid_fwd, hipFuncAttributeMaxDynamicSharedMemorySize, LDS_BYTES) != hipSuccess) { fprintf(stderr, "kernel_launch: hipFuncSetAttribute failed\n"); grid = -1; return; }
        if (hipOccupancyMaxActiveBlocksPerMultiprocessor(&per_cu, (const void*)hybrid_fwd, NWAVES * 64, LDS_BYTES) != hipSuccess || per_cu < 1) { fprintf(stderr, "kernel_launch: occupancy query says %d\n", per_cu); (void)hipGetLastError(); per_cu = 1; }
        grid = cus * 1;
        (void)per_cu;
    }
    if (grid < 0) return;
    if (hipMemsetAsync((char*)d_ws + WS_CTL, 0, CTL_ZERO_BYTES, stream) != hipSuccess) { fprintf(stderr, "kernel_launch: memset failed\n"); return; }
    Args a{};
    for (int i = 0; i < 18; ++i) a.in[i] = (const float*)d_in[i];
    a.out = (float*)d_out; a.ws = (unsigned char*)d_ws;
    if (MK_N_LAUNCHES == 1) {
        a.ph_lo = 0; a.ph_hi = N_PHASES;
        void* kargs[] = {&a};
        hipError_t e = hipLaunchCooperativeKernel((const void*)hybrid_fwd, dim3(grid), dim3(NWAVES * 64), kargs, LDS_BYTES, stream);
        if (e != hipSuccess) fprintf(stderr, "kernel_launch: cooperative launch failed: %s (grid %d)\n", hipGetErrorString(e), grid);
    } else {
        for (int p = 0; p < N_PHASES; ++p) { a.ph_lo = p; a.ph_hi = p + 1; hipLaunchKernelGGL(hybrid_fwd, dim3(grid), dim3(NWAVES * 64), LDS_BYTES, stream, a); }
    }
}
```

```cpp
#include <hip/hip_runtime.h>
#include <hip/hip_cooperative_groups.h>
#include <hip/hip_bf16.h>
#include <cstdio>
#include <cstdint>
#include <cmath>
namespace cg = cooperative_groups;

namespace pg8 {
#define PG8_LAS __attribute__((address_space(3)))
typedef unsigned short bf16_t;
typedef short bf16x8 __attribute__((ext_vector_type(8)));
typedef float f32x4 __attribute__((ext_vector_type(4)));
typedef unsigned u32x4 __attribute__((ext_vector_type(4)));
typedef unsigned u32x2 __attribute__((ext_vector_type(2)));
constexpr int BM = 256, BK = 64, HALF = 128, HTB = HALF * BK * 2  , STAGE_BYTES = 8 * HTB, NXCD = 8, WGM = 8;

__host__ __device__ __forceinline__ int lds_byte(int r, int c) { const int st = (r >> 4) * 2 + (c >> 5), rr = r & 15, cc = c & 31, ob = rr * 64 + cc * 2; return st * 1024 + (ob ^ (((ob >> 9) & 1) << 5)); }
__host__ __device__ __forceinline__ void stage_rc(int b, int& R, int& C) { const int st = b / 1024, sb = b % 1024, swz = sb ^ (((sb >> 9) & 1) << 5); R = (st >> 1) * 16 + swz / 64; C = (st & 1) * 32 + (swz % 64) / 2; }
__host__ __device__ __forceinline__ int perm32(int rho) { const int n = rho >> 4, i = rho & 15; return 8 * (i >> 2) + 4 * n + (i & 3); }

struct Unit { int pm, pn, k0, nt, split; };
struct Gemm { const bf16_t* A; const bf16_t* Bt; int M, N, K; };

struct StaticOrder {
    int nM, nN, nwg, G, c, ntk;
    __host__ __device__ void init(int M, int N, int K, int G_, int c_) { nM = M / BM; nN = N / BM; nwg = nM * nN; G = G_; c = c_; ntk = K / BK; }
    __host__ __device__ bool next(int i, Unit& u) const {
        const long L = (long)i * G + c; if (L >= nwg) return false;
        int wgid = (int)L; { const int q = nwg / NXCD, r = nwg % NXCD, xcd = wgid % NXCD, off = wgid / NXCD; wgid = (xcd < r ? xcd * (q + 1) : r * (q + 1) + (xcd - r) * q) + off; }
        const int nig = WGM * nN, gid = wgid / nig, fm = gid * WGM, gsz = (nM - fm) < WGM ? (nM - fm) : WGM;
        u.pm = fm + ((wgid % nig) % gsz); u.pn = (wgid % nig) / gsz; u.k0 = 0; u.nt = ntk; u.split = 0; return true;
    }
};
struct ConvOrder {
    int vcu, G, nsup;
    __device__ void init(int G_, int vcu_) { G = G_; vcu = vcu_; nsup = vcu < 512 ? (512 - vcu + G - 1) / G : 0; }
    __device__ bool next(int i, Unit& u) const {
        u.k0 = 0; u.nt = 16; u.split = 0;
        if (i < 8 * nsup) { const int s = vcu + G * (i >> 3), j = i & 7, combo = s >> 5, y = s & 31; const int b = (combo >> 2) * 4 + (y >> 3); u.pn = (combo & 3) * 8 + (y & 7); u.pm = b * 8 + j; return true; }
        const int su = vcu + G * (i - 8 * nsup); if (su >= 64) return false;
        u.pm = 128 + (su >> 5); u.pn = su & 31; return true;
    }
};

constexpr int NSPLIT = 8;
struct PanelOrder {
    int vcu, G, npr, ntk;
    __device__ void init(int K, int G_, int vcu_) { G = G_; vcu = vcu_; ntk = K / BK; npr = vcu < 512 ? (512 - vcu + G - 1) / G : 0; }
    __device__ bool next(int i, Unit& u) const {
        if (i < npr) { const int L = vcu + G * i; u.pm = L >> 2; u.pn = L & 3; u.k0 = 0; u.nt = ntk; u.split = 0; return true; }
        const int s = vcu + G * (i - npr); if (s >= 8 * NSPLIT) return false;
        const int tile = s / NSPLIT, ch = s % NSPLIT; u.pm = 128 + (tile >> 2); u.pn = tile & 3; u.nt = ntk / NSPLIT; u.k0 = ch * u.nt * BK; u.split = ch + 1; return true;
    }
};

__device__ __forceinline__ unsigned cvt_pk_bf16(float lo, float hi) { unsigned r; asm volatile("v_cvt_pk_bf16_f32 %0, %1, %2" : "=v"(r) : "v"(lo), "v"(hi)); return r; }
__device__ __forceinline__ float silu_f(float z) { return z * __builtin_amdgcn_rcpf(1.0f + __builtin_amdgcn_exp2f(-1.4426950408889634f * z)); }
__device__ __forceinline__ float shfl_i(float v, int srcb) { return __builtin_bit_cast(float, __builtin_amdgcn_ds_bpermute(srcb, __builtin_bit_cast(int, v))); }

constexpr int NPROMPT_TILES = 128, PROMPT_ROWS = 32768;

struct EpiConv {
    static constexpr bool PERM = false;
    bf16_t* Y; const float* convk; const float* state; float* outp; float* outs;
    __device__ __forceinline__ void operator()(f32x4 (&acc)[2][2][4][2], const Unit& u, int wr, int wc, int fr, int fq, PG8_LAS unsigned char* xl, int ui) const {
        const int lane = threadIdx.x & 63;
        const int chl = wc * 16 + fq * 4, e0 = u.pn * 64 + chl;
        const bool samp = u.pm >= NPROMPT_TILES;
        PG8_LAS float* tail = (PG8_LAS float*)xl + (ui & 1) * 512;
        PG8_LAS float* tailp = (PG8_LAS float*)xl + ((ui & 1) ^ 1) * 512;
#pragma unroll
        for (int ai = 0; ai < 2; ++ai)
#pragma unroll
            for (int m = 0; m < 4; ++m) acc[ai][0][m][1] = acc[ai][0][m][1] * acc[ai][1][m][0];
        if (fr >= 14) {
#pragma unroll
            for (int ai = 0; ai < 2; ++ai) *(PG8_LAS f32x4*)(tail + ((2 * ai + wr) * 2 + (fr - 14)) * 64 + chl) = acc[ai][0][3][1];
        }
        asm volatile("s_waitcnt lgkmcnt(0)" ::: "memory"); __builtin_amdgcn_s_barrier(); asm volatile("" ::: "memory");
        const f32x4 k0 = *(const f32x4*)(convk + e0), k1 = *(const f32x4*)(convk + 2048 + e0), k2 = *(const f32x4*)(convk + 4096 + e0);
        const int src1 = ((lane & 48) | ((lane - 1) & 15)) << 2, src2 = ((lane & 48) | ((lane - 2) & 15)) << 2;
#pragma unroll
        for (int ai = 0; ai < 2; ++ai) {
            const int g = 2 * ai + wr;
            f32x4 p1, p2;
            if (samp) { const int bs = (u.pm - NPROMPT_TILES) * 4 + g; p2 = *(const f32x4*)(state + (size_t)(bs * 2 + 0) * 2048 + e0); p1 = *(const f32x4*)(state + (size_t)(bs * 2 + 1) * 2048 + e0); }
            else if (g == 0) { if ((u.pm & 7) == 0) { p1 = (f32x4){0.f, 0.f, 0.f, 0.f}; p2 = p1; } else { p2 = *(PG8_LAS f32x4*)(tailp + (3 * 2 + 0) * 64 + chl); p1 = *(PG8_LAS f32x4*)(tailp + (3 * 2 + 1) * 64 + chl); } }
            else { p2 = *(PG8_LAS f32x4*)(tail + ((g - 1) * 2 + 0) * 64 + chl); p1 = *(PG8_LAS f32x4*)(tail + ((g - 1) * 2 + 1) * 64 + chl); }
            f32x4 r1p = p1, r2p = (fr == 0) ? p2 : p1;
#pragma unroll
            for (int m = 0; m < 4; ++m) {
                const f32x4 uu = acc[ai][0][m][1];
                f32x4 r1, r2;
#pragma unroll
                for (int i = 0; i < 4; ++i) { r1[i] = shfl_i(uu[i], src1); r2[i] = shfl_i(uu[i], src2); }
                const f32x4 um1 = (fr >= 1) ? r1 : r1p, um2 = (fr >= 2) ? r2 : r2p;
                const f32x4 cv = k2 * uu + k1 * um1 + k0 * um2;
                const f32x4 bg = acc[ai][0][m][0], z = acc[ai][1][m][1];
                f32x4 y;
#pragma unroll
                for (int i = 0; i < 4; ++i) y[i] = bg[i] * cv[i] * silu_f(z[i]);
                const size_t row = (size_t)u.pm * BM + ai * HALF + wr * 64 + m * 16 + fr;
                u32x2 w; w.x = cvt_pk_bf16(y[0], y[1]); w.y = cvt_pk_bf16(y[2], y[3]);
                *(u32x2*)(Y + row * 2048 + e0) = w;
                r1p = r1; r2p = r2;
            }
            if (fr >= 14) {
                if (samp) { const int bs = (u.pm - NPROMPT_TILES) * 4 + g; *(f32x4*)(outs + (size_t)(bs * 2 + (fr - 14)) * 2048 + e0) = acc[ai][0][3][1]; }
                else if ((u.pm & 7) == 7 && g == 3) { *(f32x4*)(outp + (size_t)((u.pm >> 3) * 2 + (fr - 14)) * 2048 + e0) = acc[ai][0][3][1]; }
            }
        }
    }
};

struct EpiRes {
    static constexpr bool PERM = false;
    const float* xp; const float* xs; float* out; const float* gate; float* slab;
    __device__ __forceinline__ void operator()(f32x4 (&acc)[2][2][4][2], const Unit& u, int wr, int wc, int fr, int fq, PG8_LAS unsigned char*, int) const {
        const bool samp = u.pm >= NPROMPT_TILES;
        const float* xb = samp ? xs : xp;
        const int col0 = u.pn * BM + wc * 32 + 4 * fq;
        if (u.split) {
            float* sb = slab + (size_t)(u.split - 1) * 512 * 1024;
#pragma unroll
            for (int ai = 0; ai < 2; ++ai)
#pragma unroll
                for (int m = 0; m < 4; ++m) { const size_t off = ((size_t)(u.pm - NPROMPT_TILES) * BM + ai * HALF + wr * 64 + m * 16 + fr) * 1024 + col0;
#pragma unroll
                    for (int bj = 0; bj < 2; ++bj)
#pragma unroll
                        for (int n = 0; n < 2; ++n) *(f32x4*)(sb + off + bj * HALF + n * 16) = acc[ai][bj][m][n]; }
            return;
        }
#pragma unroll
        for (int ai = 0; ai < 2; ++ai) {
            const int bb = samp ? 16 + (u.pm - NPROMPT_TILES) * 4 + 2 * ai + wr : (u.pm >> 3);
            f32x4 gv[2][2];
#pragma unroll
            for (int bj = 0; bj < 2; ++bj)
#pragma unroll
                for (int n = 0; n < 2; ++n) gv[bj][n] = *(const f32x4*)(gate + (size_t)bb * 3072 + col0 + bj * HALF + n * 16);
#pragma unroll
            for (int m = 0; m < 4; ++m) {
                const size_t off = ((size_t)u.pm * BM + ai * HALF + wr * 64 + m * 16 + fr) * 1024 + col0;
#pragma unroll
                for (int bj = 0; bj < 2; ++bj)
#pragma unroll
                    for (int n = 0; n < 2; ++n) { const f32x4 xv = *(const f32x4*)(xb + off + bj * HALF + n * 16); *(f32x4*)(out + off + bj * HALF + n * 16) = xv + gv[bj][n] * acc[ai][bj][m][n]; }
                if (m & 1) asm volatile("" ::: "memory");
            }
        }
    }
};

template <int MODE> struct EpiResNorm {
    static constexpr bool PERM = true;
    const float* xin; float* out; const float* gate; float* slab; bf16_t* hb; const float* g; const float* modn; float* xbuf; unsigned* cnt; bf16_t* x1b;
    __device__ __forceinline__ void operator()(f32x4 (&acc)[2][2][4][2], const Unit& u, int wr, int wc, int fr, int fq, PG8_LAS unsigned char* xl, int) const {
        const int col0 = u.pn * BM + wc * 32 + 8 * fq;
        if (u.split) {
            float* sb = slab + (size_t)(u.split - 1) * 512 * 1024;
#pragma unroll
            for (int ai = 0; ai < 2; ++ai)
#pragma unroll
                for (int m = 0; m < 4; ++m) { const size_t off = ((size_t)(u.pm - NPROMPT_TILES) * BM + ai * HALF + wr * 64 + m * 16 + fr) * 1024 + col0;
#pragma unroll
                    for (int bj = 0; bj < 2; ++bj)
#pragma unroll
                        for (int n = 0; n < 2; ++n) *(f32x4*)(sb + off + bj * HALF + n * 4) = acc[ai][bj][m][n]; }
            return;
        }
        const int lane = threadIdx.x & 63, wid = wr * 4 + wc, bb = u.pm >> 3;
        PG8_LAS float* P = (PG8_LAS float*)(xl + 4096);
        PG8_LAS float* S = P + 1024;
        {   f32x4 gv[2][2];
#pragma unroll
            for (int bj = 0; bj < 2; ++bj)
#pragma unroll
                for (int n = 0; n < 2; ++n) gv[bj][n] = *(const f32x4*)(gate + (size_t)bb * 3072 + col0 + bj * HALF + n * 4);
#pragma unroll
            for (int ai = 0; ai < 2; ++ai)
#pragma unroll
                for (int m = 0; m < 4; ++m) { const size_t off = ((size_t)u.pm * BM + ai * HALF + wr * 64 + m * 16 + fr) * 1024 + col0; float s = 0.f;
#pragma unroll
                    for (int bj = 0; bj < 2; ++bj) { f32x4 xv[2];
                        if (MODE == 0) { xv[0] = __builtin_nontemporal_load((const f32x4*)(xin + off + bj * HALF)); xv[1] = __builtin_nontemporal_load((const f32x4*)(xin + off + bj * HALF + 4)); }
                        else { const u32x4 xw = __builtin_nontemporal_load((const u32x4*)(x1b + off + bj * HALF));
                            xv[0] = (f32x4){__builtin_bit_cast(float, xw.x << 16), __builtin_bit_cast(float, xw.x & 0xffff0000u), __builtin_bit_cast(float, xw.y << 16), __builtin_bit_cast(float, xw.y & 0xffff0000u)};
                            xv[1] = (f32x4){__builtin_bit_cast(float, xw.z << 16), __builtin_bit_cast(float, xw.z & 0xffff0000u), __builtin_bit_cast(float, xw.w << 16), __builtin_bit_cast(float, xw.w & 0xffff0000u)}; }
#pragma unroll
                        for (int n = 0; n < 2; ++n) { const f32x4 a = xv[n] + gv[bj][n] * acc[ai][bj][m][n]; acc[ai][bj][m][n] = a; s += (a[0] * a[0] + a[1] * a[1]) + (a[2] * a[2] + a[3] * a[3]); } }
                    s += __shfl_xor(s, 16); s += __shfl_xor(s, 32);
                    if (fq == 0) P[(ai * HALF + wr * 64 + m * 16 + fr) * 4 + wc] = s;
                    if (m & 1) asm volatile("" ::: "memory"); } }
        asm volatile("s_waitcnt lgkmcnt(0)" ::: "memory"); __builtin_amdgcn_s_barrier(); asm volatile("" ::: "memory");
        const int row = wid * 32 + (lane & 31);
        if (lane < 32) { const float tot = (P[row * 4 + 0] + P[row * 4 + 1]) + (P[row * 4 + 2] + P[row * 4 + 3]);
            __hip_atomic_store(xbuf + ((size_t)u.pm * BM + row) * 4 + u.pn, tot, __ATOMIC_RELAXED, __HIP_MEMORY_SCOPE_AGENT); }
        asm volatile("s_waitcnt vmcnt(0)" ::: "memory");
        if (lane == 0) __hip_atomic_fetch_add(cnt + 64 * u.pm, 1u, __ATOMIC_RELAXED, __HIP_MEMORY_SCOPE_AGENT);
        if (wid == 0) { unsigned sp = 0;
            while ((unsigned)__builtin_amdgcn_readfirstlane((int)__hip_atomic_load(cnt + 64 * u.pm, __ATOMIC_RELAXED, __HIP_MEMORY_SCOPE_AGENT)) < 32u) { __builtin_amdgcn_s_sleep(2); if (++sp > (1u << 20)) break; }
            __builtin_amdgcn_fence(__ATOMIC_ACQUIRE, "agent"); }
        asm volatile("s_waitcnt vmcnt(0) lgkmcnt(0)" ::: "memory"); __builtin_amdgcn_s_barrier(); asm volatile("" ::: "memory");
        if (lane < 32) { const float* sl = xbuf + ((size_t)u.pm * BM + row) * 4; float t = 0.f;
#pragma unroll
            for (int q = 0; q < 4; ++q) t += __hip_atomic_load(sl + q, __ATOMIC_RELAXED, __HIP_MEMORY_SCOPE_AGENT);
            S[row] = 1.0f / sqrtf(t * (1.0f / 1024.0f) + 1e-6f); }
        asm volatile("s_waitcnt lgkmcnt(0)" ::: "memory"); __builtin_amdgcn_s_barrier(); asm volatile("" ::: "memory");
#pragma unroll
        for (int bj = 0; bj < 2; ++bj) { const int col = col0 + bj * HALF;
            f32x4 gm[2], sh[2];
#pragma unroll
            for (int n = 0; n < 2; ++n) { gm[n] = *(const f32x4*)(g + col + 4 * n); sh[n] = (f32x4){0.f, 0.f, 0.f, 0.f};
                if (MODE == 0) { gm[n] = gm[n] * (*(const f32x4*)(modn + (size_t)bb * 3072 + 1024 + col + 4 * n) + 1.0f); sh[n] = *(const f32x4*)(modn + (size_t)bb * 3072 + col + 4 * n); } }
#pragma unroll
            for (int ai = 0; ai < 2; ++ai)
#pragma unroll
                for (int m = 0; m < 4; ++m) { const int r = ai * HALF + wr * 64 + m * 16 + fr; const float rs = S[r]; const size_t off = ((size_t)u.pm * BM + r) * 1024 + col; const f32x4 a0 = acc[ai][bj][m][0], a1 = acc[ai][bj][m][1];
                    if (MODE == 0) { u32x4 xw; xw.x = cvt_pk_bf16(a0[0], a0[1]); xw.y = cvt_pk_bf16(a0[2], a0[3]); xw.z = cvt_pk_bf16(a1[0], a1[1]); xw.w = cvt_pk_bf16(a1[2], a1[3]); __builtin_nontemporal_store(xw, (u32x4*)(x1b + off));
                        const f32x4 h0 = a0 * rs * gm[0] + sh[0], h1 = a1 * rs * gm[1] + sh[1]; u32x4 w; w.x = cvt_pk_bf16(h0[0], h0[1]); w.y = cvt_pk_bf16(h0[2], h0[3]); w.z = cvt_pk_bf16(h1[0], h1[1]); w.w = cvt_pk_bf16(h1[2], h1[3]); *(u32x4*)(hb + off) = w; }
                    else { __builtin_nontemporal_store(a0 * rs * gm[0], (f32x4*)(out + off)); __builtin_nontemporal_store(a1 * rs * gm[1], (f32x4*)(out + off + 4)); } } }
    }
};

struct EpiQKV {
    static constexpr bool PERM = true;
    bf16_t *Qb, *Kb, *Vb, *Zb; float *okp, *oks, *ovp, *ovs, *olp, *ols; const float* bf; float c2;
    __device__ __forceinline__ void operator()(f32x4 (&acc)[2][2][4][2], const Unit& u, int wr, int wc, int fr, int fq, PG8_LAS unsigned char*, int) const {
        const int t = u.pn >> 2; const bool samp = u.pm >= NPROMPT_TILES;
        const size_t row0 = (size_t)u.pm * BM + wr * 64 + fr;
        if (t == 4) {
            if (wc == 0 && fq < 2) {
                float* ob = samp ? ols - (size_t)PROMPT_ROWS * 16 : olp;
#pragma unroll
                for (int n = 0; n < 2; ++n) { const f32x4 bv = *(const f32x4*)(bf + 8 * fq + 4 * n);
#pragma unroll
                    for (int ai = 0; ai < 2; ++ai)
#pragma unroll
                        for (int m = 0; m < 4; ++m) { const f32x4 a = acc[ai][0][m][n] + bv; f32x4 lf;
#pragma unroll
                            for (int i = 0; i < 4; ++i) lf[i] = fminf(a[i], 0.f) - log1pf(expf(-fabsf(a[i])));
                            *(f32x4*)(ob + (row0 + ai * HALF + m * 16) * 16 + 8 * fq + 4 * n) = lf; } }
            }
            return;
        }
        const int col0 = (u.pn & 3) * BM + wc * 32 + 8 * fq;
        bf16_t* bo = t == 0 ? Qb : t == 1 ? Kb : t == 2 ? Vb : Zb;
        float* fo = t == 1 ? (samp ? oks - (size_t)PROMPT_ROWS * 1024 : okp) : (samp ? ovs - (size_t)PROMPT_ROWS * 1024 : ovp);
#pragma unroll
        for (int ai = 0; ai < 2; ++ai)
#pragma unroll
            for (int m = 0; m < 4; ++m) { const size_t off = (row0 + ai * HALF + m * 16) * 1024 + col0;
#pragma unroll
                for (int bj = 0; bj < 2; ++bj) { f32x4 v0 = acc[ai][bj][m][0], v1 = acc[ai][bj][m][1];
                    if ((t == 1 || t == 2) && samp) { __builtin_nontemporal_store(v0, (f32x4*)(fo + off + bj * HALF)); __builtin_nontemporal_store(v1, (f32x4*)(fo + off + bj * HALF + 4)); }
                    if (t == 0) { v0 = v0 * c2; v1 = v1 * c2; }
                    if (t == 3) {
#pragma unroll
                        for (int i = 0; i < 4; ++i) { v0[i] = silu_f(v0[i]); v1[i] = silu_f(v1[i]); } }
                    u32x4 w; w.x = cvt_pk_bf16(v0[0], v0[1]); w.y = cvt_pk_bf16(v0[2], v0[3]); w.z = cvt_pk_bf16(v1[0], v1[1]); w.w = cvt_pk_bf16(v1[2], v1[3]);
                    *(u32x4*)(bo + off + bj * HALF) = w; } }
    }
};
template <class Epi, class Sched, bool ALIGN_EPI = false, bool SP2 = false>
__device__ __forceinline__ void gemm_phase(PG8_LAS unsigned char* lds, PG8_LAS unsigned char* xlds, const Gemm g, const Sched& S, const Epi& E) {
    const int tid = threadIdx.x, wid = __builtin_amdgcn_readfirstlane(tid >> 6), lane = tid & 63, wr = wid >> 2, wc = wid & 3, fr = lane & 15, fq = lane >> 4;
    const int K = g.K; int nt;
    unsigned voffA[2], voffB[2];
#pragma unroll
    for (int i = 0; i < 2; ++i) { int R, C; stage_rc(tid * 16 + i * 8192, R, C); const int Rb = Epi::PERM ? ((R & ~31) + perm32(R & 31)) : R;
        voffA[i] = (unsigned)(R * K + C) * 2u; voffB[i] = (unsigned)(Rb * K + C) * 2u; }
    const size_t kstep = (size_t)(BK * 2);
    const size_t hstep = (size_t)HALF * K * 2;
    const size_t tstep = 2 * hstep;
    const unsigned ldsw = (unsigned)wid * 1024u;
    const int aoff = lds_byte(wr * 64 + fr, fq * 8), boff = lds_byte(wc * 32 + fr, fq * 8);
#define PG8_SA(b, h) (((b) * 2 + (h)) * HTB)
#define PG8_SB(b, h) ((4 + (b) * 2 + (h)) * HTB)
#define PG8_STAGE(bufoff, gbase, voff) do { _Pragma("unroll") for (int _i = 0; _i < 2; ++_i) \
        __builtin_amdgcn_global_load_lds((const unsigned*)((const char*)(gbase) + (voff)[_i]), (PG8_LAS unsigned*)(lds + (bufoff) + ldsw + _i * 8192), 16, 0, 0); } while (0)
#define PG8_LDA(dst, b, h) do { _Pragma("unroll") for (int m = 0; m < 4; ++m) _Pragma("unroll") for (int k = 0; k < 2; ++k) dst[m][k] = *(const PG8_LAS bf16x8*)(lds + PG8_SA(b, h) + aoff + m * 2048 + k * 1024); } while (0)
#define PG8_LDB(dst, b, h) do { _Pragma("unroll") for (int n = 0; n < 2; ++n) _Pragma("unroll") for (int k = 0; k < 2; ++k) dst[n][k] = *(const PG8_LAS bf16x8*)(lds + PG8_SB(b, h) + boff + n * 2048 + k * 1024); } while (0)
#define PG8_MMA(ai, bj, At, Bt) do { __builtin_amdgcn_s_setprio(1); _Pragma("unroll") for (int m = 0; m < 4; ++m) _Pragma("unroll") for (int n = 0; n < 2; ++n) _Pragma("unroll") for (int k = 0; k < 2; ++k) \
        acc[ai][bj][m][n] = __builtin_amdgcn_mfma_f32_16x16x32_bf16(Bt[n][k], At[m][k], acc[ai][bj][m][n], 0, 0, 0); __builtin_amdgcn_s_setprio(0); } while (0)
#define PG8_WAIT_V(n) asm volatile("s_waitcnt vmcnt(" #n ")" ::: "memory")
#define PG8_WAIT_L(n) asm volatile("s_waitcnt lgkmcnt(" #n ")" ::: "memory")
#define PG8_BAR __builtin_amdgcn_s_barrier()
#define PG8_SCHED __builtin_amdgcn_sched_barrier(0)
    Unit cur, nxt; int ui = 0;
    if (!S.next(0, cur)) return;
    nt = cur.nt;
    f32x4 acc[2][2][4][2];
#pragma unroll
    for (int a = 0; a < 2; ++a)
#pragma unroll
        for (int b = 0; b < 2; ++b)
#pragma unroll
            for (int m = 0; m < 4; ++m)
#pragma unroll
                for (int n = 0; n < 2; ++n) acc[a][b][m][n] = (f32x4){0.f, 0.f, 0.f, 0.f};
    bf16x8 At[4][2], B0[2][2], B1[2][2];
    const char* cA = (const char*)g.A + (size_t)cur.pm * tstep + (size_t)cur.k0 * 2; const char* cB = (const char*)g.Bt + (size_t)cur.pn * tstep + (size_t)cur.k0 * 2;
    if constexpr (SP2) {
        PG8_STAGE(PG8_SB(0, 0), cB, voffB); PG8_STAGE(PG8_SB(0, 1), cB + hstep, voffB); PG8_STAGE(PG8_SA(0, 0), cA, voffA); PG8_STAGE(PG8_SA(0, 1), cA + hstep, voffA);
        if (wr == 1) PG8_BAR;
        PG8_WAIT_V(2); PG8_BAR;
        PG8_STAGE(PG8_SB(1, 0), cB + kstep, voffB); PG8_STAGE(PG8_SA(1, 0), cA + kstep, voffA); PG8_STAGE(PG8_SB(1, 1), cB + hstep + kstep, voffB);
        PG8_WAIT_V(6); PG8_BAR;
    } else {
        PG8_STAGE(PG8_SB(0, 0), cB, voffB); PG8_STAGE(PG8_SA(0, 0), cA, voffA); PG8_STAGE(PG8_SB(0, 1), cB + hstep, voffB); PG8_STAGE(PG8_SA(0, 1), cA + hstep, voffA);
        if (wr == 1) PG8_BAR;
        PG8_WAIT_V(4); PG8_BAR;
        PG8_STAGE(PG8_SB(1, 0), cB + kstep, voffB); PG8_STAGE(PG8_SA(1, 0), cA + kstep, voffA); PG8_STAGE(PG8_SB(1, 1), cB + hstep + kstep, voffB);
        PG8_WAIT_V(6); PG8_BAR;
    }
    for (;;) {
        const bool has_next = S.next(ui + 1, nxt);
        const char* nA = has_next ? (const char*)g.A + (size_t)nxt.pm * tstep + (size_t)nxt.k0 * 2 : cA; const char* nB = has_next ? (const char*)g.Bt + (size_t)nxt.pn * tstep + (size_t)nxt.k0 * 2 : cB;
        for (int t = 0; t < nt; t += 2) {
            const bool last = (t == nt - 2);
            const char* a1 = cA + (size_t)(t + 1) * kstep;
            const char* a2 = last ? nA : cA + (size_t)(t + 2) * kstep; const char* b2 = last ? nB : cB + (size_t)(t + 2) * kstep;
            const char* a3 = a2 + kstep; const char* b3 = b2 + kstep;
            if constexpr (SP2) {
            PG8_LDB(B0, 0, 0); PG8_LDB(B1, 0, 1); PG8_SCHED; PG8_LDA(At, 0, 0); PG8_STAGE(PG8_SA(1, 1), a1 + hstep, voffA);
            PG8_WAIT_V(8); PG8_WAIT_L(0); PG8_BAR; PG8_MMA(0, 0, At, B0); PG8_MMA(0, 1, At, B1); PG8_BAR; PG8_SCHED;
            PG8_LDA(At, 0, 1); PG8_STAGE(PG8_SB(0, 0), b2, voffB); PG8_STAGE(PG8_SB(0, 1), b2 + hstep, voffB); PG8_STAGE(PG8_SA(0, 0), a2, voffA);
            PG8_WAIT_V(8); PG8_WAIT_L(0); PG8_BAR; PG8_MMA(1, 0, At, B0); PG8_MMA(1, 1, At, B1); PG8_BAR; PG8_SCHED;
            PG8_LDB(B0, 1, 0); PG8_LDB(B1, 1, 1); PG8_SCHED; PG8_LDA(At, 1, 0); PG8_STAGE(PG8_SA(0, 1), a2 + hstep, voffA);
            PG8_WAIT_V(8); PG8_WAIT_L(0); PG8_BAR; PG8_MMA(0, 0, At, B0); PG8_MMA(0, 1, At, B1); PG8_BAR; PG8_SCHED;
            PG8_LDA(At, 1, 1); PG8_STAGE(PG8_SB(1, 0), b3, voffB); PG8_STAGE(PG8_SB(1, 1), b3 + hstep, voffB); PG8_STAGE(PG8_SA(1, 0), a3, voffA);
            PG8_WAIT_V(8); PG8_WAIT_L(0); PG8_BAR; PG8_MMA(1, 0, At, B0); PG8_MMA(1, 1, At, B1); PG8_BAR; PG8_SCHED;
            } else {
            PG8_LDB(B0, 0, 0); PG8_SCHED; PG8_LDA(At, 0, 0); PG8_STAGE(PG8_SA(1, 1), a1 + hstep, voffA);
            PG8_WAIT_L(8); PG8_BAR; PG8_WAIT_L(0); PG8_MMA(0, 0, At, B0); PG8_BAR; PG8_SCHED;
            PG8_LDB(B1, 0, 1); PG8_STAGE(PG8_SB(0, 0), b2, voffB);
            PG8_BAR; PG8_WAIT_L(0); PG8_MMA(0, 1, At, B1); PG8_BAR;
            PG8_LDA(At, 0, 1); PG8_STAGE(PG8_SA(0, 0), a2, voffA);
            PG8_BAR; PG8_WAIT_L(0); PG8_MMA(1, 0, At, B0); PG8_BAR; PG8_SCHED;
            PG8_STAGE(PG8_SB(0, 1), b2 + hstep, voffB);
            PG8_WAIT_V(6); PG8_BAR; PG8_MMA(1, 1, At, B1); PG8_BAR;
            PG8_LDB(B0, 1, 0); PG8_SCHED; PG8_LDA(At, 1, 0); PG8_STAGE(PG8_SA(0, 1), a2 + hstep, voffA);
            PG8_WAIT_L(8); PG8_BAR; PG8_WAIT_L(0); PG8_MMA(0, 0, At, B0); PG8_BAR; PG8_SCHED;
            PG8_LDB(B1, 1, 1); PG8_STAGE(PG8_SB(1, 0), b3, voffB);
            PG8_BAR; PG8_WAIT_L(0); PG8_MMA(0, 1, At, B1); PG8_BAR;
            PG8_LDA(At, 1, 1); PG8_STAGE(PG8_SA(1, 0), a3, voffA);
            PG8_BAR; PG8_WAIT_L(0); PG8_MMA(1, 0, At, B0); PG8_BAR; PG8_SCHED;
            PG8_STAGE(PG8_SB(1, 1), b3 + hstep, voffB);
            PG8_WAIT_V(6); PG8_BAR; PG8_MMA(1, 1, At, B1); PG8_BAR;
            }
        }
        if constexpr (ALIGN_EPI) { if (wr == 0) PG8_BAR; }
        E(acc, cur, wr, wc, fr, fq, xlds, ui);
        if (!has_next) break;
#pragma unroll
        for (int a = 0; a < 2; ++a)
#pragma unroll
            for (int b = 0; b < 2; ++b)
#pragma unroll
                for (int m = 0; m < 4; ++m)
#pragma unroll
                    for (int n = 0; n < 2; ++n) acc[a][b][m][n] = (f32x4){0.f, 0.f, 0.f, 0.f};
        cur = nxt; cA = nA; cB = nB; ++ui; nt = cur.nt;
        if constexpr (ALIGN_EPI) { if (wr == 1) PG8_BAR; }
    }
    PG8_WAIT_V(0);
    if constexpr (!ALIGN_EPI) { if (wr == 0) PG8_BAR; }
    PG8_BAR;
#undef PG8_SA
#undef PG8_SB
#undef PG8_STAGE
#undef PG8_LDA
#undef PG8_LDB
#undef PG8_MMA
#undef PG8_WAIT_V
#undef PG8_WAIT_L
#undef PG8_BAR
#undef PG8_SCHED
}
}
constexpr int NWAVES = 8;
constexpr int DM = 1024, NB_P = 16, SEQ = 2048, NB_S = 8, TS = 64, PAST = 1024, NH = 16, HD = 64, EW = 2048;
constexpr int MP = NB_P * SEQ, MS = NB_S * TS, MT = MP + MS;
constexpr int N1 = 4 * EW, N3 = 4352;
constexpr float RMS_EPS = 1e-6f, LOG2E = 1.4426950408889634f;
constexpr size_t O_Y = 0, O_CONVP = (size_t)MT * DM, O_KP = O_CONVP + (size_t)NB_P * 2 * EW, O_VP = O_KP + (size_t)MP * DM, O_LP = O_VP + (size_t)MP * DM,
                 O_CONVS = O_LP + (size_t)MP * NH, O_KS = O_CONVS + (size_t)NB_S * 2 * EW, O_VS = O_KS + (size_t)MS * DM, O_LS = O_VS + (size_t)MS * DM, O_END = O_LS + (size_t)MS * NH;
static_assert(O_END == 102866944, "output size");
constexpr size_t MiB = 1u << 20;
constexpr size_t WS_CTL = 0, CTL_ZERO_BYTES = 1 * MiB;
constexpr size_t WS_MOD = 128 * 1024, WS_CNT = 16 * 1024;
constexpr size_t WS_W1 = 1 * MiB, WS_W2 = 17 * MiB, WS_W3 = 21 * MiB, WS_W4 = 30 * MiB;
constexpr size_t WS_H = 32 * MiB;
constexpr size_t WS_Y = 98 * MiB;
constexpr size_t WS_Q = WS_Y, WS_K = WS_Y + 65 * MiB, WS_V = 228 * MiB, WS_Z = 293 * MiB, WS_SLAB = 358 * MiB  , WS_AO = 374 * MiB  , WS_X = 439 * MiB  , WS_X1 = 440 * MiB  , WS_END = 504 * MiB;
static_assert((size_t)MT * DM * 2 == 65 * MiB && WS_W3 + (size_t)N3 * DM * 2 <= WS_W4 && WS_W4 + 2 * MiB <= WS_H, "ws map");
constexpr int RING_BYTES = 131072, XL_OFF = RING_BYTES, LDS_BYTES = 155648;
#define LAS __attribute__((address_space(3)))
typedef unsigned short bf16;
typedef unsigned v4u __attribute__((ext_vector_type(4)));
typedef unsigned v2u __attribute__((ext_vector_type(2)));
typedef float f32x4 __attribute__((ext_vector_type(4)));
typedef short bf16x8 __attribute__((ext_vector_type(8)));
#define LDS_WAIT() asm volatile("s_waitcnt lgkmcnt(0)" ::: "memory")
__device__ __forceinline__ unsigned f2bf(float f) { unsigned u = __builtin_bit_cast(unsigned, f); return (u + 0x7fffu + ((u >> 16) & 1u)) >> 16; }
__device__ __forceinline__ unsigned pk2(float lo, float hi) { return f2bf(lo) | (f2bf(hi) << 16); }
__device__ __forceinline__ float wave_sum(float v) {
#pragma unroll
    for (int o = 1; o < 64; o <<= 1) v += __shfl_xor(v, o);
    return v;
}

template <int MODE> __device__ __forceinline__ void p0_transpose_item(const float* W, int K, int N, bf16* WT, LAS float* scr, int item, int lane) {
    const int nblk = (N + 63) / 64, kb = item / nblk, nb = item % nblk, k0 = 64 * kb, n0 = 64 * nb;
    const int ks = lane >> 4, n4 = (lane & 15) * 4, ncol = min(n0 + n4, N - 4);
    f32x4 v[16];
#pragma unroll
    for (int i = 0; i < 16; ++i) v[i] = __builtin_nontemporal_load((const f32x4*)(W + (size_t)(k0 + 4 * i + ks) * N + ncol));
#pragma unroll
    for (int i = 0; i < 16; ++i) { LAS float* d = scr + (4 * i + ks) * 65 + n4; d[0] = v[i].x; d[1] = v[i].y; d[2] = v[i].z; d[3] = v[i].w; }
    LDS_WAIT(); asm volatile("" ::: "memory");
    const int c = lane & 7;
#pragma unroll
    for (int j = 0; j < 8; ++j) { const int n = (lane >> 3) + 8 * j; const LAS float* s = scr + (8 * c) * 65 + n;
        v4u o; o.x = pk2(s[0 * 65], s[1 * 65]); o.y = pk2(s[2 * 65], s[3 * 65]); o.z = pk2(s[4 * 65], s[5 * 65]); o.w = pk2(s[6 * 65], s[7 * 65]);
        int drow = n0 + n;
        if (MODE == 1) { const int g = drow >> 11, e = drow & 2047, pn = e >> 6, ch = e & 63; drow = pn * 256 + (g >> 1) * 128 + (ch >> 4) * 32 + (g & 1) * 16 + (ch & 15); }
        *(v4u*)(WT + (size_t)drow * K + k0 + 8 * c) = o; }
    LDS_WAIT(); asm volatile("" ::: "memory");
}
__device__ __forceinline__ void ada_norm_row(const float* xrow, bf16* orow, const float* g, const float* mod, int lane, const float* slab = nullptr, const float* gate = nullptr, float* xst = nullptr) {
    const f32x4* xr = (const f32x4*)xrow + lane;
    f32x4 v[4]; float s = 0.f;
#pragma unroll
    for (int j = 0; j < 4; ++j) { v[j] = xr[64 * j];
        if (slab) { f32x4 p = ((const f32x4*)slab)[64 * j + lane];
#pragma unroll
            for (int q = 1; q < 8; ++q) p += ((const f32x4*)(slab + (size_t)q * 512 * 1024))[64 * j + lane];
            v[j] += ((const f32x4*)gate)[64 * j + lane] * p; ((f32x4*)xst)[64 * j + lane] = v[j]; }
        s += (v[j].x * v[j].x + v[j].y * v[j].y) + (v[j].z * v[j].z + v[j].w * v[j].w); }
    const float rstd = 1.f / sqrtf(wave_sum(s) * (1.f / DM) + RMS_EPS);
    unsigned long long* o8 = (unsigned long long*)orow + lane;
#pragma unroll
    for (int j = 0; j < 4; ++j) { const f32x4 gg = ((const f32x4*)g)[64 * j + lane], sh = ((const f32x4*)mod)[64 * j + lane], sc = ((const f32x4*)(mod + DM))[64 * j + lane];
        const f32x4 h = v[j] * rstd * gg * (sc + 1.0f) + sh;
        o8[64 * j] = (unsigned long long)pk2(h.x, h.y) | ((unsigned long long)pk2(h.z, h.w) << 32); }
}
__device__ __forceinline__ void ada_norm_rows(const float* x0, bf16* o0, int nrows, const float* g, const float* mod, int lane) {
    f32x4 gm[4], sh[4];
#pragma unroll
    for (int j = 0; j < 4; ++j) { gm[j] = ((const f32x4*)g)[64 * j + lane] * (((const f32x4*)(mod + DM))[64 * j + lane] + 1.0f); sh[j] = ((const f32x4*)mod)[64 * j + lane]; }
    f32x4 v[4], w[4];
#pragma unroll
    for (int j = 0; j < 4; ++j) v[j] = __builtin_nontemporal_load((const f32x4*)x0 + 64 * j + lane);
    for (int r = 0; r < nrows; ++r) {
        const float* xn = x0 + (size_t)(r + 1 < nrows ? r + 1 : r) * DM;
#pragma unroll
        for (int j = 0; j < 4; ++j) w[j] = __builtin_nontemporal_load((const f32x4*)xn + 64 * j + lane);
        float s = 0.f;
#pragma unroll
        for (int j = 0; j < 4; ++j) s += (v[j].x * v[j].x + v[j].y * v[j].y) + (v[j].z * v[j].z + v[j].w * v[j].w);
        const float rstd = 1.f / sqrtf(wave_sum(s) * (1.f / DM) + RMS_EPS);
        unsigned long long* o8 = (unsigned long long*)(o0 + (size_t)r * DM) + lane;
#pragma unroll
        for (int j = 0; j < 4; ++j) { const f32x4 h = v[j] * rstd * gm[j] + sh[j]; o8[64 * j] = (unsigned long long)pk2(h.x, h.y) | ((unsigned long long)pk2(h.z, h.w) << 32); v[j] = w[j]; }
    }
}
__device__ __forceinline__ void final_norm_row(float* xrow, const float* g, int lane, const float* slab = nullptr, const float* gate = nullptr) {
    f32x4* xr = (f32x4*)xrow + lane;
    f32x4 v[4]; float s = 0.f;
#pragma unroll
    for (int j = 0; j < 4; ++j) { v[j] = xr[64 * j];
        if (slab) { f32x4 p = ((const f32x4*)slab)[64 * j + lane];
#pragma unroll
            for (int q = 1; q < 8; ++q) p += ((const f32x4*)(slab + (size_t)q * 512 * 1024))[64 * j + lane];
            v[j] += ((const f32x4*)gate)[64 * j + lane] * p; }
        s += (v[j].x * v[j].x + v[j].y * v[j].y) + (v[j].z * v[j].z + v[j].w * v[j].w); }
    const float rstd = 1.f / sqrtf(wave_sum(s) * (1.f / DM) + RMS_EPS);
#pragma unroll
    for (int j = 0; j < 4; ++j) xr[64 * j] = v[j] * rstd * ((const f32x4*)g)[64 * j + lane];
}
__device__ __forceinline__ void block_scan4(f32x4 v, float* dst, LAS float* wtot, int tid, int nthr) {
    const int lane = tid & 63, wave = tid >> 6;
    v.y += v.x; v.z += v.y; v.w += v.z;
    float incl = v.w;
#pragma unroll
    for (int o = 1; o < 64; o <<= 1) { const float t = __builtin_bit_cast(float, __builtin_amdgcn_ds_bpermute((lane - o) << 2, __builtin_bit_cast(int, incl))); if (lane >= o) incl += t; }
    if (lane == 63) wtot[wave] = incl;
    LDS_WAIT(); __builtin_amdgcn_s_barrier(); asm volatile("" ::: "memory");
    float base = incl - v.w;
    for (int w = 0; w < wave; ++w) base += wtot[w];
    if (tid < nthr) *(f32x4*)(dst + 4 * tid) = (v + base) * (-LOG2E);
    LDS_WAIT(); __builtin_amdgcn_s_barrier(); asm volatile("" ::: "memory");
}
namespace attn_body {
using bf16=__hip_bfloat16;
using bf16x8=__attribute__((ext_vector_type(8)))short;
using s16x4=__attribute__((ext_vector_type(4)))short;
using f32x16=__attribute__((ext_vector_type(16)))float;
using u32x4=__attribute__((ext_vector_type(4)))unsigned;
using f32x4=__attribute__((ext_vector_type(4)))float;
constexpr int BATCH=16,NHEAD=16,SEQ=2048,D=64,DM=NHEAD*D;
constexpr int NW=8,QBLK=32,QB=QBLK*NW,KVBLK=64,NQB=SEQ/QB;
constexpr int ATTN_PITCH=DM, ATTN_UNIT_ROWS=QB;
__device__ __forceinline__ int crow(int r,int hi){return (r&3)+8*(r>>2)+4*hi;}
#define SBAR() __builtin_amdgcn_sched_barrier(0)
__device__ __forceinline__ void cmask(f32x16&p0,f32x16&p1,int jb,int qrel,int hi){
  const float NEG=-INFINITY; int kb=64*jb+4*hi;
  #pragma unroll
  for(int r=0;r<16;++r){int kv=kb+(r&3)+8*(r>>2); if(kv>qrel)p0[r]=NEG; if(kv+32>qrel)p1[r]=NEG;}
}

constexpr int NSLOT=3, SLOTB=8192;
constexpr int LDS_K=0, LDS_V=NSLOT*SLOTB, LDS_WS=2*NSLOT*SLOTB, LDS_OST=LDS_WS+NW*64*4, LDS_BYTES=LDS_OST+NW*4096;
constexpr float C2=0.125f*1.4426950408889634f;
__device__ __forceinline__ void glds16(const void*gsrc,unsigned lds_dst){unsigned keep;
  asm volatile("s_mov_b32 %0, m0\n\ts_mov_b32 m0, %2\n\ts_nop 0\n\tglobal_load_lds_dwordx4 %1, off\n\ts_mov_b32 m0, %0":"=&s"(keep):"v"(gsrc),"s"(lds_dst):"memory");}
__device__ __forceinline__ float max3f(float a,float b,float c){float r;asm("v_max3_f32 %0, %1, %2, %3":"=v"(r):"v"(a),"v"(b),"v"(c));return r;}
__device__ __forceinline__ float max2f(float a,float b){float r;asm("v_max_f32_e32 %0, %1, %2":"=v"(r):"v"(a),"v"(b));return r;}
__device__ __forceinline__ float fadd_s(float a,float b){float r;asm("v_add_f32_e32 %0, %1, %2":"=v"(r):"v"(a),"v"(b));return r;}
__device__ __forceinline__ float fsub_s(float a,float b){float r;asm("v_sub_f32_e32 %0, %1, %2":"=v"(r):"v"(a),"v"(b));return r;}
typedef float f32x2_t __attribute__((ext_vector_type(2))); typedef __bf16 bf16x2_t __attribute__((ext_vector_type(2)));
__device__ __forceinline__ unsigned cvtpk_s(float lo,float hi){f32x2_t v={lo,hi};bf16x2_t b=__builtin_convertvector(v,bf16x2_t);return __builtin_bit_cast(unsigned,b);}
#define WAIT_BAR(N) asm volatile("s_waitcnt vmcnt(" #N ") lgkmcnt(0)\n\ts_barrier":::"memory")

__device__ __forceinline__ void qkt(f32x16&p0,f32x16&p1,const char*Kslot,const bf16x8*qr,int r32,int hi){
  const char*kb=Kslot+hi*1024+r32*16;
  #pragma unroll
  for(int d0=0;d0<4;++d0){
    const bf16x8 b0=*reinterpret_cast<const bf16x8*>(kb+d0*2048);
    const bf16x8 b1=*reinterpret_cast<const bf16x8*>(kb+d0*2048+512);
    {p0=__builtin_amdgcn_mfma_f32_32x32x16_bf16(b0,qr[d0],p0,0,0,0);p1=__builtin_amdgcn_mfma_f32_32x32x16_bf16(b1,qr[d0],p1,0,0,0);}}
}
typedef __attribute__((address_space(3))) const char* lds_cptr;
typedef short v4i16_t __attribute__((ext_vector_type(4)));
__device__ __forceinline__ void kload8(bf16x8*kf,lds_cptr kp){
  kf[0]=*(const __attribute__((address_space(3))) bf16x8*)(kp);      kf[1]=*(const __attribute__((address_space(3))) bf16x8*)(kp+512);
  kf[2]=*(const __attribute__((address_space(3))) bf16x8*)(kp+2048); kf[3]=*(const __attribute__((address_space(3))) bf16x8*)(kp+2560);
  kf[4]=*(const __attribute__((address_space(3))) bf16x8*)(kp+4096); kf[5]=*(const __attribute__((address_space(3))) bf16x8*)(kp+4608);
  kf[6]=*(const __attribute__((address_space(3))) bf16x8*)(kp+6144); kf[7]=*(const __attribute__((address_space(3))) bf16x8*)(kp+6656);
}
__device__ __forceinline__ void kload2(bf16x8*kf,lds_cptr kp,int j){ kf[2*j]=*(const __attribute__((address_space(3))) bf16x8*)(kp+j*2048); kf[2*j+1]=*(const __attribute__((address_space(3))) bf16x8*)(kp+j*2048+512); }
__device__ __forceinline__ s16x4 vtr(lds_cptr p){ return __builtin_bit_cast(s16x4,__builtin_amdgcn_ds_read_tr16_b64_v4i16((__attribute__((address_space(3))) v4i16_t*)p)); }
__device__ __forceinline__ float rowmax(const f32x16&p0,const f32x16&p1){
  float a=max3f(p0[0],p0[1],p1[0]),b=max3f(p0[2],p0[3],p1[1]);a=max3f(a,p1[2],p1[3]);
  #pragma unroll
  for(int r=4;r<16;r+=4){a=max3f(a,p0[r],p0[r+1]);b=max3f(b,p0[r+2],p0[r+3]);a=max3f(a,p1[r],p1[r+1]);b=max3f(b,p1[r+2],p1[r+3]);}
  const float m=max2f(a,b);
  auto rr=__builtin_amdgcn_permlane32_swap(__float_as_uint(m),__float_as_uint(m),false,false);
  return max2f(__uint_as_float(rr[0]),__uint_as_float(rr[1]));
}
__device__ __forceinline__ void pv(f32x16*o,int vb,bf16x8 pa0,bf16x8 pa1,bf16x8 pa2,bf16x8 pa3){
  #pragma unroll
  for(int d0=0;d0<2;++d0){s16x4 lo[4],hi[4];
    #pragma unroll
    for(int ks=0;ks<4;++ks){
      asm volatile("ds_read_b64_tr_b16 %0,%1 offset:%c2":"=&v"(lo[ks]):"v"(vb),"i"(d0*4096+ks*1024):"memory");
      asm volatile("ds_read_b64_tr_b16 %0,%1 offset:%c2":"=&v"(hi[ks]):"v"(vb),"i"(d0*4096+ks*1024+512):"memory");}
    asm volatile("s_waitcnt lgkmcnt(0)":::"memory");SBAR();
    #define PK(k) (bf16x8){lo[k][0],lo[k][1],lo[k][2],lo[k][3],hi[k][0],hi[k][1],hi[k][2],hi[k][3]}
    o[d0]=__builtin_amdgcn_mfma_f32_32x32x16_bf16(pa0,PK(0),o[d0],0,0,0);
    o[d0]=__builtin_amdgcn_mfma_f32_32x32x16_bf16(pa1,PK(1),o[d0],0,0,0);
    o[d0]=__builtin_amdgcn_mfma_f32_32x32x16_bf16(pa2,PK(2),o[d0],0,0,0);
    o[d0]=__builtin_amdgcn_mfma_f32_32x32x16_bf16(pa3,PK(3),o[d0],0,0,0);
    #undef PK
  }
}

#ifndef ATTN_STORE16
#define ATTN_STORE16(p,v) (*(u32x4*)(p)=(v))
#endif
template<int THRL> __device__ __forceinline__ void attn_unit(int b,int h,int qb,const bf16*Q,const bf16*__restrict__ K,const bf16*__restrict__ V,const bf16*__restrict__ Zs,bf16*O,char*shm,const float*biasL,float*Kf,float*Vf){
  int tid=threadIdx.x; asm volatile("":"+v"(tid)); const int lane=tid&63,r32=lane&31,hi=lane>>5; const int wid=__builtin_amdgcn_readfirstlane(tid>>6);
  const long rowbase=(long)b*SEQ; const int q0=qb*QB;
  const bf16*Qw=Q+(rowbase+q0+wid*QBLK)*DM+h*D;
  const bf16*Kh=K+rowbase*DM+h*D,*Vh=V+rowbase*DM+h*D;
  const unsigned lds0=(unsigned)(uintptr_t)shm;
  float*wsf=(float*)(shm+LDS_WS)+wid*64;
  const bf16*ksrc=Kh+(long)lane*DM+wid*8;
  const bf16*vsrc=Vh+(long)(16*(wid&3)+(lane>>2))*DM+(wid>>2)*32+(lane&3)*8;
  const unsigned kdst=lds0+LDS_K+wid*1024, vdst=lds0+LDS_V+wid*1024;
  #define DMA_K(t,slot) glds16(ksrc+(long)(t)*KVBLK*DM,(unsigned)__builtin_amdgcn_readfirstlane(kdst+(slot)))
  #define DMA_V(t,slot) glds16(vsrc+(long)(t)*KVBLK*DM,(unsigned)__builtin_amdgcn_readfirstlane(vdst+(slot)))
  const int vb0=(int)(lds0+LDS_V)+((lane>>4)&1)*32+(lane&3)*8+(4*hi+((lane&15)>>2))*64;
  const char*Kbase=shm+LDS_K; bf16x8 kf[8];
  const lds_cptr shm3=(lds_cptr)shm; const lds_cptr kp0=shm3+LDS_K+hi*1024+r32*16; const lds_cptr vp0=shm3+LDS_V+((lane>>4)&1)*32+(lane&3)*8+(4*hi+((lane&15)>>2))*64;
  const int NT=(q0+QB)/KVBLK;
  DMA_K(0,0);DMA_V(0,0);DMA_K(1,SLOTB);
  bf16x8 qr[4];
  #pragma unroll
  for(int d0=0;d0<4;++d0)qr[d0]=*reinterpret_cast<const bf16x8*>(&Qw[(long)r32*DM+d0*16+hi*8]);
  float mhat=0.f,l_reg=0.f;f32x16 o[2];o[0]=f32x16{};o[1]=f32x16{};
  const int qrel=wid*QBLK+r32;
  #define BINITH(X,t,off) do{ const float*bp_=biasL+(t)*KVBLK+4*hi+(off); \
    _Pragma("unroll") for(int j_=0;j_<4;++j_){ const f32x4 a_=*(const f32x4*)(bp_+8*j_); \
      _Pragma("unroll") for(int i_=0;i_<4;++i_){ X[4*j_+i_]=a_[i_]-mhat; } } }while(0)
  #define BINIT(X0,X1,t) do{ BINITH(X0,t,0); BINITH(X1,t,32); }while(0)
  #define CMASK(P0,P1,t) do{int jb_=(t)-(NT-4); if(jb_>=0)cmask(P0,P1,jb_,qrel,hi);}while(0)
  bool resc=false;
  #define START(P0,P1) do{ const float rm=rowmax(P0,P1); resc=false; \
    { const float dl=rm; mhat=fadd_s(mhat,dl); \
      _Pragma("unroll") for(int r=0;r<16;++r){P0[r]=fsub_s(P0[r],dl);P1[r]=fsub_s(P1[r],dl);} \
      } \
    _Pragma("unroll") for(int r=0;r<16;++r)P0[r]=__builtin_amdgcn_exp2f(P0[r]); }while(0)
  #define RESC() do{ if(resc){ asm volatile("s_waitcnt lgkmcnt(0)":::"memory"); \
      _Pragma("unroll") for(int d_=0;d_<2;++d_) _Pragma("unroll") for(int r=0;r<16;++r)o[d_][r]*=wsf[crow(r,hi)]; } }while(0)
  f32x16 pA0,pA1,pB0,pB1;
  int sl_prev=0,sl_cur=0,sl_next=SLOTB;
  #define ROT() do{sl_prev=sl_cur;sl_cur=sl_next;sl_next=(sl_next==(NSLOT-1)*SLOTB)?0:sl_next+SLOTB;}while(0)
  DMA_K(2,2*SLOTB);
  WAIT_BAR(3);
  BINIT(pA0,pA1,0); qkt(pA0,pA1,Kbase,qr,r32,hi);asm volatile("s_nop 15\n\ts_nop 7":"+v"(pA0),"+v"(pA1));CMASK(pA0,pA1,0);
  START(pA0,pA1);
  BINIT(pB0,pB1,1);
  _Pragma("unroll") for(int r=0;r<16;++r)pA1[r]=__builtin_amdgcn_exp2f(pA1[r]);
  WAIT_BAR(0);
  DMA_K(3,0);DMA_V(1,SLOTB);
  ROT();
  kload8(kf,kp0+sl_cur);
  WAIT_BAR(2);
  s16x4 vlo[8],vhi[8]; u32x4 pw0,pw1,pw2,pw3;
  #define PKW(P,B) cvtpk_s(P[B],P[B+1])
  #define PAF(k) __builtin_bit_cast(bf16x8,pw##k)
  #define VFR(i) (bf16x8){vlo[i][0],vlo[i][1],vlo[i][2],vlo[i][3],vhi[i][0],vhi[i][1],vhi[i][2],vhi[i][3]}
  #define PIN(x) asm volatile("":"+v"(x))
  #define MX3(a,b,c) __builtin_fmaxf(__builtin_fmaxf((a),(b)),(c))
  #define GAPA(MF,A0,A1,A2,A3,W0,W1,PW) do{ MF; sacc+=A0; sacc+=A1; sacc+=A2; sacc+=A3; PIN(sacc); W0; W1; PIN(PW); SBAR(); }while(0)
  #define EX(v) __builtin_amdgcn_exp2f(v)
  #define GAPB(MF,X,B,GN,Y) do{ MF; X[B]=EX(X[B]); X[B+1]=EX(X[B+1]); X[B+2]=EX(X[B+2]); X[B+3]=EX(X[B+3]); PIN(X); if(GN){ Y[B]-=mhat; Y[B+1]-=mhat; Y[B+2]-=mhat; Y[B+3]-=mhat; PIN(Y); } SBAR(); }while(0)
  #define BLOAD(X0,X1,t) do{ const float*bp_=biasL+(t)*KVBLK+4*hi; \
    _Pragma("unroll") for(int j_=0;j_<4;++j_){ const f32x4 a_=*(const f32x4*)(bp_+8*j_), b_=*(const f32x4*)(bp_+32+8*j_); \
      _Pragma("unroll") for(int i_=0;i_<4;++i_){ X0[4*j_+i_]=a_[i_]; X1[4*j_+i_]=b_[i_]; } } }while(0)
  #define VRD(i) do{ vlo[i]=vtr(vp_+(((i)>>2)*4096+((i)&3)*1024)); vhi[i]=vtr(vp_+(((i)>>2)*4096+((i)&3)*1024+512)); }while(0)
  #define KRD(G,j) do{ if(G){ kload2(kf,kp0+sl_next,j); SBAR(); } }while(0)
  #define STEP(C0,C1,P0,P1,t,GK,GV,GL) do{ SBAR(); \
    const lds_cptr vp_=vp0+sl_prev; \
    VRD(0); SBAR(); float sacc=(P0[0]+P0[1]); \
    GAPA(C0=__builtin_amdgcn_mfma_f32_32x32x16_bf16(kf[0],qr[0],C0,0,0,0), P0[2],P0[3],P0[4],P0[5],     pw0[0]=PKW(P0,0), pw0[1]=PKW(P0,2), pw0); \
    VRD(4); SBAR(); GAPA(C1=__builtin_amdgcn_mfma_f32_32x32x16_bf16(kf[1],qr[0],C1,0,0,0), P0[6],P0[7],P0[8],P0[9],     pw0[2]=PKW(P0,4), pw0[3]=PKW(P0,6), pw0); \
    VRD(1); SBAR(); GAPA(C0=__builtin_amdgcn_mfma_f32_32x32x16_bf16(kf[2],qr[1],C0,0,0,0),   P0[10],P0[11],P0[12],P0[13], pw1[0]=PKW(P0,8), pw1[1]=PKW(P0,10), pw1); \
    VRD(5); SBAR(); GAPA(C1=__builtin_amdgcn_mfma_f32_32x32x16_bf16(kf[3],qr[1],C1,0,0,0),   P0[14],P0[15],P1[0],P1[1],   pw1[2]=PKW(P0,12),pw1[3]=PKW(P0,14), pw1); \
    VRD(2); SBAR(); GAPA(C0=__builtin_amdgcn_mfma_f32_32x32x16_bf16(kf[4],qr[2],C0,0,0,0),   P1[2],P1[3],P1[4],P1[5],     pw2[0]=PKW(P1,0), pw2[1]=PKW(P1,2), pw2); \
    VRD(6); SBAR(); GAPA(C1=__builtin_amdgcn_mfma_f32_32x32x16_bf16(kf[5],qr[2],C1,0,0,0),   P1[6],P1[7],P1[8],P1[9],     pw2[2]=PKW(P1,4), pw2[3]=PKW(P1,6), pw2); \
    VRD(3); SBAR(); GAPA(C0=__builtin_amdgcn_mfma_f32_32x32x16_bf16(kf[6],qr[3],C0,0,0,0),   P1[10],P1[11],P1[12],P1[13], pw3[0]=PKW(P1,8), pw3[1]=PKW(P1,10), pw3); \
    VRD(7); SBAR(); GAPA(C1=__builtin_amdgcn_mfma_f32_32x32x16_bf16(kf[7],qr[3],C1,0,0,0),   P1[14],P1[15],0.f,0.f,       pw3[2]=PKW(P1,12),pw3[3]=PKW(P1,14), pw3); \
    l_reg+=sacc; \
    if(GK){DMA_K((t)+3,sl_cur);} if(GV){DMA_V((t)+1,sl_next);} \
    CMASK(C0,C1,t); \
    { float a=MX3(C0[0],C0[1],C1[0]),b=MX3(C0[2],C0[3],C1[1]); a=MX3(a,C1[2],C1[3]); \
      _Pragma("unroll") for(int r=4;r<16;r+=4){a=MX3(a,C0[r],C0[r+1]);b=MX3(b,C0[r+2],C0[r+3]);a=MX3(a,C1[r],C1[r+1]);b=MX3(b,C1[r+2],C1[r+3]);} \
      float rm=__builtin_fmaxf(a,b); { auto rr=__builtin_amdgcn_permlane32_swap(__float_as_uint(rm),__float_as_uint(rm),false,false); rm=__builtin_fmaxf(__uint_as_float(rr[0]),__uint_as_float(rr[1])); } \
      resc=false; \
      if(__builtin_expect(__any(rm>(float)THRL),0)){ const float dl=__builtin_fmaxf(rm,0.f); mhat+=dl; \
        _Pragma("unroll") for(int r=0;r<16;++r){C0[r]-=dl;C1[r]-=dl;} \
        const float f=__builtin_amdgcn_exp2f(-dl); l_reg*=f; if(hi==0)wsf[r32]=f; resc=true; } } \
    SBAR(); if(GL){ BLOAD(P0,P1,(t)+1); } SBAR(); \
    GAPB(o[0]=__builtin_amdgcn_mfma_f32_32x32x16_bf16(PAF(0),VFR(0),o[0],0,0,0), C0,0,GL,P0); \
    GAPB(o[1]=__builtin_amdgcn_mfma_f32_32x32x16_bf16(PAF(0),VFR(4),o[1],0,0,0), C0,4,GL,P0); \
    KRD(GL,0); GAPB(o[0]=__builtin_amdgcn_mfma_f32_32x32x16_bf16(PAF(1),VFR(1),o[0],0,0,0), C0,8,GL,P0); \
    KRD(GL,1); GAPB(o[1]=__builtin_amdgcn_mfma_f32_32x32x16_bf16(PAF(1),VFR(5),o[1],0,0,0), C0,12,GL,P0); \
    KRD(GL,2); GAPB(o[0]=__builtin_amdgcn_mfma_f32_32x32x16_bf16(PAF(2),VFR(2),o[0],0,0,0), C1,0,GL,P1); \
    KRD(GL,3); GAPB(o[1]=__builtin_amdgcn_mfma_f32_32x32x16_bf16(PAF(2),VFR(6),o[1],0,0,0), C1,4,GL,P1); \
    GAPB(o[0]=__builtin_amdgcn_mfma_f32_32x32x16_bf16(PAF(3),VFR(3),o[0],0,0,0), C1,8,GL,P1); \
    GAPB(o[1]=__builtin_amdgcn_mfma_f32_32x32x16_bf16(PAF(3),VFR(7),o[1],0,0,0), C1,12,GL,P1); \
    }while(0)
  int t=1;
  #undef CMASK
  #define CMASK(P0,P1,t) do{}while(0)
  for(;t+5<NT;t+=2){
    STEP(pB0,pB1,pA0,pA1,t,true,true,true);     WAIT_BAR(2); RESC(); ROT();
    STEP(pA0,pA1,pB0,pB1,t+1,true,true,true);   WAIT_BAR(2); RESC(); ROT();
  }
  #undef CMASK
  #define CMASK(P0,P1,t) do{int jb_=(t)-(NT-4); if(jb_>=0)cmask(P0,P1,jb_,qrel,hi);}while(0)
  #define ENDW(tt) do{ if((tt)+3<NT){WAIT_BAR(2);} else if((tt)+2<NT){WAIT_BAR(1);} else {WAIT_BAR(0);} }while(0)
  for(;t+1<NT;t+=2){
    STEP(pB0,pB1,pA0,pA1,t,(t+3<NT),(t+1<NT),(t+1<NT));       ENDW(t);   RESC(); ROT();
    STEP(pA0,pA1,pB0,pB1,t+1,(t+4<NT),(t+2<NT),(t+2<NT));     ENDW(t+1); RESC(); ROT();
  }
  STEP(pB0,pB1,pA0,pA1,NT-1,false,false,false); RESC();
  u32x4 kcv[4],vcv[4]; { const bf16*Kw=K+(rowbase+q0+wid*QBLK)*DM+h*D; const bf16*Vw=V+(rowbase+q0+wid*QBLK)*DM+h*D;
    _Pragma("unroll") for(int i=0;i<4;++i){ const int row=i*8+(lane>>3),ch=lane&7; kcv[i]=*(const u32x4*)(Kw+(long)row*DM+ch*8); vcv[i]=*(const u32x4*)(Vw+(long)row*DM+ch*8); } }
  u32x4 zpre[4]; { const bf16*Zw=Zs+(rowbase+q0+wid*QBLK)*DM+h*D;
    _Pragma("unroll") for(int i=0;i<4;++i){ const int row=i*8+(lane>>3),ch=lane&7; zpre[i]=*(const u32x4*)(Zw+(long)row*DM+ch*8); } }
  { float sacc=pB0[0]+pB0[1]; _Pragma("unroll") for(int r=2;r<16;++r)sacc+=pB0[r]; _Pragma("unroll") for(int r=0;r<16;++r)sacc+=pB1[r]; l_reg+=sacc;
    pw0=(u32x4){PKW(pB0,0),PKW(pB0,2),PKW(pB0,4),PKW(pB0,6)};pw1=(u32x4){PKW(pB0,8),PKW(pB0,10),PKW(pB0,12),PKW(pB0,14)};pw2=(u32x4){PKW(pB1,0),PKW(pB1,2),PKW(pB1,4),PKW(pB1,6)};pw3=(u32x4){PKW(pB1,8),PKW(pB1,10),PKW(pB1,12),PKW(pB1,14)};
    SBAR(); pv(o,vb0+sl_cur,PAF(0),PAF(1),PAF(2),PAF(3)); }
  #undef PKW
  #undef PAF
  #undef VFR
  #undef PIN
  #undef MX3
  #undef GAPA
  #undef GAPB
  #undef BLOAD
  #undef EX
  #undef VRD
  #undef KRD
  #undef STEP
  #undef ENDW
  {auto rr=__builtin_amdgcn_permlane32_swap(__float_as_uint(l_reg),__float_as_uint(l_reg),false,false);l_reg=__uint_as_float(rr[0])+__uint_as_float(rr[1]);}
  if(hi==0)wsf[32+r32]=l_reg;asm volatile("s_waitcnt lgkmcnt(0)":::"memory");
  float rli[16];
  #pragma unroll
  for(int r=0;r<16;++r)rli[r]=__builtin_amdgcn_rcpf(wsf[32+crow(r,hi)]);
  bf16*Ow=O+(rowbase+q0+wid*QBLK)*DM+h*D;
  { bf16*stg=(bf16*)(shm+LDS_OST)+wid*2048;
    #pragma unroll
    for(int r=0;r<16;++r){const int orow=crow(r,hi);
      #pragma unroll
      for(int d0=0;d0<2;++d0)stg[orow*64+d0*32+r32]=__float2bfloat16(o[d0][r]*rli[r]);}
    asm volatile("s_waitcnt lgkmcnt(0)":::"memory");
    int lane_e=lane; asm volatile("":"+v"(lane_e));
    #pragma unroll
    for(int i=0;i<4;++i){const int lane=lane_e; const bf16*Zw=Zs+(rowbase+q0+wid*QBLK)*DM+h*D; const int row=i*8+(lane>>3),ch=lane&7; const u32x4 v=*(const u32x4*)(stg+row*64+ch*8); const u32x4 z=zpre[i]; u32x4 w;
      _Pragma("unroll") for(int e=0;e<4;++e){ const float a0=__uint_as_float(v[e]<<16)*__uint_as_float(z[e]<<16), a1=__uint_as_float(v[e]&0xffff0000u)*__uint_as_float(z[e]&0xffff0000u); w[e]=cvtpk_s(a0,a1); }
      ATTN_STORE16(Ow+(long)row*DM+ch*8,w);
      { float*kd=Kf+(rowbase+q0+wid*QBLK+row)*DM+h*D+ch*8; float*vd=Vf+(rowbase+q0+wid*QBLK+row)*DM+h*D+ch*8; const u32x4 kw=kcv[i],vw=vcv[i];
        __builtin_nontemporal_store((f32x4){__uint_as_float(kw[0]<<16),__uint_as_float(kw[0]&0xffff0000u),__uint_as_float(kw[1]<<16),__uint_as_float(kw[1]&0xffff0000u)},(f32x4*)kd);
        __builtin_nontemporal_store((f32x4){__uint_as_float(kw[2]<<16),__uint_as_float(kw[2]&0xffff0000u),__uint_as_float(kw[3]<<16),__uint_as_float(kw[3]&0xffff0000u)},(f32x4*)(kd+4));
        __builtin_nontemporal_store((f32x4){__uint_as_float(vw[0]<<16),__uint_as_float(vw[0]&0xffff0000u),__uint_as_float(vw[1]<<16),__uint_as_float(vw[1]&0xffff0000u)},(f32x4*)vd);
        __builtin_nontemporal_store((f32x4){__uint_as_float(vw[2]<<16),__uint_as_float(vw[2]&0xffff0000u),__uint_as_float(vw[3]<<16),__uint_as_float(vw[3]&0xffff0000u)},(f32x4*)(vd+4)); } } }
  asm volatile("s_waitcnt lgkmcnt(0)\n\ts_barrier":::"memory");
  #undef DMA_K
  #undef DMA_V
  #undef CMASK
  #undef START
  #undef RESC
  #undef BINIT
  #undef BINITH
  #undef ROT
}
constexpr int ATTN_LDS_BYTES=LDS_BYTES;
__device__ __forceinline__ void sample_unit(int b,int h,int qblk,const bf16*Q,const bf16*Kb,const bf16*Vb,const bf16*Zs,bf16*O,
    const float*__restrict__ ck,const float*__restrict__ cv,const float*__restrict__ clf,const float*__restrict__ lfs,char*shm){
  int tid=threadIdx.x; asm volatile("":"+v"(tid)); const int lane=tid&63,r32=lane&31,hi=lane>>5; const int wid=__builtin_amdgcn_readfirstlane(tid>>6);
  constexpr int S_V=0,S_O=65536,S_ML=131072,S_BIAS=133120,S_WT=137728; constexpr long SROW0=32768;
  float*biasS=(float*)(shm+S_BIAS);
  { f32x4 v=(f32x4){0.f,0.f,0.f,0.f};
    if(tid<272){
      #pragma unroll
      for(int i=0;i<4;++i){const int p=4*tid+i; v[i]= p<1024 ? clf[((size_t)b*1024+p)*16+h] : lfs[((size_t)b*64+(p-1024))*16+h];} }
    block_scan4(v,biasS,(LAS float*)(shm+S_WT),tid,272); }
  const bf16*Qw=Q+(SROW0+b*64+qblk*32)*DM+h*D;
  bf16x8 qr[4];
  #pragma unroll
  for(int d0=0;d0<4;++d0)qr[d0]=*reinterpret_cast<const bf16x8*>(&Qw[(long)r32*DM+d0*16+hi*8]);
  f32x16 P[3][2];
  #define SU_BIAS(acc,t,hf) do{ const float*bp=biasS+64*(t)+32*(hf)+4*hi; \
      _Pragma("unroll") for(int j=0;j<4;++j){ const f32x4 a=*(const f32x4*)(bp+8*j); _Pragma("unroll") for(int e=0;e<4;++e)acc[4*j+e]=a[e]; } }while(0)
  #pragma unroll
  for(int i=0;i<2;++i){ const int t=wid+8*i;
    #pragma unroll
    for(int hf=0;hf<2;++hf){
      bf16x8 kf[4];
      const float*kp=ck+(((size_t)b*1024+64*t+32*hf+r32)*16+h)*64+hi*8;
      #pragma unroll
      for(int d0=0;d0<4;++d0){ const f32x4 a=*(const f32x4*)(kp+d0*16),c=*(const f32x4*)(kp+d0*16+4);
        u32x4 w; w[0]=cvtpk_s(a[0],a[1]); w[1]=cvtpk_s(a[2],a[3]); w[2]=cvtpk_s(c[0],c[1]); w[3]=cvtpk_s(c[2],c[3]); kf[d0]=__builtin_bit_cast(bf16x8,w);}
      f32x16 acc; SU_BIAS(acc,t,hf);
      #pragma unroll
      for(int d0=0;d0<4;++d0)acc=__builtin_amdgcn_mfma_f32_32x32x16_bf16(kf[d0],qr[d0],acc,0,0,0);
      P[i][hf]=acc; } }
  if(wid==0){
    #pragma unroll
    for(int hf=0;hf<2;++hf){
      bf16x8 kf[4]; const bf16*kp=Kb+(SROW0+b*64+32*hf+r32)*DM+h*D+hi*8;
      #pragma unroll
      for(int d0=0;d0<4;++d0)kf[d0]=*reinterpret_cast<const bf16x8*>(kp+d0*16);
      f32x16 acc; SU_BIAS(acc,16,hf);
      #pragma unroll
      for(int d0=0;d0<4;++d0)acc=__builtin_amdgcn_mfma_f32_32x32x16_bf16(kf[d0],qr[d0],acc,0,0,0);
      #pragma unroll
      for(int r=0;r<16;++r){ if(crow(r,hi)+32*hf>32*qblk+r32)acc[r]=-INFINITY; }
      P[2][hf]=acc; }
  } else {
    #pragma unroll
    for(int hf=0;hf<2;++hf){
      #pragma unroll
      for(int r=0;r<16;++r)P[2][hf][r]=-INFINITY; }
  }
  #undef SU_BIAS
  float m=-INFINITY;
  #pragma unroll
  for(int i=0;i<3;++i){
    #pragma unroll
    for(int hf=0;hf<2;++hf){
      #pragma unroll
      for(int r=0;r<16;++r)m=fmaxf(m,P[i][hf][r]); } }
  m=fmaxf(m,__shfl_xor(m,32));
  float l=0.f;
  #pragma unroll
  for(int i=0;i<3;++i){
    #pragma unroll
    for(int hf=0;hf<2;++hf){
      #pragma unroll
      for(int r=0;r<16;++r){ const float p=__builtin_amdgcn_exp2f(P[i][hf][r]-m); P[i][hf][r]=p; l+=p; } } }
  l+=__shfl_xor(l,32);
  f32x16 o[2]; o[0]=f32x16{}; o[1]=f32x16{};
  const unsigned lds0=(unsigned)(uintptr_t)shm;
  char*vslot=shm+S_V+wid*8192;
  const int vb=(int)(lds0+S_V+wid*8192)+((lane>>4)&1)*32+(lane&3)*8+(4*hi+((lane&15)>>2))*64;
  #pragma unroll
  for(int i=0;i<3;++i){ const int t=wid+8*i;
    if(i<2||wid==0){
      #pragma unroll
      for(int j=0;j<8;++j){ const int k=8*j+(lane>>3),c8=lane&7; u32x4 w;
        if(i<2){ const float*vp=cv+(((size_t)b*1024+64*t+k)*16+h)*64+c8*8; const f32x4 a=*(const f32x4*)vp,c=*(const f32x4*)(vp+4);
          w[0]=cvtpk_s(a[0],a[1]); w[1]=cvtpk_s(a[2],a[3]); w[2]=cvtpk_s(c[0],c[1]); w[3]=cvtpk_s(c[2],c[3]); }
        else{ w=*reinterpret_cast<const u32x4*>(Vb+(SROW0+b*64+k)*DM+h*D+c8*8); }
        *reinterpret_cast<u32x4*>(vslot+(((c8>>2)*4+(k>>4))*1024+(k&15)*64+(c8&3)*16))=w; }
      asm volatile("s_waitcnt lgkmcnt(0)":::"memory");
      u32x4 pw0,pw1,pw2,pw3;
      #define PKW(X,B) cvtpk_s(X[B],X[B+1])
      pw0=(u32x4){PKW(P[i][0],0),PKW(P[i][0],2),PKW(P[i][0],4),PKW(P[i][0],6)}; pw1=(u32x4){PKW(P[i][0],8),PKW(P[i][0],10),PKW(P[i][0],12),PKW(P[i][0],14)};
      pw2=(u32x4){PKW(P[i][1],0),PKW(P[i][1],2),PKW(P[i][1],4),PKW(P[i][1],6)}; pw3=(u32x4){PKW(P[i][1],8),PKW(P[i][1],10),PKW(P[i][1],12),PKW(P[i][1],14)};
      #undef PKW
      SBAR(); pv(o,vb,__builtin_bit_cast(bf16x8,pw0),__builtin_bit_cast(bf16x8,pw1),__builtin_bit_cast(bf16x8,pw2),__builtin_bit_cast(bf16x8,pw3)); SBAR();
    }
  }
  { float*Op=(float*)(shm+S_O)+wid*2048;
    #pragma unroll
    for(int d0=0;d0<2;++d0){
      #pragma unroll
      for(int r=0;r<16;++r)Op[crow(r,hi)*64+d0*32+r32]=o[d0][r]; }
    float*ml=(float*)(shm+S_ML)+wid*64; if(hi==0){ml[r32]=m;ml[32+r32]=l;} }
  asm volatile("s_waitcnt lgkmcnt(0)\n\ts_barrier":::"memory");
  { const int q=tid>>4,d4=(tid&15)*4; const float*mlb=(const float*)(shm+S_ML); const float*Ob=(const float*)(shm+S_O);
    float M=-INFINITY;
    #pragma unroll
    for(int w=0;w<8;++w)M=fmaxf(M,mlb[w*64+q]);
    f32x4 num=(f32x4){0.f,0.f,0.f,0.f}; float den=0.f;
    #pragma unroll
    for(int w=0;w<8;++w){ const float f=__builtin_amdgcn_exp2f(mlb[w*64+q]-M); den+=f*mlb[w*64+32+q]; num+=*(const f32x4*)(Ob+w*2048+q*64+d4)*f; }
    const float inv=1.0f/den; const long row=SROW0+b*64+qblk*32+q;
    typedef unsigned u32x2_t __attribute__((ext_vector_type(2)));
    const u32x2_t z=*reinterpret_cast<const u32x2_t*>(Zs+row*DM+h*D+d4); u32x2_t w;
    w[0]=cvtpk_s(num[0]*inv*__uint_as_float(z[0]<<16),num[1]*inv*__uint_as_float(z[0]&0xffff0000u));
    w[1]=cvtpk_s(num[2]*inv*__uint_as_float(z[1]<<16),num[3]*inv*__uint_as_float(z[1]&0xffff0000u));
    *reinterpret_cast<u32x2_t*>(O+row*DM+h*D+d4)=w; }
  asm volatile("s_waitcnt lgkmcnt(0)\n\ts_barrier":::"memory");
}
#undef SBAR
#undef WAIT_BAR
}
typedef __attribute__((address_space(1))) unsigned gu32;
#define XB_TMO      128
#define XB_XCNT(j)  (256  + 64 * (j))
#define XB_XSUB(j)  (1280 + 64 * (j))
#define XB_XGEN(j)  (2304 + 64 * (j))
#define XB_TOP      3328
#define XB_TOPGEN   3392
#define XCD_BAR_WORDS 3456
#define XB_SPIN_CAP (1u << 18)

__device__ __forceinline__ unsigned xb_ld(unsigned* p)              { return __hip_atomic_load(p, __ATOMIC_RELAXED, __HIP_MEMORY_SCOPE_AGENT); }
__device__ __forceinline__ unsigned xb_add(unsigned* p, unsigned v) { return __hip_atomic_fetch_add(p, v, __ATOMIC_RELAXED, __HIP_MEMORY_SCOPE_AGENT); }
__device__ __forceinline__ unsigned xb_xcc_id() { return (unsigned)__builtin_amdgcn_s_getreg((3 << 11) | 20) & 0xFu; }
#define XB_SPIN(cond, bar) do { unsigned _sp = 0; while (cond) { __builtin_amdgcn_s_sleep(1); \
    if ((++_sp & 255u) == 0u) { if (xb_ld(&(bar)[XB_TMO])) break; if (_sp > XB_SPIN_CAP) { atomicAdd(&(bar)[XB_TMO], 1u); break; } } } } while (0)

struct XcdBarrier {
    unsigned* bar; unsigned x;
    volatile LAS unsigned* st;
};

__device__ __forceinline__ XcdBarrier xcd_barrier_post(unsigned* bar, volatile LAS unsigned* st) {
    XcdBarrier b; b.bar = bar; b.x = xb_xcc_id(); b.st = st;
    if (threadIdx.x == 0) (void)xb_add(&bar[XB_XCNT(b.x)], 1u);
    return b;
}
__device__ __forceinline__ void xcd_barrier_complete(unsigned* bar, unsigned x, unsigned& nloc, unsigned& nx) {
    const unsigned G = gridDim.x * gridDim.y * gridDim.z;
    unsigned sum, cnt, mine, sp = 0u;
    for (;;) {
        sum = 0u; cnt = 0u; mine = 0u;
#pragma unroll
        for (unsigned j = 0; j < 16; ++j) { const unsigned c = xb_ld(&bar[XB_XCNT(j)]); sum += c; cnt += (c > 0u) ? 1u : 0u; mine = (j == x) ? c : mine; }
        if (sum == G) break;
        __builtin_amdgcn_s_sleep(1);
        if ((++sp & 255u) == 0u) { if (xb_ld(&bar[XB_TMO])) break; if (sp > XB_SPIN_CAP) { atomicAdd(&bar[XB_TMO], 1u); break; } }
    }
    nloc = mine > 0u ? mine : 1u; nx = cnt > 0u ? cnt : 1u;
}

__device__ __forceinline__ void xcd_barrier(const XcdBarrier& b) {
    asm volatile("s_waitcnt vmcnt(0)" ::: "memory");
    __syncthreads();
    if (threadIdx.x == 0) {
        unsigned* bar = b.bar;
        __builtin_amdgcn_s_waitcnt(0);
        unsigned nloc = b.st[0], nx = b.st[1];
        if (nloc == 0u) { xcd_barrier_complete(bar, b.x, nloc, nx); b.st[0] = nloc; b.st[1] = nx; }
        const unsigned old = xb_add(&bar[XB_XSUB(b.x)], 1u);
        const unsigned gen = old / nloc;
        if (old + 1u == (gen + 1u) * nloc) {
            __builtin_amdgcn_fence(__ATOMIC_RELEASE, "agent");
            asm volatile("s_waitcnt vmcnt(0)" ::: "memory");
            const unsigned og = xb_add(&bar[XB_TOP], 1u);
            const unsigned tg = og / nx;
            if (og + 1u == (tg + 1u) * nx) xb_add(&bar[XB_TOPGEN], 1u);
            else XB_SPIN(xb_ld(&bar[XB_TOPGEN]) == tg, bar);
            __builtin_amdgcn_fence(__ATOMIC_ACQUIRE, "agent");
            xb_add(&bar[XB_XGEN(b.x)], 1u);
            asm volatile("s_waitcnt vmcnt(0)" ::: "memory");
        } else {
            XB_SPIN(xb_ld(&bar[XB_XGEN(b.x)]) == gen, bar);
            __builtin_amdgcn_fence(__ATOMIC_ACQUIRE, "agent");
            asm volatile("s_waitcnt vmcnt(0)" ::: "memory");
        }
    }
    __syncthreads();
}

#ifndef SKIPMASK
#define SKIPMASK 0
#endif
#ifndef MK_N_LAUNCHES
#define MK_N_LAUNCHES 1
#endif
constexpr int N_PHASES = 9;
struct Args { const float* in[18]; float* out; unsigned char* ws; int ph_lo, ph_hi; };
enum { I_XP = 0, I_XS, I_CP, I_CS, I_STATE, I_CK, I_CV, I_CLF, I_NORMG, I_ADAW, I_ADAB, I_W1, I_CONVK, I_W2, I_W3, I_BF, I_W4, I_FG };

__global__ void __launch_bounds__(NWAVES * 64, 2) hybrid_fwd(Args args) {
    extern __shared__ __attribute__((aligned(16))) unsigned char lds[];
    LAS unsigned char* L = (LAS unsigned char*)lds;
    const int tid0 = threadIdx.x, wave = __builtin_amdgcn_readfirstlane(tid0 >> 6);
#define PHASE_TID() int tid = tid0; asm volatile("" : "+v"(tid)); const int lane = tid & 63; (void)lane
    const int G = gridDim.x; const int bx = blockIdx.x; const int vcu = (G % 8 == 0) ? (bx % 8) * (G / 8) + bx / 8 : bx;
    const int gw = vcu * NWAVES + wave, NGW = G * NWAVES;
    unsigned char* ws = args.ws; float* out = args.out;
    float* mod = (float*)(ws + WS_MOD);
    bf16* W1t = (bf16*)(ws + WS_W1); bf16* W2t = (bf16*)(ws + WS_W2); bf16* W3t = (bf16*)(ws + WS_W3); bf16* W4t = (bf16*)(ws + WS_W4);
    float* slab = (float*)(ws + WS_SLAB); bf16* AOb = (bf16*)(ws + WS_AO);
    bf16* Hb = (bf16*)(ws + WS_H); bf16* Yb = (bf16*)(ws + WS_Y); bf16* Qb = (bf16*)(ws + WS_Q); bf16* Kb = (bf16*)(ws + WS_K); bf16* Vb = (bf16*)(ws + WS_V); bf16* Zb = (bf16*)(ws + WS_Z);
    const int lo = args.ph_lo, hi = args.ph_hi;
#define IN(k) (lo <= (k) && (k) < hi)
#define SEAM(k) do { if (IN(k) && IN((k) + 1)) { xcd_barrier(bar); } } while (0)
    volatile LAS unsigned* MISC = (volatile LAS unsigned*)(L + XL_OFF + 12288);
    if (tid0 < 64) MISC[tid0] = 0u;
    __syncthreads();
    XcdBarrier bar = xcd_barrier_post((unsigned*)(ws + WS_CTL), MISC + 8);
    if (args.ph_lo < 0) cg::this_grid().sync();

    if (IN(0) && !(SKIPMASK & (1 << 0))) { PHASE_TID();
        LAS float* scr = (LAS float*)(L + wave * 16640);
        const int it = wave * G + vcu;
        if (it < 1536) {
            const int l = it / 768, rem = it % 768, cb = rem >> 4, kc = rem & 15, k0 = 64 * kc;
#pragma unroll
            for (int bb = 0; bb < 24; ++bb) { const float c = bb < 16 ? args.in[I_CP][bb * 1024 + k0 + lane] : args.in[I_CS][(bb - 16) * 1024 + k0 + lane]; scr[bb * 64 + lane] = c / (1.0f + expf(-c)); }
            const float* W = args.in[I_ADAW] + (size_t)l * 1024 * 3072 + (size_t)k0 * 3072 + cb * 64 + lane;
            float a[24];
#pragma unroll
            for (int bb = 0; bb < 24; ++bb) a[bb] = 0.f;
            LDS_WAIT(); asm volatile("" ::: "memory");
#pragma unroll 4
            for (int k4 = 0; k4 < 16; ++k4) { const int k = 4 * k4;
                const float w0 = W[(size_t)k * 3072], w1 = W[(size_t)(k + 1) * 3072], w2 = W[(size_t)(k + 2) * 3072], w3 = W[(size_t)(k + 3) * 3072];
#pragma unroll
                for (int bb = 0; bb < 24; ++bb) { const f32x4 s = *(const LAS f32x4*)(scr + bb * 64 + k); a[bb] += (s.x * w0 + s.y * w1) + (s.z * w2 + s.w * w3); } }
            float* mo = mod + (size_t)l * 24 * 3072 + cb * 64 + lane;
            const float bias = kc == 0 ? args.in[I_ADAB][l * 3072 + cb * 64 + lane] : 0.f;
#pragma unroll
            for (int bb = 0; bb < 24; ++bb) __hip_atomic_fetch_add(mo + (size_t)bb * 3072, a[bb] + bias, __ATOMIC_RELAXED, __HIP_MEMORY_SCOPE_AGENT);
            LDS_WAIT(); asm volatile("" ::: "memory");
        }
        for (int t = gw; t < 16 * 128; t += NGW) p0_transpose_item<1>(args.in[I_W1], 1024, N1, W1t, scr, t, lane);
    }
    SEAM(0);
    if (IN(1) && !(SKIPMASK & (1 << 1))) { PHASE_TID();
        for (int c = gw; c < MP / 16; c += NGW) ada_norm_rows(args.in[I_XP] + (size_t)c * 16 * DM, Hb + (size_t)c * 16 * DM, 16, args.in[I_NORMG], mod + (size_t)(c >> 7) * 3072, lane);
        for (int m = gw; m < MS; m += NGW) ada_norm_row(args.in[I_XS] + (size_t)m * DM, Hb + (size_t)(MP + m) * DM, args.in[I_NORMG], mod + (size_t)(16 + (m >> 6)) * 3072, lane);
    }
    SEAM(1);
    if (IN(2) && !(SKIPMASK & (1 << 2))) { PHASE_TID();
        pg8::Gemm g{Hb, W1t, MT, N1, DM}; pg8::ConvOrder S; S.init(G, vcu);
        pg8::EpiConv E{Yb, args.in[I_CONVK], args.in[I_STATE], out + O_CONVP, out + O_CONVS};
        pg8::gemm_phase<pg8::EpiConv, pg8::ConvOrder, true, true>(L, L + XL_OFF, g, S, E);
        {
            const bool part = (G == 256);
            if (!part || vcu >= 64) {
                LAS float* scr = (LAS float*)(L + wave * 16640);
                constexpr int I2 = 32 * 16, I3 = 16 * 65, I4 = 16 * 16;
                const int w0 = part ? (vcu - 64) * NWAVES + wave : gw, nw = part ? (G - 64) * NWAVES : NGW;
                for (int t = w0; t < I2 + I3 + I4; t += nw) {
                    int r = t;
                    if (r < I2) { p0_transpose_item<0>(args.in[I_W2], 2048, 1024, W2t, scr, r, lane); continue; } r -= I2;
                    if (r < I3) { p0_transpose_item<0>(args.in[I_W3], 1024, 4112, W3t, scr, r, lane); continue; } r -= I3;
                    p0_transpose_item<0>(args.in[I_W4], 1024, 1024, W4t, scr, r, lane);
                }
            }
        }
    }
    SEAM(2);
    if (IN(3) && !(SKIPMASK & (1 << 3))) { PHASE_TID();
        pg8::Gemm g{Yb, W2t, MT, DM, EW}; pg8::PanelOrder S; S.init(EW, G, vcu);
        pg8::EpiResNorm<0> E{args.in[I_XP], out + O_Y, mod + 2048, slab, Hb, args.in[I_NORMG] + DM, mod + (size_t)24 * 3072, (float*)(ws + WS_X), (unsigned*)(ws + WS_CNT), (bf16*)(ws + WS_X1)};
        pg8::gemm_phase<pg8::EpiResNorm<0>, pg8::PanelOrder, true, true>(L, L + XL_OFF, g, S, E);
    }
    SEAM(3);
    if (IN(4) && !(SKIPMASK & (1 << 4))) { PHASE_TID();
        for (int m = MP + gw; m < MT; m += NGW) { const int bb = 16 + ((m - MP) >> 6);
            ada_norm_row(args.in[I_XS] + (size_t)(m - MP) * DM, Hb + (size_t)m * DM, args.in[I_NORMG] + DM, mod + (size_t)(24 + bb) * 3072, lane, slab + (size_t)(m - MP) * DM, mod + (size_t)bb * 3072 + 2048, out + O_Y + (size_t)m * DM); }
    }
    SEAM(4);
    if (IN(5) && !(SKIPMASK & (1 << 5))) { PHASE_TID();
        pg8::Gemm g{Hb, W3t, MT, N3, DM}; pg8::StaticOrder S; S.init(MT, N3, DM, G, bx);
        pg8::EpiQKV E{Qb, Kb, Vb, Zb, out + O_KP, out + O_KS, out + O_VP, out + O_VS, out + O_LP, out + O_LS, args.in[I_BF], attn_body::C2};
        pg8::gemm_phase<pg8::EpiQKV, pg8::StaticOrder, true, true>(L, L + XL_OFF, g, S, E);
    }
    SEAM(5);
    if (IN(6) && !(SKIPMASK & (1 << 6))) { PHASE_TID();
        char* shm = (char*)lds; float* biasL = (float*)(shm + 86016);
        typedef attn_body::bf16 abf;
        for (int bh = vcu; bh < NB_P * NH; bh += G) { const int b = bh >> 4, h = bh & 15;
            f32x4 v; int tq = tid; asm volatile("" : "+v"(tq));
#pragma unroll
            for (int i = 0; i < 4; ++i) v[i] = out[O_LP + ((size_t)b * SEQ + 4 * tq + i) * NH + h];
            block_scan4(v, biasL, (LAS float*)(L + 96 * 1024), tq, 512);
#ifndef NO_PROMPT_ATT
            for (int i = 0; i < SEQ / 256; ++i) { const int qb = (vcu + 8 - i) & 7;
                attn_body::attn_unit<24>(b, h, qb, (const abf*)Qb, (const abf*)Kb, (const abf*)Vb, (const abf*)Zb, (abf*)AOb, shm, biasL, out + O_KP, out + O_VP); }
#endif
        }
#ifndef NO_SAMPLE_ATT
        for (int su = vcu; su < NB_S * NH * 2; su += G)
            attn_body::sample_unit(su >> 5, (su >> 1) & 15, su & 1, (const abf*)Qb, (const abf*)Kb, (const abf*)Vb, (const abf*)Zb, (abf*)AOb, args.in[I_CK], args.in[I_CV], args.in[I_CLF], out + O_LS, shm);
#endif
    }
    SEAM(6);
    if (IN(7) && !(SKIPMASK & (1 << 7))) { PHASE_TID();
        pg8::Gemm g{AOb, W4t, MT, DM, DM}; pg8::PanelOrder S; S.init(DM, G, vcu);
        pg8::EpiResNorm<1> E{out + O_Y, out + O_Y, mod + (size_t)24 * 3072 + 2048, slab, nullptr, args.in[I_FG], nullptr, (float*)(ws + WS_X + 512 * 1024), (unsigned*)(ws + WS_CNT + 32 * 1024), (bf16*)(ws + WS_X1)};
        pg8::gemm_phase<pg8::EpiResNorm<1>, pg8::PanelOrder, true, true>(L, L + XL_OFF, g, S, E);
    }
    SEAM(7);
    if (IN(8) && !(SKIPMASK & (1 << 8))) { PHASE_TID();
        for (int m = MP + gw; m < MT; m += NGW) final_norm_row(out + O_Y + (size_t)m * DM, args.in[I_FG], lane, slab + (size_t)(m - MP) * DM, mod + (size_t)(24 + 16 + ((m - MP) >> 6)) * 3072 + 2048);
    }
#undef IN
#undef SEAM
}

extern "C" void kernel_launch(void* const* d_in, const int* in_sizes, int n_in, void* d_out, int out_size, void* d_ws, size_t ws_size, hipStream_t stream) {
    static int grid = 0;
    if (grid == 0) {
        if (n_in != 18 || (size_t)out_size != O_END || ws_size < WS_END) { fprintf(stderr, "kernel_launch: unexpected shapes (n_in %d out %d ws %zu)\n", n_in, out_size, ws_size); grid = -1; return; }
        int dev = 0, cus = 0, per_cu = 0;
        if (hipGetDevice(&dev) != hipSuccess || hipDeviceGetAttribute(&cus, hipDeviceAttributeMultiprocessorCount, dev) != hipSuccess) { grid = -1; return; }
        if (hipFuncSetAttribute((const void*)hybrid_fwd, hipFuncAttributeMaxDynamicSharedMemorySize, LDS_BYTES) != hipSuccess) { fprintf(stderr, "kernel_launch: hipFuncSetAttribute failed\n"); grid = -1; return; }
        if (hipOccupancyMaxActiveBlocksPerMultiprocessor(&per_cu, (const void*)hybrid_fwd, NWAVES * 64, LDS_BYTES) != hipSuccess || per_cu < 1) { fprintf(stderr, "kernel_launch: occupancy query says %d\n", per_cu); (void)hipGetLastError(); per_cu = 1; }
        grid = cus * 1;
        (void)per_cu;
    }
    if (grid < 0) return;
    if (hipMemsetAsync((char*)d_ws + WS_CTL, 0, CTL_ZERO_BYTES, stream) != hipSuccess) { fprintf(stderr, "kernel_launch: memset failed\n"); return; }
    Args a{};
    for (int i = 0; i < 18; ++i) a.in[i] = (const float*)d_in[i];
    a.out = (float*)d_out; a.ws = (unsigned char*)d_ws;
    if (MK_N_LAUNCHES == 1) {
        a.ph_lo = 0; a.ph_hi = N_PHASES;
        void* kargs[] = {&a};
        hipError_t e = hipLaunchCooperativeKernel((const void*)hybrid_fwd, dim3(grid), dim3(NWAVES * 64), kargs, LDS_BYTES, stream);
        if (e != hipSuccess) fprintf(stderr, "kernel_launch: cooperative launch failed: %s (grid %d)\n", hipGetErrorString(e), grid);
    } else {
        for (int p = 0; p < N_PHASES; ++p) { a.ph_lo = p; a.ph_hi = p + 1; hipLaunchKernelGGL(hybrid_fwd, dim3(grid), dim3(NWAVES * 64), LDS_BYTES, stream, a); }
    }
}
```

```cpp
#include <hip/hip_runtime.h>
#include <hip/hip_cooperative_groups.h>
#include <hip/hip_bf16.h>
#include <cstdio>
#include <cstdint>
#include <cmath>
namespace cg = cooperative_groups;

namespace pg8 {
#define PG8_LAS __attribute__((address_space(3)))
typedef unsigned short bf16_t;
typedef short bf16x8 __attribute__((ext_vector_type(8)));
typedef float f32x4 __attribute__((ext_vector_type(4)));
typedef unsigned u32x4 __attribute__((ext_vector_type(4)));
typedef unsigned u32x2 __attribute__((ext_vector_type(2)));
constexpr int BM = 256, BK = 64, HALF = 128, HTB = HALF * BK * 2  , STAGE_BYTES = 8 * HTB, NXCD = 8, WGM = 8;

__host__ __device__ __forceinline__ int lds_byte(int r, int c) { const int st = (r >> 4) * 2 + (c >> 5), rr = r & 15, cc = c & 31, ob = rr * 64 + cc * 2; return st * 1024 + (ob ^ (((ob >> 9) & 1) << 5)); }
__host__ __device__ __forceinline__ void stage_rc(int b, int& R, int& C) { const int st = b / 1024, sb = b % 1024, swz = sb ^ (((sb >> 9) & 1) << 5); R = (st >> 1) * 16 + swz / 64; C = (st & 1) * 32 + (swz % 64) / 2; }
__host__ __device__ __forceinline__ int perm32(int rho) { const int n = rho >> 4, i = rho & 15; return 8 * (i >> 2) + 4 * n + (i & 3); }

struct Unit { int pm, pn, k0, nt, split; };
struct Gemm { const bf16_t* A; const bf16_t* Bt; int M, N, K; };

struct StaticOrder {
    int nM, nN, nwg, G, c, ntk;
    __host__ __device__ void init(int M, int N, int K, int G_, int c_) { nM = M / BM; nN = N / BM; nwg = nM * nN; G = G_; c = c_; ntk = K / BK; }
    __host__ __device__ bool next(int i, Unit& u) const {
        const long L = (long)i * G + c; if (L >= nwg) return false;
        int wgid = (int)L; { const int q = nwg / NXCD, r = nwg % NXCD, xcd = wgid % NXCD, off = wgid / NXCD; wgid = (xcd < r ? xcd * (q + 1) : r * (q + 1) + (xcd - r) * q) + off; }
        const int nig = WGM * nN, gid = wgid / nig, fm = gid * WGM, gsz = (nM - fm) < WGM ? (nM - fm) : WGM;
        u.pm = fm + ((wgid % nig) % gsz); u.pn = (wgid % nig) / gsz; u.k0 = 0; u.nt = ntk; u.split = 0; return true;
    }
};
struct ConvOrder {
    int vcu, G, nsup;
    __device__ void init(int G_, int vcu_) { G = G_; vcu = vcu_; nsup = vcu < 512 ? (512 - vcu + G - 1) / G : 0; }
    __device__ bool next(int i, Unit& u) const {
        u.k0 = 0; u.nt = 16; u.split = 0;
        if (i < 8 * nsup) { const int s = vcu + G * (i >> 3), j = i & 7, combo = s >> 5, y = s & 31; const int b = (combo >> 2) * 4 + (y >> 3); u.pn = (combo & 3) * 8 + (y & 7); u.pm = b * 8 + j; return true; }
        const int su = vcu + G * (i - 8 * nsup); if (su >= 64) return false;
        u.pm = 128 + (su >> 5); u.pn = su & 31; return true;
    }
};

constexpr int NSPLIT = 8;
struct PanelOrder {
    int vcu, G, npr, ntk;
    __device__ void init(int K, int G_, int vcu_) { G = G_; vcu = vcu_; ntk = K / BK; npr = vcu < 512 ? (512 - vcu + G - 1) / G : 0; }
    __device__ bool next(int i, Unit& u) const {
        if (i < npr) { const int L = vcu + G * i; u.pm = L >> 2; u.pn = L & 3; u.k0 = 0; u.nt = ntk; u.split = 0; return true; }
        const int s = vcu + G * (i - npr); if (s >= 8 * NSPLIT) return false;
        const int tile = s / NSPLIT, ch = s % NSPLIT; u.pm = 128 + (tile >> 2); u.pn = tile & 3; u.nt = ntk / NSPLIT; u.k0 = ch * u.nt * BK; u.split = ch + 1; return true;
    }
};

__device__ __forceinline__ unsigned cvt_pk_bf16(float lo, float hi) { unsigned r; asm volatile("v_cvt_pk_bf16_f32 %0, %1, %2" : "=v"(r) : "v"(lo), "v"(hi)); return r; }
__device__ __forceinline__ float silu_f(float z) { return z * __builtin_amdgcn_rcpf(1.0f + __builtin_amdgcn_exp2f(-1.4426950408889634f * z)); }
__device__ __forceinline__ float shfl_i(float v, int srcb) { return __builtin_bit_cast(float, __builtin_amdgcn_ds_bpermute(srcb, __builtin_bit_cast(int, v))); }

constexpr int NPROMPT_TILES = 128, PROMPT_ROWS = 32768;

struct EpiConv {
    static constexpr bool PERM = false;
    bf16_t* Y; const float* convk; const float* state; float* outp; float* outs;
    __device__ __forceinline__ void operator()(f32x4 (&acc)[2][2][4][2], const Unit& u, int wr, int wc, int fr, int fq, PG8_LAS unsigned char* xl, int ui) const {
        const int lane = threadIdx.x & 63;
        const int chl = wc * 16 + fq * 4, e0 = u.pn * 64 + chl;
        const bool samp = u.pm >= NPROMPT_TILES;
        PG8_LAS float* tail = (PG8_LAS float*)xl + (ui & 1) * 512;
        PG8_LAS float* tailp = (PG8_LAS float*)xl + ((ui & 1) ^ 1) * 512;
#pragma unroll
        for (int ai = 0; ai < 2; ++ai)
#pragma unroll
            for (int m = 0; m < 4; ++m) acc[ai][0][m][1] = acc[ai][0][m][1] * acc[ai][1][m][0];
        if (fr >= 14) {
#pragma unroll
            for (int ai = 0; ai < 2; ++ai) *(PG8_LAS f32x4*)(tail + ((2 * ai + wr) * 2 + (fr - 14)) * 64 + chl) = acc[ai][0][3][1];
        }
        asm volatile("s_waitcnt lgkmcnt(0)" ::: "memory"); __builtin_amdgcn_s_barrier(); asm volatile("" ::: "memory");
        const f32x4 k0 = *(const f32x4*)(convk + e0), k1 = *(const f32x4*)(convk + 2048 + e0), k2 = *(const f32x4*)(convk + 4096 + e0);
        const int src1 = ((lane & 48) | ((lane - 1) & 15)) << 2, src2 = ((lane & 48) | ((lane - 2) & 15)) << 2;
#pragma unroll
        for (int ai = 0; ai < 2; ++ai) {
            const int g = 2 * ai + wr;
            f32x4 p1, p2;
            if (samp) { const int bs = (u.pm - NPROMPT_TILES) * 4 + g; p2 = *(const f32x4*)(state + (size_t)(bs * 2 + 0) * 2048 + e0); p1 = *(const f32x4*)(state + (size_t)(bs * 2 + 1) * 2048 + e0); }
            else if (g == 0) { if ((u.pm & 7) == 0) { p1 = (f32x4){0.f, 0.f, 0.f, 0.f}; p2 = p1; } else { p2 = *(PG8_LAS f32x4*)(tailp + (3 * 2 + 0) * 64 + chl); p1 = *(PG8_LAS f32x4*)(tailp + (3 * 2 + 1) * 64 + chl); } }
            else { p2 = *(PG8_LAS f32x4*)(tail + ((g - 1) * 2 + 0) * 64 + chl); p1 = *(PG8_LAS f32x4*)(tail + ((g - 1) * 2 + 1) * 64 + chl); }
            f32x4 r1p = p1, r2p = (fr == 0) ? p2 : p1;
#pragma unroll
            for (int m = 0; m < 4; ++m) {
                const f32x4 uu = acc[ai][0][m][1];
                f32x4 r1, r2;
#pragma unroll
                for (int i = 0; i < 4; ++i) { r1[i] = shfl_i(uu[i], src1); r2[i] = shfl_i(uu[i], src2); }
                const f32x4 um1 = (fr >= 1) ? r1 : r1p, um2 = (fr >= 2) ? r2 : r2p;
                const f32x4 cv = k2 * uu + k1 * um1 + k0 * um2;
                const f32x4 bg = acc[ai][0][m][0], z = acc[ai][1][m][1];
                f32x4 y;
#pragma unroll
                for (int i = 0; i < 4; ++i) y[i] = bg[i] * cv[i] * silu_f(z[i]);
                const size_t row = (size_t)u.pm * BM + ai * HALF + wr * 64 + m * 16 + fr;
                u32x2 w; w.x = cvt_pk_bf16(y[0], y[1]); w.y = cvt_pk_bf16(y[2], y[3]);
                *(u32x2*)(Y + row * 2048 + e0) = w;
                r1p = r1; r2p = r2;
            }
            if (fr >= 14) {
                if (samp) { const int bs = (u.pm - NPROMPT_TILES) * 4 + g; *(f32x4*)(outs + (size_t)(bs * 2 + (fr - 14)) * 2048 + e0) = acc[ai][0][3][1]; }
                else if ((u.pm & 7) == 7 && g == 3) { *(f32x4*)(outp + (size_t)((u.pm >> 3) * 2 + (fr - 14)) * 2048 + e0) = acc[ai][0][3][1]; }
            }
        }
    }
};

struct EpiRes {
    static constexpr bool PERM = false;
    const float* xp; const float* xs; float* out; const float* gate; float* slab;
    __device__ __forceinline__ void operator()(f32x4 (&acc)[2][2][4][2], const Unit& u, int wr, int wc, int fr, int fq, PG8_LAS unsigned char*, int) const {
        const bool samp = u.pm >= NPROMPT_TILES;
        const float* xb = samp ? xs : xp;
        const int col0 = u.pn * BM + wc * 32 + 4 * fq;
        if (u.split) {
            float* sb = slab + (size_t)(u.split - 1) * 512 * 1024;
#pragma unroll
            for (int ai = 0; ai < 2; ++ai)
#pragma unroll
                for (int m = 0; m < 4; ++m) { const size_t off = ((size_t)(u.pm - NPROMPT_TILES) * BM + ai * HALF + wr * 64 + m * 16 + fr) * 1024 + col0;
#pragma unroll
                    for (int bj = 0; bj < 2; ++bj)
#pragma unroll
                        for (int n = 0; n < 2; ++n) *(f32x4*)(sb + off + bj * HALF + n * 16) = acc[ai][bj][m][n]; }
            return;
        }
#pragma unroll
        for (int ai = 0; ai < 2; ++ai) {
            const int bb = samp ? 16 + (u.pm - NPROMPT_TILES) * 4 + 2 * ai + wr : (u.pm >> 3);
            f32x4 gv[2][2];
#pragma unroll
            for (int bj = 0; bj < 2; ++bj)
#pragma unroll
                for (int n = 0; n < 2; ++n) gv[bj][n] = *(const f32x4*)(gate + (size_t)bb * 3072 + col0 + bj * HALF + n * 16);
#pragma unroll
            for (int m = 0; m < 4; ++m) {
                const size_t off = ((size_t)u.pm * BM + ai * HALF + wr * 64 + m * 16 + fr) * 1024 + col0;
#pragma unroll
                for (int bj = 0; bj < 2; ++bj)
#pragma unroll
                    for (int n = 0; n < 2; ++n) { const f32x4 xv = *(const f32x4*)(xb + off + bj * HALF + n * 16); *(f32x4*)(out + off + bj * HALF + n * 16) = xv + gv[bj][n] * acc[ai][bj][m][n]; }
                if (m & 1) asm volatile("" ::: "memory");
            }
        }
    }
};

template <int MODE> struct EpiResNorm {
    static constexpr bool PERM = true;
    const float* xin; float* out; const float* gate; float* slab; bf16_t* hb; const float* g; const float* modn; float* xbuf; unsigned* cnt; bf16_t* x1b;
    __device__ __forceinline__ void operator()(f32x4 (&acc)[2][2][4][2], const Unit& u, int wr, int wc, int fr, int fq, PG8_LAS unsigned char* xl, int) const {
        const int col0 = u.pn * BM + wc * 32 + 8 * fq;
        if (u.split) {
            float* sb = slab + (size_t)(u.split - 1) * 512 * 1024;
#pragma unroll
            for (int ai = 0; ai < 2; ++ai)
#pragma unroll
                for (int m = 0; m < 4; ++m) { const size_t off = ((size_t)(u.pm - NPROMPT_TILES) * BM + ai * HALF + wr * 64 + m * 16 + fr) * 1024 + col0;
#pragma unroll
                    for (int bj = 0; bj < 2; ++bj)
#pragma unroll
                        for (int n = 0; n < 2; ++n) *(f32x4*)(sb + off + bj * HALF + n * 4) = acc[ai][bj][m][n]; }
            return;
        }
        const int lane = threadIdx.x & 63, wid = wr * 4 + wc, bb = u.pm >> 3;
        PG8_LAS float* P = (PG8_LAS float*)(xl + 4096);
        PG8_LAS float* S = P + 1024;
        {   f32x4 gv[2][2];
#pragma unroll
            for (int bj = 0; bj < 2; ++bj)
#pragma unroll
                for (int n = 0; n < 2; ++n) gv[bj][n] = *(const f32x4*)(gate + (size_t)bb * 3072 + col0 + bj * HALF + n * 4);
#pragma unroll
            for (int ai = 0; ai < 2; ++ai)
#pragma unroll
                for (int m = 0; m < 4; ++m) { const size_t off = ((size_t)u.pm * BM + ai * HALF + wr * 64 + m * 16 + fr) * 1024 + col0; float s = 0.f;
#pragma unroll
                    for (int bj = 0; bj < 2; ++bj) { f32x4 xv[2];
                        if (MODE == 0) { xv[0] = __builtin_nontemporal_load((const f32x4*)(xin + off + bj * HALF)); xv[1] = __builtin_nontemporal_load((const f32x4*)(xin + off + bj * HALF + 4)); }
                        else { const u32x4 xw = __builtin_nontemporal_load((const u32x4*)(x1b + off + bj * HALF));
                            xv[0] = (f32x4){__builtin_bit_cast(float, xw.x << 16), __builtin_bit_cast(float, xw.x & 0xffff0000u), __builtin_bit_cast(float, xw.y << 16), __builtin_bit_cast(float, xw.y & 0xffff0000u)};
                            xv[1] = (f32x4){__builtin_bit_cast(float, xw.z << 16), __builtin_bit_cast(float, xw.z & 0xffff0000u), __builtin_bit_cast(float, xw.w << 16), __builtin_bit_cast(float, xw.w & 0xffff0000u)}; }
#pragma unroll
                        for (int n = 0; n < 2; ++n) { const f32x4 a = xv[n] + gv[bj][n] * acc[ai][bj][m][n]; acc[ai][bj][m][n] = a; s += (a[0] * a[0] + a[1] * a[1]) + (a[2] * a[2] + a[3] * a[3]); } }
                    s += __shfl_xor(s, 16); s += __shfl_xor(s, 32);
                    if (fq == 0) P[(ai * HALF + wr * 64 + m * 16 + fr) * 4 + wc] = s;
                    if (m & 1) asm volatile("" ::: "memory"); } }
        asm volatile("s_waitcnt lgkmcnt(0)" ::: "memory"); __builtin_amdgcn_s_barrier(); asm volatile("" ::: "memory");
        const int row = wid * 32 + (lane & 31);
        if (lane < 32) { const float tot = (P[row * 4 + 0] + P[row * 4 + 1]) + (P[row * 4 + 2] + P[row * 4 + 3]);
            __hip_atomic_store(xbuf + ((size_t)u.pm * BM + row) * 4 + u.pn, tot, __ATOMIC_RELAXED, __HIP_MEMORY_SCOPE_AGENT); }
        asm volatile("s_waitcnt vmcnt(0)" ::: "memory");
        if (lane == 0) __hip_atomic_fetch_add(cnt + 64 * u.pm, 1u, __ATOMIC_RELAXED, __HIP_MEMORY_SCOPE_AGENT);
        if (wid == 0) { unsigned sp = 0;
            while ((unsigned)__builtin_amdgcn_readfirstlane((int)__hip_atomic_load(cnt + 64 * u.pm, __ATOMIC_RELAXED, __HIP_MEMORY_SCOPE_AGENT)) < 32u) { __builtin_amdgcn_s_sleep(2); if (++sp > (1u << 20)) break; }
            __builtin_amdgcn_fence(__ATOMIC_ACQUIRE, "agent"); }
        asm volatile("s_waitcnt vmcnt(0) lgkmcnt(0)" ::: "memory"); __builtin_amdgcn_s_barrier(); asm volatile("" ::: "memory");
        if (lane < 32) { const float* sl = xbuf + ((size_t)u.pm * BM + row) * 4; float t = 0.f;
#pragma unroll
            for (int q = 0; q < 4; ++q) t += __hip_atomic_load(sl + q, __ATOMIC_RELAXED, __HIP_MEMORY_SCOPE_AGENT);
            S[row] = 1.0f / sqrtf(t * (1.0f / 1024.0f) + 1e-6f); }
        asm volatile("s_waitcnt lgkmcnt(0)" ::: "memory"); __builtin_amdgcn_s_barrier(); asm volatile("" ::: "memory");
#pragma unroll
        for (int bj = 0; bj < 2; ++bj) { const int col = col0 + bj * HALF;
            f32x4 gm[2], sh[2];
#pragma unroll
            for (int n = 0; n < 2; ++n) { gm[n] = *(const f32x4*)(g + col + 4 * n); sh[n] = (f32x4){0.f, 0.f, 0.f, 0.f};
                if (MODE == 0) { gm[n] = gm[n] * (*(const f32x4*)(modn + (size_t)bb * 3072 + 1024 + col + 4 * n) + 1.0f); sh[n] = *(const f32x4*)(modn + (size_t)bb * 3072 + col + 4 * n); } }
#pragma unroll
            for (int ai = 0; ai < 2; ++ai)
#pragma unroll
                for (int m = 0; m < 4; ++m) { const int r = ai * HALF + wr * 64 + m * 16 + fr; const float rs = S[r]; const size_t off = ((size_t)u.pm * BM + r) * 1024 + col; const f32x4 a0 = acc[ai][bj][m][0], a1 = acc[ai][bj][m][1];
                    if (MODE == 0) { u32x4 xw; xw.x = cvt_pk_bf16(a0[0], a0[1]); xw.y = cvt_pk_bf16(a0[2], a0[3]); xw.z = cvt_pk_bf16(a1[0], a1[1]); xw.w = cvt_pk_bf16(a1[2], a1[3]); __builtin_nontemporal_store(xw, (u32x4*)(x1b + off));
                        const f32x4 h0 = a0 * rs * gm[0] + sh[0], h1 = a1 * rs * gm[1] + sh[1]; u32x4 w; w.x = cvt_pk_bf16(h0[0], h0[1]); w.y = cvt_pk_bf16(h0[2], h0[3]); w.z = cvt_pk_bf16(h1[0], h1[1]); w.w = cvt_pk_bf16(h1[2], h1[3]); *(u32x4*)(hb + off) = w; }
                    else { __builtin_nontemporal_store(a0 * rs * gm[0], (f32x4*)(out + off)); __builtin_nontemporal_store(a1 * rs * gm[1], (f32x4*)(out + off + 4)); } } }
    }
};

struct EpiQKV {
    static constexpr bool PERM = true;
    bf16_t *Qb, *Kb, *Vb, *Zb; float *okp, *oks, *ovp, *ovs, *olp, *ols; const float* bf; float c2;
    __device__ __forceinline__ void operator()(f32x4 (&acc)[2][2][4][2], const Unit& u, int wr, int wc, int fr, int fq, PG8_LAS unsigned char*, int) const {
        const int t = u.pn >> 2; const bool samp = u.pm >= NPROMPT_TILES;
        const size_t row0 = (size_t)u.pm * BM + wr * 64 + fr;
        if (t == 4) {
            if (wc == 0 && fq < 2) {
                float* ob = samp ? ols - (size_t)PROMPT_ROWS * 16 : olp;
#pragma unroll
                for (int n = 0; n < 2; ++n) { const f32x4 bv = *(const f32x4*)(bf + 8 * fq + 4 * n);
#pragma unroll
                    for (int ai = 0; ai < 2; ++ai)
#pragma unroll
                        for (int m = 0; m < 4; ++m) { const f32x4 a = acc[ai][0][m][n] + bv; f32x4 lf;
#pragma unroll
                            for (int i = 0; i < 4; ++i) lf[i] = fminf(a[i], 0.f) - log1pf(expf(-fabsf(a[i])));
                            *(f32x4*)(ob + (row0 + ai * HALF + m * 16) * 16 + 8 * fq + 4 * n) = lf; } }
            }
            return;
        }
        const int col0 = (u.pn & 3) * BM + wc * 32 + 8 * fq;
        bf16_t* bo = t == 0 ? Qb : t == 1 ? Kb : t == 2 ? Vb : Zb;
        float* fo = t == 1 ? (samp ? oks - (size_t)PROMPT_ROWS * 1024 : okp) : (samp ? ovs - (size_t)PROMPT_ROWS * 1024 : ovp);
#pragma unroll
        for (int ai = 0; ai < 2; ++ai)
#pragma unroll
            for (int m = 0; m < 4; ++m) { const size_t off = (row0 + ai * HALF + m * 16) * 1024 + col0;
#pragma unroll
                for (int bj = 0; bj < 2; ++bj) { f32x4 v0 = acc[ai][bj][m][0], v1 = acc[ai][bj][m][1];
                    if ((t == 1 || t == 2) && samp) { __builtin_nontemporal_store(v0, (f32x4*)(fo + off + bj * HALF)); __builtin_nontemporal_store(v1, (f32x4*)(fo + off + bj * HALF + 4)); }
                    if (t == 0) { v0 = v0 * c2; v1 = v1 * c2; }
                    if (t == 3) {
#pragma unroll
                        for (int i = 0; i < 4; ++i) { v0[i] = silu_f(v0[i]); v1[i] = silu_f(v1[i]); } }
                    u32x4 w; w.x = cvt_pk_bf16(v0[0], v0[1]); w.y = cvt_pk_bf16(v0[2], v0[3]); w.z = cvt_pk_bf16(v1[0], v1[1]); w.w = cvt_pk_bf16(v1[2], v1[3]);
                    *(u32x4*)(bo + off + bj * HALF) = w; } }
    }
};
template <class Epi, class Sched, bool ALIGN_EPI = false, bool SP2 = false>
__device__ __forceinline__ void gemm_phase(PG8_LAS unsigned char* lds, PG8_LAS unsigned char* xlds, const Gemm g, const Sched& S, const Epi& E) {
    const int tid = threadIdx.x, wid = __builtin_amdgcn_readfirstlane(tid >> 6), lane = tid & 63, wr = wid >> 2, wc = wid & 3, fr = lane & 15, fq = lane >> 4;
    const int K = g.K; int nt;
    unsigned voffA[2], voffB[2];
#pragma unroll
    for (int i = 0; i < 2; ++i) { int R, C; stage_rc(tid * 16 + i * 8192, R, C); const int Rb = Epi::PERM ? ((R & ~31) + perm32(R & 31)) : R;
        voffA[i] = (unsigned)(R * K + C) * 2u; voffB[i] = (unsigned)(Rb * K + C) * 2u; }
    const size_t kstep = (size_t)(BK * 2);
    const size_t hstep = (size_t)HALF * K * 2;
    const size_t tstep = 2 * hstep;
    const unsigned ldsw = (unsigned)wid * 1024u;
    const int aoff = lds_byte(wr * 64 + fr, fq * 8), boff = lds_byte(wc * 32 + fr, fq * 8);
#define PG8_SA(b, h) (((b) * 2 + (h)) * HTB)
#define PG8_SB(b, h) ((4 + (b) * 2 + (h)) * HTB)
#define PG8_STAGE(bufoff, gbase, voff) do { _Pragma("unroll") for (int _i = 0; _i < 2; ++_i) \
        __builtin_amdgcn_global_load_lds((const unsigned*)((const char*)(gbase) + (voff)[_i]), (PG8_LAS unsigned*)(lds + (bufoff) + ldsw + _i * 8192), 16, 0, 0); } while (0)
#define PG8_LDA(dst, b, h) do { _Pragma("unroll") for (int m = 0; m < 4; ++m) _Pragma("unroll") for (int k = 0; k < 2; ++k) dst[m][k] = *(const PG8_LAS bf16x8*)(lds + PG8_SA(b, h) + aoff + m * 2048 + k * 1024); } while (0)
#define PG8_LDB(dst, b, h) do { _Pragma("unroll") for (int n = 0; n < 2; ++n) _Pragma("unroll") for (int k = 0; k < 2; ++k) dst[n][k] = *(const PG8_LAS bf16x8*)(lds + PG8_SB(b, h) + boff + n * 2048 + k * 1024); } while (0)
#define PG8_MMA(ai, bj, At, Bt) do { __builtin_amdgcn_s_setprio(1); _Pragma("unroll") for (int m = 0; m < 4; ++m) _Pragma("unroll") for (int n = 0; n < 2; ++n) _Pragma("unroll") for (int k = 0; k < 2; ++k) \
        acc[ai][bj][m][n] = __builtin_amdgcn_mfma_f32_16x16x32_bf16(Bt[n][k], At[m][k], acc[ai][bj][m][n], 0, 0, 0); __builtin_amdgcn_s_setprio(0); } while (0)
#define PG8_WAIT_V(n) asm volatile("s_waitcnt vmcnt(" #n ")" ::: "memory")
#define PG8_WAIT_L(n) asm volatile("s_waitcnt lgkmcnt(" #n ")" ::: "memory")
#define PG8_BAR __builtin_amdgcn_s_barrier()
#define PG8_SCHED __builtin_amdgcn_sched_barrier(0)
    Unit cur, nxt; int ui = 0;
    if (!S.next(0, cur)) return;
    nt = cur.nt;
    f32x4 acc[2][2][4][2];
#pragma unroll
    for (int a = 0; a < 2; ++a)
#pragma unroll
        for (int b = 0; b < 2; ++b)
#pragma unroll
            for (int m = 0; m < 4; ++m)
#pragma unroll
                for (int n = 0; n < 2; ++n) acc[a][b][m][n] = (f32x4){0.f, 0.f, 0.f, 0.f};
    bf16x8 At[4][2], B0[2][2], B1[2][2];
    const char* cA = (const char*)g.A + (size_t)cur.pm * tstep + (size_t)cur.k0 * 2; const char* cB = (const char*)g.Bt + (size_t)cur.pn * tstep + (size_t)cur.k0 * 2;
    if constexpr (SP2) {
        PG8_STAGE(PG8_SB(0, 0), cB, voffB); PG8_STAGE(PG8_SB(0, 1), cB + hstep, voffB); PG8_STAGE(PG8_SA(0, 0), cA, voffA); PG8_STAGE(PG8_SA(0, 1), cA + hstep, voffA);
        if (wr == 1) PG8_BAR;
        PG8_WAIT_V(2); PG8_BAR;
        PG8_STAGE(PG8_SB(1, 0), cB + kstep, voffB); PG8_STAGE(PG8_SA(1, 0), cA + kstep, voffA); PG8_STAGE(PG8_SB(1, 1), cB + hstep + kstep, voffB);
        PG8_WAIT_V(6); PG8_BAR;
    } else {
        PG8_STAGE(PG8_SB(0, 0), cB, voffB); PG8_STAGE(PG8_SA(0, 0), cA, voffA); PG8_STAGE(PG8_SB(0, 1), cB + hstep, voffB); PG8_STAGE(PG8_SA(0, 1), cA + hstep, voffA);
        if (wr == 1) PG8_BAR;
        PG8_WAIT_V(4); PG8_BAR;
        PG8_STAGE(PG8_SB(1, 0), cB + kstep, voffB); PG8_STAGE(PG8_SA(1, 0), cA + kstep, voffA); PG8_STAGE(PG8_SB(1, 1), cB + hstep + kstep, voffB);
        PG8_WAIT_V(6); PG8_BAR;
    }
    for (;;) {
        const bool has_next = S.next(ui + 1, nxt);
        const char* nA = has_next ? (const char*)g.A + (size_t)nxt.pm * tstep + (size_t)nxt.k0 * 2 : cA; const char* nB = has_next ? (const char*)g.Bt + (size_t)nxt.pn * tstep + (size_t)nxt.k0 * 2 : cB;
        for (int t = 0; t < nt; t += 2) {
            const bool last = (t == nt - 2);
            const char* a1 = cA + (size_t)(t + 1) * kstep;
            const char* a2 = last ? nA : cA + (size_t)(t + 2) * kstep; const char* b2 = last ? nB : cB + (size_t)(t + 2) * kstep;
            const char* a3 = a2 + kstep; const char* b3 = b2 + kstep;
            if constexpr (SP2) {
            PG8_LDB(B0, 0, 0); PG8_LDB(B1, 0, 1); PG8_SCHED; PG8_LDA(At, 0, 0); PG8_STAGE(PG8_SA(1, 1), a1 + hstep, voffA);
            PG8_WAIT_V(8); PG8_WAIT_L(0); PG8_BAR; PG8_MMA(0, 0, At, B0); PG8_MMA(0, 1, At, B1); PG8_BAR; PG8_SCHED;
            PG8_LDA(At, 0, 1); PG8_STAGE(PG8_SB(0, 0), b2, voffB); PG8_STAGE(PG8_SB(0, 1), b2 + hstep, voffB); PG8_STAGE(PG8_SA(0, 0), a2, voffA);
            PG8_WAIT_V(8); PG8_WAIT_L(0); PG8_BAR; PG8_MMA(1, 0, At, B0); PG8_MMA(1, 1, At, B1); PG8_BAR; PG8_SCHED;
            PG8_LDB(B0, 1, 0); PG8_LDB(B1, 1, 1); PG8_SCHED; PG8_LDA(At, 1, 0); PG8_STAGE(PG8_SA(0, 1), a2 + hstep, voffA);
            PG8_WAIT_V(8); PG8_WAIT_L(0); PG8_BAR; PG8_MMA(0, 0, At, B0); PG8_MMA(0, 1, At, B1); PG8_BAR; PG8_SCHED;
            PG8_LDA(At, 1, 1); PG8_STAGE(PG8_SB(1, 0), b3, voffB); PG8_STAGE(PG8_SB(1, 1), b3 + hstep, voffB); PG8_STAGE(PG8_SA(1, 0), a3, voffA);
            PG8_WAIT_V(8); PG8_WAIT_L(0); PG8_BAR; PG8_MMA(1, 0, At, B0); PG8_MMA(1, 1, At, B1); PG8_BAR; PG8_SCHED;
            } else {
            PG8_LDB(B0, 0, 0); PG8_SCHED; PG8_LDA(At, 0, 0); PG8_STAGE(PG8_SA(1, 1), a1 + hstep, voffA);
            PG8_WAIT_L(8); PG8_BAR; PG8_WAIT_L(0); PG8_MMA(0, 0, At, B0); PG8_BAR; PG8_SCHED;
            PG8_LDB(B1, 0, 1); PG8_STAGE(PG8_SB(0, 0), b2, voffB);
            PG8_BAR; PG8_WAIT_L(0); PG8_MMA(0, 1, At, B1); PG8_BAR;
            PG8_LDA(At, 0, 1); PG8_STAGE(PG8_SA(0, 0), a2, voffA);
            PG8_BAR; PG8_WAIT_L(0); PG8_MMA(1, 0, At, B0); PG8_BAR; PG8_SCHED;
            PG8_STAGE(PG8_SB(0, 1), b2 + hstep, voffB);
            PG8_WAIT_V(6); PG8_BAR; PG8_MMA(1, 1, At, B1); PG8_BAR;
            PG8_LDB(B0, 1, 0); PG8_SCHED; PG8_LDA(At, 1, 0); PG8_STAGE(PG8_SA(0, 1), a2 + hstep, voffA);
            PG8_WAIT_L(8); PG8_BAR; PG8_WAIT_L(0); PG8_MMA(0, 0, At, B0); PG8_BAR; PG8_SCHED;
            PG8_LDB(B1, 1, 1); PG8_STAGE(PG8_SB(1, 0), b3, voffB);
            PG8_BAR; PG8_WAIT_L(0); PG8_MMA(0, 1, At, B1); PG8_BAR;
            PG8_LDA(At, 1, 1); PG8_STAGE(PG8_SA(1, 0), a3, voffA);
            PG8_BAR; PG8_WAIT_L(0); PG8_MMA(1, 0, At, B0); PG8_BAR; PG8_SCHED;
            PG8_STAGE(PG8_SB(1, 1), b3 + hstep, voffB);
            PG8_WAIT_V(6); PG8_BAR; PG8_MMA(1, 1, At, B1); PG8_BAR;
            }
        }
        if constexpr (ALIGN_EPI) { if (wr == 0) PG8_BAR; }
        E(acc, cur, wr, wc, fr, fq, xlds, ui);
        if (!has_next) break;
#pragma unroll
        for (int a = 0; a < 2; ++a)
#pragma unroll
            for (int b = 0; b < 2; ++b)
#pragma unroll
                for (int m = 0; m < 4; ++m)
#pragma unroll
                    for (int n = 0; n < 2; ++n) acc[a][b][m][n] = (f32x4){0.f, 0.f, 0.f, 0.f};
        cur = nxt; cA = nA; cB = nB; ++ui; nt = cur.nt;
        if constexpr (ALIGN_EPI) { if (wr == 1) PG8_BAR; }
    }
    PG8_WAIT_V(0);
    if constexpr (!ALIGN_EPI) { if (wr == 0) PG8_BAR; }
    PG8_BAR;
#undef PG8_SA
#undef PG8_SB
#undef PG8_STAGE
#undef PG8_LDA
#undef PG8_LDB
#undef PG8_MMA
#undef PG8_WAIT_V
#undef PG8_WAIT_L
#undef PG8_BAR
#undef PG8_SCHED
}
}
constexpr int NWAVES = 8;
constexpr int DM = 1024, NB_P = 16, SEQ = 2048, NB_S = 8, TS = 64, PAST = 1024, NH = 16, HD = 64, EW = 2048;
constexpr int MP = NB_P * SEQ, MS = NB_S * TS, MT = MP + MS;
constexpr int N1 = 4 * EW, N3 = 4352;
constexpr float RMS_EPS = 1e-6f, LOG2E = 1.4426950408889634f;
constexpr size_t O_Y = 0, O_CONVP = (size_t)MT * DM, O_KP = O_CONVP + (size_t)NB_P * 2 * EW, O_VP = O_KP + (size_t)MP * DM, O_LP = O_VP + (size_t)MP * DM,
                 O_CONVS = O_LP + (size_t)MP * NH, O_KS = O_CONVS + (size_t)NB_S * 2 * EW, O_VS = O_KS + (size_t)MS * DM, O_LS = O_VS + (size_t)MS * DM, O_END = O_LS + (size_t)MS * NH;
static_assert(O_END == 102866944, "output size");
constexpr size_t MiB = 1u << 20;
constexpr size_t WS_CTL = 0, CTL_ZERO_BYTES = 1 * MiB;
constexpr size_t WS_MOD = 128 * 1024, WS_CNT = 16 * 1024;
constexpr size_t WS_W1 = 1 * MiB, WS_W2 = 17 * MiB, WS_W3 = 21 * MiB, WS_W4 = 30 * MiB;
constexpr size_t WS_H = 32 * MiB;
constexpr size_t WS_Y = 98 * MiB;
constexpr size_t WS_Q = WS_Y, WS_K = WS_Y + 65 * MiB, WS_V = 228 * MiB, WS_Z = 293 * MiB, WS_SLAB = 358 * MiB  , WS_AO = 374 * MiB  , WS_X = 439 * MiB  , WS_X1 = 440 * MiB  , WS_END = 504 * MiB;
static_assert((size_t)MT * DM * 2 == 65 * MiB && WS_W3 + (size_t)N3 * DM * 2 <= WS_W4 && WS_W4 + 2 * MiB <= WS_H, "ws map");
constexpr int RING_BYTES = 131072, XL_OFF = RING_BYTES, LDS_BYTES = 155648;
#define LAS __attribute__((address_space(3)))
typedef unsigned short bf16;
typedef unsigned v4u __attribute__((ext_vector_type(4)));
typedef unsigned v2u __attribute__((ext_vector_type(2)));
typedef float f32x4 __attribute__((ext_vector_type(4)));
typedef short bf16x8 __attribute__((ext_vector_type(8)));
#define LDS_WAIT() asm volatile("s_waitcnt lgkmcnt(0)" ::: "memory")
__device__ __forceinline__ unsigned f2bf(float f) { unsigned u = __builtin_bit_cast(unsigned, f); return (u + 0x7fffu + ((u >> 16) & 1u)) >> 16; }
__device__ __forceinline__ unsigned pk2(float lo, float hi) { return f2bf(lo) | (f2bf(hi) << 16); }
__device__ __forceinline__ float wave_sum(float v) {
#pragma unroll
    for (int o = 1; o < 64; o <<= 1) v += __shfl_xor(v, o);
    return v;
}

template <int MODE> __device__ __forceinline__ void p0_transpose_item(const float* W, int K, int N, bf16* WT, LAS float* scr, int item, int lane) {
    const int nblk = (N + 63) / 64, kb = item / nblk, nb = item % nblk, k0 = 64 * kb, n0 = 64 * nb;
    const int ks = lane >> 4, n4 = (lane & 15) * 4, ncol = min(n0 + n4, N - 4);
    f32x4 v[16];
#pragma unroll
    for (int i = 0; i < 16; ++i) v[i] = __builtin_nontemporal_load((const f32x4*)(W + (size_t)(k0 + 4 * i + ks) * N + ncol));
#pragma unroll
    for (int i = 0; i < 16; ++i) { LAS float* d = scr + (4 * i + ks) * 65 + n4; d[0] = v[i].x; d[1] = v[i].y; d[2] = v[i].z; d[3] = v[i].w; }
    LDS_WAIT(); asm volatile("" ::: "memory");
    const int c = lane & 7;
#pragma unroll
    for (int j = 0; j < 8; ++j) { const int n = (lane >> 3) + 8 * j; const LAS float* s = scr + (8 * c) * 65 + n;
        v4u o; o.x = pk2(s[0 * 65], s[1 * 65]); o.y = pk2(s[2 * 65], s[3 * 65]); o.z = pk2(s[4 * 65], s[5 * 65]); o.w = pk2(s[6 * 65], s[7 * 65]);
        int drow = n0 + n;
        if (MODE == 1) { const int g = drow >> 11, e = drow & 2047, pn = e >> 6, ch = e & 63; drow = pn * 256 + (g >> 1) * 128 + (ch >> 4) * 32 + (g & 1) * 16 + (ch & 15); }
        *(v4u*)(WT + (size_t)drow * K + k0 + 8 * c) = o; }
    LDS_WAIT(); asm volatile("" ::: "memory");
}
__device__ __forceinline__ void ada_norm_row(const float* xrow, bf16* orow, const float* g, const float* mod, int lane, const float* slab = nullptr, const float* gate = nullptr, float* xst = nullptr) {
    const f32x4* xr = (const f32x4*)xrow + lane;
    f32x4 v[4]; float s = 0.f;
#pragma unroll
    for (int j = 0; j < 4; ++j) { v[j] = xr[64 * j];
        if (slab) { f32x4 p = ((const f32x4*)slab)[64 * j + lane];
#pragma unroll
            for (int q = 1; q < 8; ++q) p += ((const f32x4*)(slab + (size_t)q * 512 * 1024))[64 * j + lane];
            v[j] += ((const f32x4*)gate)[64 * j + lane] * p; ((f32x4*)xst)[64 * j + lane] = v[j]; }
        s += (v[j].x * v[j].x + v[j].y * v[j].y) + (v[j].z * v[j].z + v[j].w * v[j].w); }
    const float rstd = 1.f / sqrtf(wave_sum(s) * (1.f / DM) + RMS_EPS);
    unsigned long long* o8 = (unsigned long long*)orow + lane;
#pragma unroll
    for (int j = 0; j < 4; ++j) { const f32x4 gg = ((const f32x4*)g)[64 * j + lane], sh = ((const f32x4*)mod)[64 * j + lane], sc = ((const f32x4*)(mod + DM))[64 * j + lane];
        const f32x4 h = v[j] * rstd * gg * (sc + 1.0f) + sh;
        o8[64 * j] = (unsigned long long)pk2(h.x, h.y) | ((unsigned long long)pk2(h.z, h.w) << 32); }
}
__device__ __forceinline__ void ada_norm_rows(const float* x0, bf16* o0, int nrows, const float* g, const float* mod, int lane) {
    f32x4 gm[4], sh[4];
#pragma unroll
    for (int j = 0; j < 4; ++j) { gm[j] = ((const f32x4*)g)[64 * j + lane] * (((const f32x4*)(mod + DM))[64 * j + lane] + 1.0f); sh[j] = ((const f32x4*)mod)[64 * j + lane]; }
    f32x4 v[4], w[4];
#pragma unroll
    for (int j = 0; j < 4; ++j) v[j] = __builtin_nontemporal_load((const f32x4*)x0 + 64 * j + lane);
    for (int r = 0; r < nrows; ++r) {
        const float* xn = x0 + (size_t)(r + 1 < nrows ? r + 1 : r) * DM;
#pragma unroll
        for (int j = 0; j < 4; ++j) w[j] = __builtin_nontemporal_load((const f32x4*)xn + 64 * j + lane);
        float s = 0.f;
#pragma unroll
        for (int j = 0; j < 4; ++j) s += (v[j].x * v[j].x + v[j].y * v[j].y) + (v[j].z * v[j].z + v[j].w * v[j].w);
        const float rstd = 1.f / sqrtf(wave_sum(s) * (1.f / DM) + RMS_EPS);
        unsigned long long* o8 = (unsigned long long*)(o0 + (size_t)r * DM) + lane;
#pragma unroll
        for (int j = 0; j < 4; ++j) { const f32x4 h = v[j] * rstd * gm[j] + sh[j]; o8[64 * j] = (unsigned long long)pk2(h.x, h.y) | ((unsigned long long)pk2(h.z, h.w) << 32); v[j] = w[j]; }
    }
}
__device__ __forceinline__ void final_norm_row(float* xrow, const float* g, int lane, const float* slab = nullptr, const float* gate = nullptr) {
    f32x4* xr = (f32x4*)xrow + lane;
    f32x4 v[4]; float s = 0.f;
#pragma unroll
    for (int j = 0; j < 4; ++j) { v[j] = xr[64 * j];
        if (slab) { f32x4 p = ((const f32x4*)slab)[64 * j + lane];
#pragma unroll
            for (int q = 1; q < 8; ++q) p += ((const f32x4*)(slab + (size_t)q * 512 * 1024))[64 * j + lane];
            v[j] += ((const f32x4*)gate)[64 * j + lane] * p; }
        s += (v[j].x * v[j].x + v[j].y * v[j].y) + (v[j].z * v[j].z + v[j].w * v[j].w); }
    const float rstd = 1.f / sqrtf(wave_sum(s) * (1.f / DM) + RMS_EPS);
#pragma unroll
    for (int j = 0; j < 4; ++j) xr[64 * j] = v[j] * rstd * ((const f32x4*)g)[64 * j + lane];
}
__device__ __forceinline__ void block_scan4(f32x4 v, float* dst, LAS float* wtot, int tid, int nthr) {
    const int lane = tid & 63, wave = tid >> 6;
    v.y += v.x; v.z += v.y; v.w += v.z;
    float incl = v.w;
#pragma unroll
    for (int o = 1; o < 64; o <<= 1) { const float t = __builtin_bit_cast(float, __builtin_amdgcn_ds_bpermute((lane - o) << 2, __builtin_bit_cast(int, incl))); if (lane >= o) incl += t; }
    if (lane == 63) wtot[wave] = incl;
    LDS_WAIT(); __builtin_amdgcn_s_barrier(); asm volatile("" ::: "memory");
    float base = incl - v.w;
    for (int w = 0; w < wave; ++w) base += wtot[w];
    if (tid < nthr) *(f32x4*)(dst + 4 * tid) = (v + base) * (-LOG2E);
    LDS_WAIT(); __builtin_amdgcn_s_barrier(); asm volatile("" ::: "memory");
}
namespace attn_body {
using bf16=__hip_bfloat16;
using bf16x8=__attribute__((ext_vector_type(8)))short;
using s16x4=__attribute__((ext_vector_type(4)))short;
using f32x16=__attribute__((ext_vector_type(16)))float;
using u32x4=__attribute__((ext_vector_type(4)))unsigned;
using f32x4=__attribute__((ext_vector_type(4)))float;
constexpr int BATCH=16,NHEAD=16,SEQ=2048,D=64,DM=NHEAD*D;
constexpr int NW=8,QBLK=32,QB=QBLK*NW,KVBLK=64,NQB=SEQ/QB;
constexpr int ATTN_PITCH=DM, ATTN_UNIT_ROWS=QB;
__device__ __forceinline__ int crow(int r,int hi){return (r&3)+8*(r>>2)+4*hi;}
#define SBAR() __builtin_amdgcn_sched_barrier(0)
__device__ __forceinline__ void cmask(f32x16&p0,f32x16&p1,int jb,int qrel,int hi){
  const float NEG=-INFINITY; int kb=64*jb+4*hi;
  #pragma unroll
  for(int r=0;r<16;++r){int kv=kb+(r&3)+8*(r>>2); if(kv>qrel)p0[r]=NEG; if(kv+32>qrel)p1[r]=NEG;}
}

constexpr int NSLOT=3, SLOTB=8192;
constexpr int LDS_K=0, LDS_V=NSLOT*SLOTB, LDS_WS=2*NSLOT*SLOTB, LDS_OST=LDS_WS+NW*64*4, LDS_BYTES=LDS_OST+NW*4096;
constexpr float C2=0.125f*1.4426950408889634f;
__device__ __forceinline__ void glds16(const void*gsrc,unsigned lds_dst){unsigned keep;
  asm volatile("s_mov_b32 %0, m0\n\ts_mov_b32 m0, %2\n\ts_nop 0\n\tglobal_load_lds_dwordx4 %1, off\n\ts_mov_b32 m0, %0":"=&s"(keep):"v"(gsrc),"s"(lds_dst):"memory");}
__device__ __forceinline__ float max3f(float a,float b,float c){float r;asm("v_max3_f32 %0, %1, %2, %3":"=v"(r):"v"(a),"v"(b),"v"(c));return r;}
__device__ __forceinline__ float max2f(float a,float b){float r;asm("v_max_f32_e32 %0, %1, %2":"=v"(r):"v"(a),"v"(b));return r;}
__device__ __forceinline__ float fadd_s(float a,float b){float r;asm("v_add_f32_e32 %0, %1, %2":"=v"(r):"v"(a),"v"(b));return r;}
__device__ __forceinline__ float fsub_s(float a,float b){float r;asm("v_sub_f32_e32 %0, %1, %2":"=v"(r):"v"(a),"v"(b));return r;}
typedef float f32x2_t __attribute__((ext_vector_type(2))); typedef __bf16 bf16x2_t __attribute__((ext_vector_type(2)));
__device__ __forceinline__ unsigned cvtpk_s(float lo,float hi){f32x2_t v={lo,hi};bf16x2_t b=__builtin_convertvector(v,bf16x2_t);return __builtin_bit_cast(unsigned,b);}
#define WAIT_BAR(N) asm volatile("s_waitcnt vmcnt(" #N ") lgkmcnt(0)\n\ts_barrier":::"memory")

__device__ __forceinline__ void qkt(f32x16&p0,f32x16&p1,const char*Kslot,const bf16x8*qr,int r32,int hi){
  const char*kb=Kslot+hi*1024+r32*16;
  #pragma unroll
  for(int d0=0;d0<4;++d0){
    const bf16x8 b0=*reinterpret_cast<const bf16x8*>(kb+d0*2048);
    const bf16x8 b1=*reinterpret_cast<const bf16x8*>(kb+d0*2048+512);
    {p0=__builtin_amdgcn_mfma_f32_32x32x16_bf16(b0,qr[d0],p0,0,0,0);p1=__builtin_amdgcn_mfma_f32_32x32x16_bf16(b1,qr[d0],p1,0,0,0);}}
}
typedef __attribute__((address_space(3))) const char* lds_cptr;
typedef short v4i16_t __attribute__((ext_vector_type(4)));
__device__ __forceinline__ void kload8(bf16x8*kf,lds_cptr kp){
  kf[0]=*(const __attribute__((address_space(3))) bf16x8*)(kp);      kf[1]=*(const __attribute__((address_space(3))) bf16x8*)(kp+512);
  kf[2]=*(const __attribute__((address_space(3))) bf16x8*)(kp+2048); kf[3]=*(const __attribute__((address_space(3))) bf16x8*)(kp+2560);
  kf[4]=*(const __attribute__((address_space(3))) bf16x8*)(kp+4096); kf[5]=*(const __attribute__((address_space(3))) bf16x8*)(kp+4608);
  kf[6]=*(const __attribute__((address_space(3))) bf16x8*)(kp+6144); kf[7]=*(const __attribute__((address_space(3))) bf16x8*)(kp+6656);
}
__device__ __forceinline__ void kload2(bf16x8*kf,lds_cptr kp,int j){ kf[2*j]=*(const __attribute__((address_space(3))) bf16x8*)(kp+j*2048); kf[2*j+1]=*(const __attribute__((address_space(3))) bf16x8*)(kp+j*2048+512); }
__device__ __forceinline__ s16x4 vtr(lds_cptr p){ return __builtin_bit_cast(s16x4,__builtin_amdgcn_ds_read_tr16_b64_v4i16((__attribute__((address_space(3))) v4i16_t*)p)); }
__device__ __forceinline__ float rowmax(const f32x16&p0,const f32x16&p1){
  float a=max3f(p0[0],p0[1],p1[0]),b=max3f(p0[2],p0[3],p1[1]);a=max3f(a,p1[2],p1[3]);
  #pragma unroll
  for(int r=4;r<16;r+=4){a=max3f(a,p0[r],p0[r+1]);b=max3f(b,p0[r+2],p0[r+3]);a=max3f(a,p1[r],p1[r+1]);b=max3f(b,p1[r+2],p1[r+3]);}
  const float m=max2f(a,b);
  auto rr=__builtin_amdgcn_permlane32_swap(__float_as_uint(m),__float_as_uint(m),false,false);
  return max2f(__uint_as_float(rr[0]),__uint_as_float(rr[1]));
}
__device__ __forceinline__ void pv(f32x16*o,int vb,bf16x8 pa0,bf16x8 pa1,bf16x8 pa2,bf16x8 pa3){
  #pragma unroll
  for(int d0=0;d0<2;++d0){s16x4 lo[4],hi[4];
    #pragma unroll
    for(int ks=0;ks<4;++ks){
      asm volatile("ds_read_b64_tr_b16 %0,%1 offset:%c2":"=&v"(lo[ks]):"v"(vb),"i"(d0*4096+ks*1024):"memory");
      asm volatile("ds_read_b64_tr_b16 %0,%1 offset:%c2":"=&v"(hi[ks]):"v"(vb),"i"(d0*4096+ks*1024+512):"memory");}
    asm volatile("s_waitcnt lgkmcnt(0)":::"memory");SBAR();
    #define PK(k) (bf16x8){lo[k][0],lo[k][1],lo[k][2],lo[k][3],hi[k][0],hi[k][1],hi[k][2],hi[k][3]}
    o[d0]=__builtin_amdgcn_mfma_f32_32x32x16_bf16(pa0,PK(0),o[d0],0,0,0);
    o[d0]=__builtin_amdgcn_mfma_f32_32x32x16_bf16(pa1,PK(1),o[d0],0,0,0);
    o[d0]=__builtin_amdgcn_mfma_f32_32x32x16_bf16(pa2,PK(2),o[d0],0,0,0);
    o[d0]=__builtin_amdgcn_mfma_f32_32x32x16_bf16(pa3,PK(3),o[d0],0,0,0);
    #undef PK
  }
}

#ifndef ATTN_STORE16
#define ATTN_STORE16(p,v) (*(u32x4*)(p)=(v))
#endif
template<int THRL> __device__ __forceinline__ void attn_unit(int b,int h,int qb,const bf16*Q,const bf16*__restrict__ K,const bf16*__restrict__ V,const bf16*__restrict__ Zs,bf16*O,char*shm,const float*biasL,float*Kf,float*Vf){
  int tid=threadIdx.x; asm volatile("":"+v"(tid)); const int lane=tid&63,r32=lane&31,hi=lane>>5; const int wid=__builtin_amdgcn_readfirstlane(tid>>6);
  const long rowbase=(long)b*SEQ; const int q0=qb*QB;
  const bf16*Qw=Q+(rowbase+q0+wid*QBLK)*DM+h*D;
  const bf16*Kh=K+rowbase*DM+h*D,*Vh=V+rowbase*DM+h*D;
  const unsigned lds0=(unsigned)(uintptr_t)shm;
  float*wsf=(float*)(shm+LDS_WS)+wid*64;
  const bf16*ksrc=Kh+(long)lane*DM+wid*8;
  const bf16*vsrc=Vh+(long)(16*(wid&3)+(lane>>2))*DM+(wid>>2)*32+(lane&3)*8;
  const unsigned kdst=lds0+LDS_K+wid*1024, vdst=lds0+LDS_V+wid*1024;
  #define DMA_K(t,slot) glds16(ksrc+(long)(t)*KVBLK*DM,(unsigned)__builtin_amdgcn_readfirstlane(kdst+(slot)))
  #define DMA_V(t,slot) glds16(vsrc+(long)(t)*KVBLK*DM,(unsigned)__builtin_amdgcn_readfirstlane(vdst+(slot)))
  const int vb0=(int)(lds0+LDS_V)+((lane>>4)&1)*32+(lane&3)*8+(4*hi+((lane&15)>>2))*64;
  const char*Kbase=shm+LDS_K; bf16x8 kf[8];
  const lds_cptr shm3=(lds_cptr)shm; const lds_cptr kp0=shm3+LDS_K+hi*1024+r32*16; const lds_cptr vp0=shm3+LDS_V+((lane>>4)&1)*32+(lane&3)*8+(4*hi+((lane&15)>>2))*64;
  const int NT=(q0+QB)/KVBLK;
  DMA_K(0,0);DMA_V(0,0);DMA_K(1,SLOTB);
  bf16x8 qr[4];
  #pragma unroll
  for(int d0=0;d0<4;++d0)qr[d0]=*reinterpret_cast<const bf16x8*>(&Qw[(long)r32*DM+d0*16+hi*8]);
  float mhat=0.f,l_reg=0.f;f32x16 o[2];o[0]=f32x16{};o[1]=f32x16{};
  const int qrel=wid*QBLK+r32;
  #define BINITH(X,t,off) do{ const float*bp_=biasL+(t)*KVBLK+4*hi+(off); \
    _Pragma("unroll") for(int j_=0;j_<4;++j_){ const f32x4 a_=*(const f32x4*)(bp_+8*j_); \
      _Pragma("unroll") for(int i_=0;i_<4;++i_){ X[4*j_+i_]=a_[i_]-mhat; } } }while(0)
  #define BINIT(X0,X1,t) do{ BINITH(X0,t,0); BINITH(X1,t,32); }while(0)
  #define CMASK(P0,P1,t) do{int jb_=(t)-(NT-4); if(jb_>=0)cmask(P0,P1,jb_,qrel,hi);}while(0)
  bool resc=false;
  #define START(P0,P1) do{ const float rm=rowmax(P0,P1); resc=false; \
    { const float dl=rm; mhat=fadd_s(mhat,dl); \
      _Pragma("unroll") for(int r=0;r<16;++r){P0[r]=fsub_s(P0[r],dl);P1[r]=fsub_s(P1[r],dl);} \
      } \
    _Pragma("unroll") for(int r=0;r<16;++r)P0[r]=__builtin_amdgcn_exp2f(P0[r]); }while(0)
  #define RESC() do{ if(resc){ asm volatile("s_waitcnt lgkmcnt(0)":::"memory"); \
      _Pragma("unroll") for(int d_=0;d_<2;++d_) _Pragma("unroll") for(int r=0;r<16;++r)o[d_][r]*=wsf[crow(r,hi)]; } }while(0)
  f32x16 pA0,pA1,pB0,pB1;
  int sl_prev=0,sl_cur=0,sl_next=SLOTB;
  #define ROT() do{sl_prev=sl_cur;sl_cur=sl_next;sl_next=(sl_next==(NSLOT-1)*SLOTB)?0:sl_next+SLOTB;}while(0)
  DMA_K(2,2*SLOTB);
  WAIT_BAR(3);
  BINIT(pA0,pA1,0); qkt(pA0,pA1,Kbase,qr,r32,hi);asm volatile("s_nop 15\n\ts_nop 7":"+v"(pA0),"+v"(pA1));CMASK(pA0,pA1,0);
  START(pA0,pA1);
  BINIT(pB0,pB1,1);
  _Pragma("unroll") for(int r=0;r<16;++r)pA1[r]=__builtin_amdgcn_exp2f(pA1[r]);
  WAIT_BAR(0);
  DMA_K(3,0);DMA_V(1,SLOTB);
  ROT();
  kload8(kf,kp0+sl_cur);
  WAIT_BAR(2);
  s16x4 vlo[8],vhi[8]; u32x4 pw0,pw1,pw2,pw3;
  #define PKW(P,B) cvtpk_s(P[B],P[B+1])
  #define PAF(k) __builtin_bit_cast(bf16x8,pw##k)
  #define VFR(i) (bf16x8){vlo[i][0],vlo[i][1],vlo[i][2],vlo[i][3],vhi[i][0],vhi[i][1],vhi[i][2],vhi[i][3]}
  #define PIN(x) asm volatile("":"+v"(x))
  #define MX3(a,b,c) __builtin_fmaxf(__builtin_fmaxf((a),(b)),(c))
  #define GAPA(MF,A0,A1,A2,A3,W0,W1,PW) do{ MF; sacc+=A0; sacc+=A1; sacc+=A2; sacc+=A3; PIN(sacc); W0; W1; PIN(PW); SBAR(); }while(0)
  #define EX(v) __builtin_amdgcn_exp2f(v)
  #define GAPB(MF,X,B,GN,Y) do{ MF; X[B]=EX(X[B]); X[B+1]=EX(X[B+1]); X[B+2]=EX(X[B+2]); X[B+3]=EX(X[B+3]); PIN(X); if(GN){ Y[B]-=mhat; Y[B+1]-=mhat; Y[B+2]-=mhat; Y[B+3]-=mhat; PIN(Y); } SBAR(); }while(0)
  #define BLOAD(X0,X1,t) do{ const float*bp_=biasL+(t)*KVBLK+4*hi; \
    _Pragma("unroll") for(int j_=0;j_<4;++j_){ const f32x4 a_=*(const f32x4*)(bp_+8*j_), b_=*(const f32x4*)(bp_+32+8*j_); \
      _Pragma("unroll") for(int i_=0;i_<4;++i_){ X0[4*j_+i_]=a_[i_]; X1[4*j_+i_]=b_[i_]; } } }while(0)
  #define VRD(i) do{ vlo[i]=vtr(vp_+(((i)>>2)*4096+((i)&3)*1024)); vhi[i]=vtr(vp_+(((i)>>2)*4096+((i)&3)*1024+512)); }while(0)
  #define KRD(G,j) do{ if(G){ kload2(kf,kp0+sl_next,j); SBAR(); } }while(0)
  #define STEP(C0,C1,P0,P1,t,GK,GV,GL) do{ SBAR(); \
    const lds_cptr vp_=vp0+sl_prev; \
    VRD(0); SBAR(); float sacc=(P0[0]+P0[1]); \
    GAPA(C0=__builtin_amdgcn_mfma_f32_32x32x16_bf16(kf[0],qr[0],C0,0,0,0), P0[2],P0[3],P0[4],P0[5],     pw0[0]=PKW(P0,0), pw0[1]=PKW(P0,2), pw0); \
    VRD(4); SBAR(); GAPA(C1=__builtin_amdgcn_mfma_f32_32x32x16_bf16(kf[1],qr[0],C1,0,0,0), P0[6],P0[7],P0[8],P0[9],     pw0[2]=PKW(P0,4), pw0[3]=PKW(P0,6), pw0); \
    VRD(1); SBAR(); GAPA(C0=__builtin_amdgcn_mfma_f32_32x32x16_bf16(kf[2],qr[1],C0,0,0,0),   P0[10],P0[11],P0[12],P0[13], pw1[0]=PKW(P0,8), pw1[1]=PKW(P0,10), pw1); \
    VRD(5); SBAR(); GAPA(C1=__builtin_amdgcn_mfma_f32_32x32x16_bf16(kf[3],qr[1],C1,0,0,0),   P0[14],P0[15],P1[0],P1[1],   pw1[2]=PKW(P0,12),pw1[3]=PKW(P0,14), pw1); \
    VRD(2); SBAR(); GAPA(C0=__builtin_amdgcn_mfma_f32_32x32x16_bf16(kf[4],qr[2],C0,0,0,0),   P1[2],P1[3],P1[4],P1[5],     pw2[0]=PKW(P1,0), pw2[1]=PKW(P1,2), pw2); \
    VRD(6); SBAR(); GAPA(C1=__builtin_amdgcn_mfma_f32_32x32x16_bf16(kf[5],qr[2],C1,0,0,0),   P1[6],P1[7],P1[8],P1[9],     pw2[2]=PKW(P1,4), pw2[3]=PKW(P1,6), pw2); \
    VRD(3); SBAR(); GAPA(C0=__builtin_amdgcn_mfma_f32_32x32x16_bf16(kf[6],qr[3],C0,0,0,0),   P1[10],P1[11],P1[12],P1[13], pw3[0]=PKW(P1,8), pw3[1]=PKW(P1,10), pw3); \
    VRD(7); SBAR(); GAPA(C1=__builtin_amdgcn_mfma_f32_32x32x16_bf16(kf[7],qr[3],C1,0,0,0),   P1[14],P1[15],0.f,0.f,       pw3[2]=PKW(P1,12),pw3[3]=PKW(P1,14), pw3); \
    l_reg+=sacc; \
    if(GK){DMA_K((t)+3,sl_cur);} if(GV){DMA_V((t)+1,sl_next);} \
    CMASK(C0,C1,t); \
    { float a=MX3(C0[0],C0[1],C1[0]),b=MX3(C0[2],C0[3],C1[1]); a=MX3(a,C1[2],C1[3]); \
      _Pragma("unroll") for(int r=4;r<16;r+=4){a=MX3(a,C0[r],C0[r+1]);b=MX3(b,C0[r+2],C0[r+3]);a=MX3(a,C1[r],C1[r+1]);b=MX3(b,C1[r+2],C1[r+3]);} \
      float rm=__builtin_fmaxf(a,b); { auto rr=__builtin_amdgcn_permlane32_swap(__float_as_uint(rm),__float_as_uint(rm),false,false); rm=__builtin_fmaxf(__uint_as_float(rr[0]),__uint_as_float(rr[1])); } \
      resc=false; \
      if(__builtin_expect(__any(rm>(float)THRL),0)){ const float dl=__builtin_fmaxf(rm,0.f); mhat+=dl; \
        _Pragma("unroll") for(int r=0;r<16;++r){C0[r]-=dl;C1[r]-=dl;} \
        const float f=__builtin_amdgcn_exp2f(-dl); l_reg*=f; if(hi==0)wsf[r32]=f; resc=true; } } \
    SBAR(); if(GL){ BLOAD(P0,P1,(t)+1); } SBAR(); \
    GAPB(o[0]=__builtin_amdgcn_mfma_f32_32x32x16_bf16(PAF(0),VFR(0),o[0],0,0,0), C0,0,GL,P0); \
    GAPB(o[1]=__builtin_amdgcn_mfma_f32_32x32x16_bf16(PAF(0),VFR(4),o[1],0,0,0), C0,4,GL,P0); \
    KRD(GL,0); GAPB(o[0]=__builtin_amdgcn_mfma_f32_32x32x16_bf16(PAF(1),VFR(1),o[0],0,0,0), C0,8,GL,P0); \
    KRD(GL,1); GAPB(o[1]=__builtin_amdgcn_mfma_f32_32x32x16_bf16(PAF(1),VFR(5),o[1],0,0,0), C0,12,GL,P0); \
    KRD(GL,2); GAPB(o[0]=__builtin_amdgcn_mfma_f32_32x32x16_bf16(PAF(2),VFR(2),o[0],0,0,0), C1,0,GL,P1); \
    KRD(GL,3); GAPB(o[1]=__builtin_amdgcn_mfma_f32_32x32x16_bf16(PAF(2),VFR(6),o[1],0,0,0), C1,4,GL,P1); \
    GAPB(o[0]=__builtin_amdgcn_mfma_f32_32x32x16_bf16(PAF(3),VFR(3),o[0],0,0,0), C1,8,GL,P1); \
    GAPB(o[1]=__builtin_amdgcn_mfma_f32_32x32x16_bf16(PAF(3),VFR(7),o[1],0,0,0), C1,12,GL,P1); \
    }while(0)
  int t=1;
  #undef CMASK
  #define CMASK(P0,P1,t) do{}while(0)
  for(;t+5<NT;t+=2){
    STEP(pB0,pB1,pA0,pA1,t,true,true,true);     WAIT_BAR(2); RESC(); ROT();
    STEP(pA0,pA1,pB0,pB1,t+1,true,true,true);   WAIT_BAR(2); RESC(); ROT();
  }
  #undef CMASK
  #define CMASK(P0,P1,t) do{int jb_=(t)-(NT-4); if(jb_>=0)cmask(P0,P1,jb_,qrel,hi);}while(0)
  #define ENDW(tt) do{ if((tt)+3<NT){WAIT_BAR(2);} else if((tt)+2<NT){WAIT_BAR(1);} else {WAIT_BAR(0);} }while(0)
  for(;t+1<NT;t+=2){
    STEP(pB0,pB1,pA0,pA1,t,(t+3<NT),(t+1<NT),(t+1<NT));       ENDW(t);   RESC(); ROT();
    STEP(pA0,pA1,pB0,pB1,t+1,(t+4<NT),(t+2<NT),(t+2<NT));     ENDW(t+1); RESC(); ROT();
  }
  STEP(pB0,pB1,pA0,pA1,NT-1,false,false,false); RESC();
  u32x4 kcv[4],vcv[4]; { const bf16*Kw=K+(rowbase+q0+wid*QBLK)*DM+h*D; const bf16*Vw=V+(rowbase+q0+wid*QBLK)*DM+h*D;
    _Pragma("unroll") for(int i=0;i<4;++i){ const int row=i*8+(lane>>3),ch=lane&7; kcv[i]=*(const u32x4*)(Kw+(long)row*DM+ch*8); vcv[i]=*(const u32x4*)(Vw+(long)row*DM+ch*8); } }
  u32x4 zpre[4]; { const bf16*Zw=Zs+(rowbase+q0+wid*QBLK)*DM+h*D;
    _Pragma("unroll") for(int i=0;i<4;++i){ const int row=i*8+(lane>>3),ch=lane&7; zpre[i]=*(const u32x4*)(Zw+(long)row*DM+ch*8); } }
  { float sacc=pB0[0]+pB0[1]; _Pragma("unroll") for(int r=2;r<16;++r)sacc+=pB0[r]; _Pragma("unroll") for(int r=0;r<16;++r)sacc+=pB1[r]; l_reg+=sacc;
    pw0=(u32x4){PKW(pB0,0),PKW(pB0,2),PKW(pB0,4),PKW(pB0,6)};pw1=(u32x4){PKW(pB0,8),PKW(pB0,10),PKW(pB0,12),PKW(pB0,14)};pw2=(u32x4){PKW(pB1,0),PKW(pB1,2),PKW(pB1,4),PKW(pB1,6)};pw3=(u32x4){PKW(pB1,8),PKW(pB1,10),PKW(pB1,12),PKW(pB1,14)};
    SBAR(); pv(o,vb0+sl_cur,PAF(0),PAF(1),PAF(2),PAF(3)); }
  #undef PKW
  #undef PAF
  #undef VFR
  #undef PIN
  #undef MX3
  #undef GAPA
  #undef GAPB
  #undef BLOAD
  #undef EX
  #undef VRD
  #undef KRD
  #undef STEP
  #undef ENDW
  {auto rr=__builtin_amdgcn_permlane32_swap(__float_as_uint(l_reg),__float_as_uint(l_reg),false,false);l_reg=__uint_as_float(rr[0])+__uint_as_float(rr[1]);}
  if(hi==0)wsf[32+r32]=l_reg;asm volatile("s_waitcnt lgkmcnt(0)":::"memory");
  float rli[16];
  #pragma unroll
  for(int r=0;r<16;++r)rli[r]=__builtin_amdgcn_rcpf(wsf[32+crow(r,hi)]);
  bf16*Ow=O+(rowbase+q0+wid*QBLK)*DM+h*D;
  { bf16*stg=(bf16*)(shm+LDS_OST)+wid*2048;
    #pragma unroll
    for(int r=0;r<16;++r){const int orow=crow(r,hi);
      #pragma unroll
      for(int d0=0;d0<2;++d0)stg[orow*64+d0*32+r32]=__float2bfloat16(o[d0][r]*rli[r]);}
    asm volatile("s_waitcnt lgkmcnt(0)":::"memory");
    int lane_e=lane; asm volatile("":"+v"(lane_e));
    #pragma unroll
    for(int i=0;i<4;++i){const int lane=lane_e; const bf16*Zw=Zs+(rowbase+q0+wid*QBLK)*DM+h*D; const int row=i*8+(lane>>3),ch=lane&7; const u32x4 v=*(const u32x4*)(stg+row*64+ch*8); const u32x4 z=zpre[i]; u32x4 w;
      _Pragma("unroll") for(int e=0;e<4;++e){ const float a0=__uint_as_float(v[e]<<16)*__uint_as_float(z[e]<<16), a1=__uint_as_float(v[e]&0xffff0000u)*__uint_as_float(z[e]&0xffff0000u); w[e]=cvtpk_s(a0,a1); }
      ATTN_STORE16(Ow+(long)row*DM+ch*8,w);
      { float*kd=Kf+(rowbase+q0+wid*QBLK+row)*DM+h*D+ch*8; float*vd=Vf+(rowbase+q0+wid*QBLK+row)*DM+h*D+ch*8; const u32x4 kw=kcv[i],vw=vcv[i];
        __builtin_nontemporal_store((f32x4){__uint_as_float(kw[0]<<16),__uint_as_float(kw[0]&0xffff0000u),__uint_as_float(kw[1]<<16),__uint_as_float(kw[1]&0xffff0000u)},(f32x4*)kd);
        __builtin_nontemporal_store((f32x4){__uint_as_float(kw[2]<<16),__uint_as_float(kw[2]&0xffff0000u),__uint_as_float(kw[3]<<16),__uint_as_float(kw[3]&0xffff0000u)},(f32x4*)(kd+4));
        __builtin_nontemporal_store((f32x4){__uint_as_float(vw[0]<<16),__uint_as_float(vw[0]&0xffff0000u),__uint_as_float(vw[1]<<16),__uint_as_float(vw[1]&0xffff0000u)},(f32x4*)vd);
        __builtin_nontemporal_store((f32x4){__uint_as_float(vw[2]<<16),__uint_as_float(vw[2]&0xffff0000u),__uint_as_float(vw[3]<<16),__uint_as_float(vw[3]&0xffff0000u)},(f32x4*)(vd+4)); } } }
  asm volatile("s_waitcnt lgkmcnt(0)\n\ts_barrier":::"memory");
  #undef DMA_K
  #undef DMA_V
  #undef CMASK
  #undef START
  #undef RESC
  #undef BINIT
  #undef BINITH
  #undef ROT
}
constexpr int ATTN_LDS_BYTES=LDS_BYTES;
__device__ __forceinline__ void sample_unit(int b,int h,int qblk,const bf16*Q,const bf16*Kb,const bf16*Vb,const bf16*Zs,bf16*O,
    const float*__restrict__ ck,const float*__restrict__ cv,const float*__restrict__ clf,const float*__restrict__ lfs,char*shm){
  int tid=threadIdx.x; asm volatile("":"+v"(tid)); const int lane=tid&63,r32=lane&31,hi=lane>>5; const int wid=__builtin_amdgcn_readfirstlane(tid>>6);
  constexpr int S_V=0,S_O=65536,S_ML=131072,S_BIAS=133120,S_WT=137728; constexpr long SROW0=32768;
  float*biasS=(float*)(shm+S_BIAS);
  { f32x4 v=(f32x4){0.f,0.f,0.f,0.f};
    if(tid<272){
      #pragma unroll
      for(int i=0;i<4;++i){const int p=4*tid+i; v[i]= p<1024 ? clf[((size_t)b*1024+p)*16+h] : lfs[((size_t)b*64+(p-1024))*16+h];} }
    block_scan4(v,biasS,(LAS float*)(shm+S_WT),tid,272); }
  const bf16*Qw=Q+(SROW0+b*64+qblk*32)*DM+h*D;
  bf16x8 qr[4];
  #pragma unroll
  for(int d0=0;d0<4;++d0)qr[d0]=*reinterpret_cast<const bf16x8*>(&Qw[(long)r32*DM+d0*16+hi*8]);
  f32x16 P[3][2];
  #define SU_BIAS(acc,t,hf) do{ const float*bp=biasS+64*(t)+32*(hf)+4*hi; \
      _Pragma("unroll") for(int j=0;j<4;++j){ const f32x4 a=*(const f32x4*)(bp+8*j); _Pragma("unroll") for(int e=0;e<4;++e)acc[4*j+e]=a[e]; } }while(0)
  #pragma unroll
  for(int i=0;i<2;++i){ const int t=wid+8*i;
    #pragma unroll
    for(int hf=0;hf<2;++hf){
      bf16x8 kf[4];
      const float*kp=ck+(((size_t)b*1024+64*t+32*hf+r32)*16+h)*64+hi*8;
      #pragma unroll
      for(int d0=0;d0<4;++d0){ const f32x4 a=*(const f32x4*)(kp+d0*16),c=*(const f32x4*)(kp+d0*16+4);
        u32x4 w; w[0]=cvtpk_s(a[0],a[1]); w[1]=cvtpk_s(a[2],a[3]); w[2]=cvtpk_s(c[0],c[1]); w[3]=cvtpk_s(c[2],c[3]); kf[d0]=__builtin_bit_cast(bf16x8,w);}
      f32x16 acc; SU_BIAS(acc,t,hf);
      #pragma unroll
      for(int d0=0;d0<4;++d0)acc=__builtin_amdgcn_mfma_f32_32x32x16_bf16(kf[d0],qr[d0],acc,0,0,0);
      P[i][hf]=acc; } }
  if(wid==0){
    #pragma unroll
    for(int hf=0;hf<2;++hf){
      bf16x8 kf[4]; const bf16*kp=Kb+(SROW0+b*64+32*hf+r32)*DM+h*D+hi*8;
      #pragma unroll
      for(int d0=0;d0<4;++d0)kf[d0]=*reinterpret_cast<const bf16x8*>(kp+d0*16);
      f32x16 acc; SU_BIAS(acc,16,hf);
      #pragma unroll
      for(int d0=0;d0<4;++d0)acc=__builtin_amdgcn_mfma_f32_32x32x16_bf16(kf[d0],qr[d0],acc,0,0,0);
      #pragma unroll
      for(int r=0;r<16;++r){ if(crow(r,hi)+32*hf>32*qblk+r32)acc[r]=-INFINITY; }
      P[2][hf]=acc; }
  } else {
    #pragma unroll
    for(int hf=0;hf<2;++hf){
      #pragma unroll
      for(int r=0;r<16;++r)P[2][hf][r]=-INFINITY; }
  }
  #undef SU_BIAS
  float m=-INFINITY;
  #pragma unroll
  for(int i=0;i<3;++i){
    #pragma unroll
    for(int hf=0;hf<2;++hf){
      #pragma unroll
      for(int r=0;r<16;++r)m=fmaxf(m,P[i][hf][r]); } }
  m=fmaxf(m,__shfl_xor(m,32));
  float l=0.f;
  #pragma unroll
  for(int i=0;i<3;++i){
    #pragma unroll
    for(int hf=0;hf<2;++hf){
      #pragma unroll
      for(int r=0;r<16;++r){ const float p=__builtin_amdgcn_exp2f(P[i][hf][r]-m); P[i][hf][r]=p; l+=p; } } }
  l+=__shfl_xor(l,32);
  f32x16 o[2]; o[0]=f32x16{}; o[1]=f32x16{};
  const unsigned lds0=(unsigned)(uintptr_t)shm;
  char*vslot=shm+S_V+wid*8192;
  const int vb=(int)(lds0+S_V+wid*8192)+((lane>>4)&1)*32+(lane&3)*8+(4*hi+((lane&15)>>2))*64;
  #pragma unroll
  for(int i=0;i<3;++i){ const int t=wid+8*i;
    if(i<2||wid==0){
      #pragma unroll
      for(int j=0;j<8;++j){ const int k=8*j+(lane>>3),c8=lane&7; u32x4 w;
        if(i<2){ const float*vp=cv+(((size_t)b*1024+64*t+k)*16+h)*64+c8*8; const f32x4 a=*(const f32x4*)vp,c=*(const f32x4*)(vp+4);
          w[0]=cvtpk_s(a[0],a[1]); w[1]=cvtpk_s(a[2],a[3]); w[2]=cvtpk_s(c[0],c[1]); w[3]=cvtpk_s(c[2],c[3]); }
        else{ w=*reinterpret_cast<const u32x4*>(Vb+(SROW0+b*64+k)*DM+h*D+c8*8); }
        *reinterpret_cast<u32x4*>(vslot+(((c8>>2)*4+(k>>4))*1024+(k&15)*64+(c8&3)*16))=w; }
      asm volatile("s_waitcnt lgkmcnt(0)":::"memory");
      u32x4 pw0,pw1,pw2,pw3;
      #define PKW(X,B) cvtpk_s(X[B],X[B+1])
      pw0=(u32x4){PKW(P[i][0],0),PKW(P[i][0],2),PKW(P[i][0],4),PKW(P[i][0],6)}; pw1=(u32x4){PKW(P[i][0],8),PKW(P[i][0],10),PKW(P[i][0],12),PKW(P[i][0],14)};
      pw2=(u32x4){PKW(P[i][1],0),PKW(P[i][1],2),PKW(P[i][1],4),PKW(P[i][1],6)}; pw3=(u32x4){PKW(P[i][1],8),PKW(P[i][1],10),PKW(P[i][1],12),PKW(P[i][1],14)};
      #undef PKW
      SBAR(); pv(o,vb,__builtin_bit_cast(bf16x8,pw0),__builtin_bit_cast(bf16x8,pw1),__builtin_bit_cast(bf16x8,pw2),__builtin_bit_cast(bf16x8,pw3)); SBAR();
    }
  }
  { float*Op=(float*)(shm+S_O)+wid*2048;
    #pragma unroll
    for(int d0=0;d0<2;++d0){
      #pragma unroll
      for(int r=0;r<16;++r)Op[crow(r,hi)*64+d0*32+r32]=o[d0][r]; }
    float*ml=(float*)(shm+S_ML)+wid*64; if(hi==0){ml[r32]=m;ml[32+r32]=l;} }
  asm volatile("s_waitcnt lgkmcnt(0)\n\ts_barrier":::"memory");
  { const int q=tid>>4,d4=(tid&15)*4; const float*mlb=(const float*)(shm+S_ML); const float*Ob=(const float*)(shm+S_O);
    float M=-INFINITY;
    #pragma unroll
    for(int w=0;w<8;++w)M=fmaxf(M,mlb[w*64+q]);
    f32x4 num=(f32x4){0.f,0.f,0.f,0.f}; float den=0.f;
    #pragma unroll
    for(int w=0;w<8;++w){ const float f=__builtin_amdgcn_exp2f(mlb[w*64+q]-M); den+=f*mlb[w*64+32+q]; num+=*(const f32x4*)(Ob+w*2048+q*64+d4)*f; }
    const float inv=1.0f/den; const long row=SROW0+b*64+qblk*32+q;
    typedef unsigned u32x2_t __attribute__((ext_vector_type(2)));
    const u32x2_t z=*reinterpret_cast<const u32x2_t*>(Zs+row*DM+h*D+d4); u32x2_t w;
    w[0]=cvtpk_s(num[0]*inv*__uint_as_float(z[0]<<16),num[1]*inv*__uint_as_float(z[0]&0xffff0000u));
    w[1]=cvtpk_s(num[2]*inv*__uint_as_float(z[1]<<16),num[3]*inv*__uint_as_float(z[1]&0xffff0000u));
    *reinterpret_cast<u32x2_t*>(O+row*DM+h*D+d4)=w; }
  asm volatile("s_waitcnt lgkmcnt(0)\n\ts_barrier":::"memory");
}
#undef SBAR
#undef WAIT_BAR
}
typedef __attribute__((address_space(1))) unsigned gu32;
#define XB_TMO      128
#define XB_XCNT(j)  (256  + 64 * (j))
#define XB_XSUB(j)  (1280 + 64 * (j))
#define XB_XGEN(j)  (2304 + 64 * (j))
#define XB_TOP      3328
#define XB_TOPGEN   3392
#define XCD_BAR_WORDS 3456
#define XB_SPIN_CAP (1u << 18)

__device__ __forceinline__ unsigned xb_ld(unsigned* p)              { return __hip_atomic_load(p, __ATOMIC_RELAXED, __HIP_MEMORY_SCOPE_AGENT); }
__device__ __forceinline__ unsigned xb_add(unsigned* p, unsigned v) { return __hip_atomic_fetch_add(p, v, __ATOMIC_RELAXED, __HIP_MEMORY_SCOPE_AGENT); }
__device__ __forceinline__ unsigned xb_xcc_id() { return (unsigned)__builtin_amdgcn_s_getreg((3 << 11) | 20) & 0xFu; }
#define XB_SPIN(cond, bar) do { unsigned _sp = 0; while (cond) { __builtin_amdgcn_s_sleep(1); \
    if ((++_sp & 255u) == 0u) { if (xb_ld(&(bar)[XB_TMO])) break; if (_sp > XB_SPIN_CAP) { atomicAdd(&(bar)[XB_TMO], 1u); break; } } } } while (0)

struct XcdBarrier {
    unsigned* bar; unsigned x;
    volatile LAS unsigned* st;
};

__device__ __forceinline__ XcdBarrier xcd_barrier_post(unsigned* bar, volatile LAS unsigned* st) {
    XcdBarrier b; b.bar = bar; b.x = xb_xcc_id(); b.st = st;
    if (threadIdx.x == 0) (void)xb_add(&bar[XB_XCNT(b.x)], 1u);
    return b;
}
__device__ __forceinline__ void xcd_barrier_complete(unsigned* bar, unsigned x, unsigned& nloc, unsigned& nx) {
    const unsigned G = gridDim.x * gridDim.y * gridDim.z;
    unsigned sum, cnt, mine, sp = 0u;
    for (;;) {
        sum = 0u; cnt = 0u; mine = 0u;
#pragma unroll
        for (unsigned j = 0; j < 16; ++j) { const unsigned c = xb_ld(&bar[XB_XCNT(j)]); sum += c; cnt += (c > 0u) ? 1u : 0u; mine = (j == x) ? c : mine; }
        if (sum == G) break;
        __builtin_amdgcn_s_sleep(1);
        if ((++sp & 255u) == 0u) { if (xb_ld(&bar[XB_TMO])) break; if (sp > XB_SPIN_CAP) { atomicAdd(&bar[XB_TMO], 1u); break; } }
    }
    nloc = mine > 0u ? mine : 1u; nx = cnt > 0u ? cnt : 1u;
}

__device__ __forceinline__ void xcd_barrier(const XcdBarrier& b) {
    asm volatile("s_waitcnt vmcnt(0)" ::: "memory");
    __syncthreads();
    if (threadIdx.x == 0) {
        unsigned* bar = b.bar;
        __builtin_amdgcn_s_waitcnt(0);
        unsigned nloc = b.st[0], nx = b.st[1];
        if (nloc == 0u) { xcd_barrier_complete(bar, b.x, nloc, nx); b.st[0] = nloc; b.st[1] = nx; }
        const unsigned old = xb_add(&bar[XB_XSUB(b.x)], 1u);
        const unsigned gen = old / nloc;
        if (old + 1u == (gen + 1u) * nloc) {
            __builtin_amdgcn_fence(__ATOMIC_RELEASE, "agent");
            asm volatile("s_waitcnt vmcnt(0)" ::: "memory");
            const unsigned og = xb_add(&bar[XB_TOP], 1u);
            const unsigned tg = og / nx;
            if (og + 1u == (tg + 1u) * nx) xb_add(&bar[XB_TOPGEN], 1u);
            else XB_SPIN(xb_ld(&bar[XB_TOPGEN]) == tg, bar);
            __builtin_amdgcn_fence(__ATOMIC_ACQUIRE, "agent");
            xb_add(&bar[XB_XGEN(b.x)], 1u);
            asm volatile("s_waitcnt vmcnt(0)" ::: "memory");
        } else {
            XB_SPIN(xb_ld(&bar[XB_XGEN(b.x)]) == gen, bar);
            __builtin_amdgcn_fence(__ATOMIC_ACQUIRE, "agent");
            asm volatile("s_waitcnt vmcnt(0)" ::: "memory");
        }
    }
    __syncthreads();
}

#ifndef SKIPMASK
#define SKIPMASK 0
#endif
#ifndef MK_N_LAUNCHES
#define MK_N_LAUNCHES 1
#endif
constexpr int N_PHASES = 9;
struct Args { const float* in[18]; float* out; unsigned char* ws; int ph_lo, ph_hi; };
enum { I_XP = 0, I_XS, I_CP, I_CS, I_STATE, I_CK, I_CV, I_CLF, I_NORMG, I_ADAW, I_ADAB, I_W1, I_CONVK, I_W2, I_W3, I_BF, I_W4, I_FG };

__global__ void __launch_bounds__(NWAVES * 64, 2) hybrid_fwd(Args args) {
    extern __shared__ __attribute__((aligned(16))) unsigned char lds[];
    LAS unsigned char* L = (LAS unsigned char*)lds;
    const int tid0 = threadIdx.x, wave = __builtin_amdgcn_readfirstlane(tid0 >> 6);
#define PHASE_TID() int tid = tid0; asm volatile("" : "+v"(tid)); const int lane = tid & 63; (void)lane
    const int G = gridDim.x; const int bx = blockIdx.x; const int vcu = (G % 8 == 0) ? (bx % 8) * (G / 8) + bx / 8 : bx;
    const int gw = vcu * NWAVES + wave, NGW = G * NWAVES;
    unsigned char* ws = args.ws; float* out = args.out;
    float* mod = (float*)(ws + WS_MOD);
    bf16* W1t = (bf16*)(ws + WS_W1); bf16* W2t = (bf16*)(ws + WS_W2); bf16* W3t = (bf16*)(ws + WS_W3); bf16* W4t = (bf16*)(ws + WS_W4);
    float* slab = (float*)(ws + WS_SLAB); bf16* AOb = (bf16*)(ws + WS_AO);
    bf16* Hb = (bf16*)(ws + WS_H); bf16* Yb = (bf16*)(ws + WS_Y); bf16* Qb = (bf16*)(ws + WS_Q); bf16* Kb = (bf16*)(ws + WS_K); bf16* Vb = (bf16*)(ws + WS_V); bf16* Zb = (bf16*)(ws + WS_Z);
    const int lo = args.ph_lo, hi = args.ph_hi;
#define IN(k) (lo <= (k) && (k) < hi)
#define SEAM(k) do { if (IN(k) && IN((k) + 1)) { xcd_barrier(bar); } } while (0)
    volatile LAS unsigned* MISC = (volatile LAS unsigned*)(L + XL_OFF + 12288);
    if (tid0 < 64) MISC[tid0] = 0u;
    __syncthreads();
    XcdBarrier bar = xcd_barrier_post((unsigned*)(ws + WS_CTL), MISC + 8);
    if (args.ph_lo < 0) cg::this_grid().sync();

    if (IN(0) && !(SKIPMASK & (1 << 0))) { PHASE_TID();
        LAS float* scr = (LAS float*)(L + wave * 16640);
        const int it = wave * G + vcu;
        if (it < 1536) {
            const int l = it / 768, rem = it % 768, cb = rem >> 4, kc = rem & 15, k0 = 64 * kc;
#pragma unroll
            for (int bb = 0; bb < 24; ++bb) { const float c = bb < 16 ? args.in[I_CP][bb * 1024 + k0 + lane] : args.in[I_CS][(bb - 16) * 1024 + k0 + lane]; scr[bb * 64 + lane] = c / (1.0f + expf(-c)); }
            const float* W = args.in[I_ADAW] + (size_t)l * 1024 * 3072 + (size_t)k0 * 3072 + cb * 64 + lane;
            float a[24];
#pragma unroll
            for (int bb = 0; bb < 24; ++bb) a[bb] = 0.f;
            LDS_WAIT(); asm volatile("" ::: "memory");
#pragma unroll 4
            for (int k4 = 0; k4 < 16; ++k4) { const int k = 4 * k4;
                const float w0 = W[(size_t)k * 3072], w1 = W[(size_t)(k + 1) * 3072], w2 = W[(size_t)(k + 2) * 3072], w3 = W[(size_t)(k + 3) * 3072];
#pragma unroll
                for (int bb = 0; bb < 24; ++bb) { const f32x4 s = *(const LAS f32x4*)(scr + bb * 64 + k); a[bb] += (s.x * w0 + s.y * w1) + (s.z * w2 + s.w * w3); } }
            float* mo = mod + (size_t)l * 24 * 3072 + cb * 64 + lane;
            const float bias = kc == 0 ? args.in[I_ADAB][l * 3072 + cb * 64 + lane] : 0.f;
#pragma unroll
            for (int bb = 0; bb < 24; ++bb) __hip_atomic_fetch_add(mo + (size_t)bb * 3072, a[bb] + bias, __ATOMIC_RELAXED, __HIP_MEMORY_SCOPE_AGENT);
            LDS_WAIT(); asm volatile("" ::: "memory");
        }
        for (int t = gw; t < 16 * 128; t += NGW) p0_transpose_item<1>(args.in[I_W1], 1024, N1, W1t, scr, t, lane);
    }
    SEAM(0);
    if (IN(1) && !(SKIPMASK & (1 << 1))) { PHASE_TID();
        for (int c = gw; c < MP / 16; c += NGW) ada_norm_rows(args.in[I_XP] + (size_t)c * 16 * DM, Hb + (size_t)c * 16 * DM, 16, args.in[I_NORMG], mod + (size_t)(c >> 7) * 3072, lane);
        for (int m = gw; m < MS; m += NGW) ada_norm_row(args.in[I_XS] + (size_t)m * DM, Hb + (size_t)(MP + m) * DM, args.in[I_NORMG], mod + (size_t)(16 + (m >> 6)) * 3072, lane);
    }
    SEAM(1);
    if (IN(2) && !(SKIPMASK & (1 << 2))) { PHASE_TID();
        pg8::Gemm g{Hb, W1t, MT, N1, DM}; pg8::ConvOrder S; S.init(G, vcu);
        pg8::EpiConv E{Yb, args.in[I_CONVK], args.in[I_STATE], out + O_CONVP, out + O_CONVS};
        pg8::gemm_phase<pg8::EpiConv, pg8::ConvOrder, true, true>(L, L + XL_OFF, g, S, E);
        {
            const bool part = (G == 256);
            if (!part || vcu >= 64) {
                LAS float* scr = (LAS float*)(L + wave * 16640);
                constexpr int I2 = 32 * 16, I3 = 16 * 65, I4 = 16 * 16;
                const int w0 = part ? (vcu - 64) * NWAVES + wave : gw, nw = part ? (G - 64) * NWAVES : NGW;
                for (int t = w0; t < I2 + I3 + I4; t += nw) {
                    int r = t;
                    if (r < I2) { p0_transpose_item<0>(args.in[I_W2], 2048, 1024, W2t, scr, r, lane); continue; } r -= I2;
                    if (r < I3) { p0_transpose_item<0>(args.in[I_W3], 1024, 4112, W3t, scr, r, lane); continue; } r -= I3;
                    p0_transpose_item<0>(args.in[I_W4], 1024, 1024, W4t, scr, r, lane);
                }
            }
        }
    }
    SEAM(2);
    if (IN(3) && !(SKIPMASK & (1 << 3))) { PHASE_TID();
        pg8::Gemm g{Yb, W2t, MT, DM, EW}; pg8::PanelOrder S; S.init(EW, G, vcu);
        pg8::EpiResNorm<0> E{args.in[I_XP], out + O_Y, mod + 2048, slab, Hb, args.in[I_NORMG] + DM, mod + (size_t)24 * 3072, (float*)(ws + WS_X), (unsigned*)(ws + WS_CNT), (bf16*)(ws + WS_X1)};
        pg8::gemm_phase<pg8::EpiResNorm<0>, pg8::PanelOrder, true, true>(L, L + XL_OFF, g, S, E);
    }
    SEAM(3);
    if (IN(4) && !(SKIPMASK & (1 << 4))) { PHASE_TID();
        for (int m = MP + gw; m < MT; m += NGW) { const int bb = 16 + ((m - MP) >> 6);
            ada_norm_row(args.in[I_XS] + (size_t)(m - MP) * DM, Hb + (size_t)m * DM, args.in[I_NORMG] + DM, mod + (size_t)(24 + bb) * 3072, lane, slab + (size_t)(m - MP) * DM, mod + (size_t)bb * 3072 + 2048, out + O_Y + (size_t)m * DM); }
    }
    SEAM(4);
    if (IN(5) && !(SKIPMASK & (1 << 5))) { PHASE_TID();
        pg8::Gemm g{Hb, W3t, MT, N3, DM}; pg8::StaticOrder S; S.init(MT, N3, DM, G, bx);
        pg8::EpiQKV E{Qb, Kb, Vb, Zb, out + O_KP, out + O_KS, out + O_VP, out + O_VS, out + O_LP, out + O_LS, args.in[I_BF], attn_body::C2};
        pg8::gemm_phase<pg8::EpiQKV, pg8::StaticOrder, true, true>(L, L + XL_OFF, g, S, E);
    }
    SEAM(5);
    if (IN(6) && !(SKIPMASK & (1 << 6))) { PHASE_TID();
        char* shm = (char*)lds; float* biasL = (float*)(shm + 86016);
        typedef attn_body::bf16 abf;
        for (int bh = vcu; bh < NB_P * NH; bh += G) { const int b = bh >> 4, h = bh & 15;
            f32x4 v; int tq = tid; asm volatile("" : "+v"(tq));
#pragma unroll
            for (int i = 0; i < 4; ++i) v[i] = out[O_LP + ((size_t)b * SEQ + 4 * tq + i) * NH + h];
            block_scan4(v, biasL, (LAS float*)(L + 96 * 1024), tq, 512);
#ifndef NO_PROMPT_ATT
            for (int i = 0; i < SEQ / 256; ++i) { const int qb = (vcu + 8 - i) & 7;
                attn_body::attn_unit<64>(b, h, qb, (const abf*)Qb, (const abf*)Kb, (const abf*)Vb, (const abf*)Zb, (abf*)AOb, shm, biasL, out + O_KP, out + O_VP); }
#endif
        }
#ifndef NO_SAMPLE_ATT
        for (int su = vcu; su < NB_S * NH * 2; su += G)
            attn_body::sample_unit(su >> 5, (su >> 1) & 15, su & 1, (const abf*)Qb, (const abf*)Kb, (const abf*)Vb, (const abf*)Zb, (abf*)AOb, args.in[I_CK], args.in[I_CV], args.in[I_CLF], out + O_LS, shm);
#endif
    }
    SEAM(6);
    if (IN(7) && !(SKIPMASK & (1 << 7))) { PHASE_TID();
        pg8::Gemm g{AOb, W4t, MT, DM, DM}; pg8::PanelOrder S; S.init(DM, G, vcu);
        pg8::EpiResNorm<1> E{out + O_Y, out + O_Y, mod + (size_t)24 * 3072 + 2048, slab, nullptr, args.in[I_FG], nullptr, (float*)(ws + WS_X + 512 * 1024), (unsigned*)(ws + WS_CNT + 32 * 1024), (bf16*)(ws + WS_X1)};
        pg8::gemm_phase<pg8::EpiResNorm<1>, pg8::PanelOrder, true, true>(L, L + XL_OFF, g, S, E);
    }
    SEAM(7);
    if (IN(8) && !(SKIPMASK & (1 << 8))) { PHASE_TID();
        for (int m = MP + gw; m < MT; m += NGW) final_norm_row(out + O_Y + (size_t)m * DM, args.in[I_FG], lane, slab + (size_t)(m - MP) * DM, mod + (size_t)(24 + 16 + ((m - MP) >> 6)) * 3072 + 2048);
    }
#undef IN
#undef SEAM
}

extern "C" void kernel_launch(void* const* d_in, const int* in_sizes, int n_in, void* d_out, int out_size, void* d_ws, size_t ws_size, hipStream_t stream) {
    static int grid = 0;
    if (grid == 0) {
        if (n_in != 18 || (size_t)out_size != O_END || ws_size < WS_END) { fprintf(stderr, "kernel_launch: unexpected shapes (n_in %d out %d ws %zu)\n", n_in, out_size, ws_size); grid = -1; return; }
        int dev = 0, cus = 0, per_cu = 0;
        if (hipGetDevice(&dev) != hipSuccess || hipDeviceGetAttribute(&cus, hipDeviceAttributeMultiprocessorCount, dev) != hipSuccess) { grid = -1; return; }
        if (hipFuncSetAttribute((const void*)hybrid_fwd, hipFuncAttributeMaxDynamicSharedMemorySize, LDS_BYTES) != hipSuccess) { fprintf(stderr, "kernel_launch: hipFuncSetAttribute failed\n"); grid = -1; return; }
        if (hipOccupancyMaxActiveBlocksPerMultiprocessor(&per_cu, (const void*)hybrid_fwd, NWAVES * 64, LDS_BYTES) != hipSuccess || per_cu < 1) { fprintf(stderr, "kernel_launch: occupancy query says %d\n", per_cu); (void)hipGetLastError(); per_cu = 1; }
        grid = cus * 1;
        (void)per_cu;
    }
    if (grid < 0) return;
    if (hipMemsetAsync((char*)d_ws + WS_CTL, 0, CTL_ZERO_BYTES, stream) != hipSuccess) { fprintf(stderr, "kernel_launch: memset failed\n"); return; }
    Args a{};
    for (int i = 0; i < 18; ++i) a.in[i] = (const float*)d_in[i];
    a.out = (float*)d_out; a.ws = (unsigned char*)d_ws;
    if (MK_N_LAUNCHES == 1) {
        a.ph_lo = 0; a.ph_hi = N_PHASES;
        void* kargs[] = {&a};
        hipError_t e = hipLaunchCooperativeKernel((const void*)hybrid_fwd, dim3(grid), dim3(NWAVES * 64), kargs, LDS_BYTES, stream);
        if (e != hipSuccess) fprintf(stderr, "kernel_launch: cooperative launch failed: %s (grid %d)\n", hipGetErrorString(e), grid);
    } else {
        for (int p = 0; p < N_PHASES; ++p) { a.ph_lo = p; a.ph_hi = p + 1; hipLaunchKernelGGL(hybrid_fwd, dim3(grid), dim3(NWAVES * 64), LDS_BYTES, stream, a); }
    }
}
```

```cpp
#include <hip/hip_runtime.h>
#include <hip/hip_cooperative_groups.h>
#include <hip/hip_bf16.h>
#include <cstdio>
#include <cstdint>
#include <cmath>
namespace cg = cooperative_groups;

namespace pg8 {
#define PG8_LAS __attribute__((address_space(3)))
typedef unsigned short bf16_t;
typedef short bf16x8 __attribute__((ext_vector_type(8)));
typedef float f32x4 __attribute__((ext_vector_type(4)));
typedef unsigned u32x4 __attribute__((ext_vector_type(4)));
typedef unsigned u32x2 __attribute__((ext_vector_type(2)));
constexpr int BM = 256, BK = 64, HALF = 128, HTB = HALF * BK * 2  , STAGE_BYTES = 8 * HTB, NXCD = 8, WGM = 8;

__host__ __device__ __forceinline__ int lds_byte(int r, int c) { const int st = (r >> 4) * 2 + (c >> 5), rr = r & 15, cc = c & 31, ob = rr * 64 + cc * 2; return st * 1024 + (ob ^ (((ob >> 9) & 1) << 5)); }
__host__ __device__ __forceinline__ void stage_rc(int b, int& R, int& C) { const int st = b / 1024, sb = b % 1024, swz = sb ^ (((sb >> 9) & 1) << 5); R = (st >> 1) * 16 + swz / 64; C = (st & 1) * 32 + (swz % 64) / 2; }
__host__ __device__ __forceinline__ int perm32(int rho) { const int n = rho >> 4, i = rho & 15; return 8 * (i >> 2) + 4 * n + (i & 3); }

struct Unit { int pm, pn, k0, nt, split; };
struct Gemm { const bf16_t* A; const bf16_t* Bt; int M, N, K; };

struct StaticOrder {
    int nM, nN, nwg, G, c, ntk;
    __host__ __device__ void init(int M, int N, int K, int G_, int c_) { nM = M / BM; nN = N / BM; nwg = nM * nN; G = G_; c = c_; ntk = K / BK; }
    __host__ __device__ bool next(int i, Unit& u) const {
        const long L = (long)i * G + c; if (L >= nwg) return false;
        int wgid = (int)L; { const int q = nwg / NXCD, r = nwg % NXCD, xcd = wgid % NXCD, off = wgid / NXCD; wgid = (xcd < r ? xcd * (q + 1) : r * (q + 1) + (xcd - r) * q) + off; }
        const int nig = WGM * nN, gid = wgid / nig, fm = gid * WGM, gsz = (nM - fm) < WGM ? (nM - fm) : WGM;
        u.pm = fm + ((wgid % nig) % gsz); u.pn = (wgid % nig) / gsz; u.k0 = 0; u.nt = ntk; u.split = 0; return true;
    }
};
struct ConvOrder {
    int vcu, G, nsup;
    __device__ void init(int G_, int vcu_) { G = G_; vcu = vcu_; nsup = vcu < 512 ? (512 - vcu + G - 1) / G : 0; }
    __device__ bool next(int i, Unit& u) const {
        u.k0 = 0; u.nt = 16; u.split = 0;
        if (i < 8 * nsup) { const int s = vcu + G * (i >> 3), j = i & 7, combo = s >> 5, y = s & 31; const int b = (combo >> 2) * 4 + (y >> 3); u.pn = (combo & 3) * 8 + (y & 7); u.pm = b * 8 + j; return true; }
        const int su = vcu + G * (i - 8 * nsup); if (su >= 64) return false;
        u.pm = 128 + (su >> 5); u.pn = su & 31; return true;
    }
};

constexpr int NSPLIT = 8;
struct PanelOrder {
    int vcu, G, npr, ntk;
    __device__ void init(int K, int G_, int vcu_) { G = G_; vcu = vcu_; ntk = K / BK; npr = vcu < 512 ? (512 - vcu + G - 1) / G : 0; }
    __device__ bool next(int i, Unit& u) const {
        if (i < npr) { const int L = vcu + G * i; u.pm = L >> 2; u.pn = L & 3; u.k0 = 0; u.nt = ntk; u.split = 0; return true; }
        const int s = vcu + G * (i - npr); if (s >= 8 * NSPLIT) return false;
        const int tile = s / NSPLIT, ch = s % NSPLIT; u.pm = 128 + (tile >> 2); u.pn = tile & 3; u.nt = ntk / NSPLIT; u.k0 = ch * u.nt * BK; u.split = ch + 1; return true;
    }
};

__device__ __forceinline__ unsigned cvt_pk_bf16(float lo, float hi) { unsigned r; asm volatile("v_cvt_pk_bf16_f32 %0, %1, %2" : "=v"(r) : "v"(lo), "v"(hi)); return r; }
__device__ __forceinline__ float silu_f(float z) { return z * __builtin_amdgcn_rcpf(1.0f + __builtin_amdgcn_exp2f(-1.4426950408889634f * z)); }
__device__ __forceinline__ float shfl_i(float v, int srcb) { return __builtin_bit_cast(float, __builtin_amdgcn_ds_bpermute(srcb, __builtin_bit_cast(int, v))); }

constexpr int NPROMPT_TILES = 128, PROMPT_ROWS = 32768;

struct EpiConv {
    static constexpr bool PERM = false;
    bf16_t* Y; const float* convk; const float* state; float* outp; float* outs;
    __device__ __forceinline__ void operator()(f32x4 (&acc)[2][2][4][2], const Unit& u, int wr, int wc, int fr, int fq, PG8_LAS unsigned char* xl, int ui) const {
        const int lane = threadIdx.x & 63;
        const int chl = wc * 16 + fq * 4, e0 = u.pn * 64 + chl;
        const bool samp = u.pm >= NPROMPT_TILES;
        PG8_LAS float* tail = (PG8_LAS float*)xl + (ui & 1) * 512;
        PG8_LAS float* tailp = (PG8_LAS float*)xl + ((ui & 1) ^ 1) * 512;
#pragma unroll
        for (int ai = 0; ai < 2; ++ai)
#pragma unroll
            for (int m = 0; m < 4; ++m) acc[ai][0][m][1] = acc[ai][0][m][1] * acc[ai][1][m][0];
        if (fr >= 14) {
#pragma unroll
            for (int ai = 0; ai < 2; ++ai) *(PG8_LAS f32x4*)(tail + ((2 * ai + wr) * 2 + (fr - 14)) * 64 + chl) = acc[ai][0][3][1];
        }
        asm volatile("s_waitcnt lgkmcnt(0)" ::: "memory"); __builtin_amdgcn_s_barrier(); asm volatile("" ::: "memory");
        const f32x4 k0 = *(const f32x4*)(convk + e0), k1 = *(const f32x4*)(convk + 2048 + e0), k2 = *(const f32x4*)(convk + 4096 + e0);
        const int src1 = ((lane & 48) | ((lane - 1) & 15)) << 2, src2 = ((lane & 48) | ((lane - 2) & 15)) << 2;
#pragma unroll
        for (int ai = 0; ai < 2; ++ai) {
            const int g = 2 * ai + wr;
            f32x4 p1, p2;
            if (samp) { const int bs = (u.pm - NPROMPT_TILES) * 4 + g; p2 = *(const f32x4*)(state + (size_t)(bs * 2 + 0) * 2048 + e0); p1 = *(const f32x4*)(state + (size_t)(bs * 2 + 1) * 2048 + e0); }
            else if (g == 0) { if ((u.pm & 7) == 0) { p1 = (f32x4){0.f, 0.f, 0.f, 0.f}; p2 = p1; } else { p2 = *(PG8_LAS f32x4*)(tailp + (3 * 2 + 0) * 64 + chl); p1 = *(PG8_LAS f32x4*)(tailp + (3 * 2 + 1) * 64 + chl); } }
            else { p2 = *(PG8_LAS f32x4*)(tail + ((g - 1) * 2 + 0) * 64 + chl); p1 = *(PG8_LAS f32x4*)(tail + ((g - 1) * 2 + 1) * 64 + chl); }
            f32x4 r1p = p1, r2p = (fr == 0) ? p2 : p1;
#pragma unroll
            for (int m = 0; m < 4; ++m) {
                const f32x4 uu = acc[ai][0][m][1];
                f32x4 r1, r2;
#pragma unroll
                for (int i = 0; i < 4; ++i) { r1[i] = shfl_i(uu[i], src1); r2[i] = shfl_i(uu[i], src2); }
                const f32x4 um1 = (fr >= 1) ? r1 : r1p, um2 = (fr >= 2) ? r2 : r2p;
                const f32x4 cv = k2 * uu + k1 * um1 + k0 * um2;
                const f32x4 bg = acc[ai][0][m][0], z = acc[ai][1][m][1];
                f32x4 y;
#pragma unroll
                for (int i = 0; i < 4; ++i) y[i] = bg[i] * cv[i] * silu_f(z[i]);
                const size_t row = (size_t)u.pm * BM + ai * HALF + wr * 64 + m * 16 + fr;
                u32x2 w; w.x = cvt_pk_bf16(y[0], y[1]); w.y = cvt_pk_bf16(y[2], y[3]);
                *(u32x2*)(Y + row * 2048 + e0) = w;
                r1p = r1; r2p = r2;
            }
            if (fr >= 14) {
                if (samp) { const int bs = (u.pm - NPROMPT_TILES) * 4 + g; *(f32x4*)(outs + (size_t)(bs * 2 + (fr - 14)) * 2048 + e0) = acc[ai][0][3][1]; }
                else if ((u.pm & 7) == 7 && g == 3) { *(f32x4*)(outp + (size_t)((u.pm >> 3) * 2 + (fr - 14)) * 2048 + e0) = acc[ai][0][3][1]; }
            }
        }
    }
};

struct EpiRes {
    static constexpr bool PERM = false;
    const float* xp; const float* xs; float* out; const float* gate; float* slab;
    __device__ __forceinline__ void operator()(f32x4 (&acc)[2][2][4][2], const Unit& u, int wr, int wc, int fr, int fq, PG8_LAS unsigned char*, int) const {
        const bool samp = u.pm >= NPROMPT_TILES;
        const float* xb = samp ? xs : xp;
        const int col0 = u.pn * BM + wc * 32 + 4 * fq;
        if (u.split) {
            float* sb = slab + (size_t)(u.split - 1) * 512 * 1024;
#pragma unroll
            for (int ai = 0; ai < 2; ++ai)
#pragma unroll
                for (int m = 0; m < 4; ++m) { const size_t off = ((size_t)(u.pm - NPROMPT_TILES) * BM + ai * HALF + wr * 64 + m * 16 + fr) * 1024 + col0;
#pragma unroll
                    for (int bj = 0; bj < 2; ++bj)
#pragma unroll
                        for (int n = 0; n < 2; ++n) *(f32x4*)(sb + off + bj * HALF + n * 16) = acc[ai][bj][m][n]; }
            return;
        }
#pragma unroll
        for (int ai = 0; ai < 2; ++ai) {
            const int bb = samp ? 16 + (u.pm - NPROMPT_TILES) * 4 + 2 * ai + wr : (u.pm >> 3);
            f32x4 gv[2][2];
#pragma unroll
            for (int bj = 0; bj < 2; ++bj)
#pragma unroll
                for (int n = 0; n < 2; ++n) gv[bj][n] = *(const f32x4*)(gate + (size_t)bb * 3072 + col0 + bj * HALF + n * 16);
#pragma unroll
            for (int m = 0; m < 4; ++m) {
                const size_t off = ((size_t)u.pm * BM + ai * HALF + wr * 64 + m * 16 + fr) * 1024 + col0;
#pragma unroll
                for (int bj = 0; bj < 2; ++bj)
#pragma unroll
                    for (int n = 0; n < 2; ++n) { const f32x4 xv = *(const f32x4*)(xb + off + bj * HALF + n * 16); *(f32x4*)(out + off + bj * HALF + n * 16) = xv + gv[bj][n] * acc[ai][bj][m][n]; }
                if (m & 1) asm volatile("" ::: "memory");
            }
        }
    }
};

template <int MODE> struct EpiResNorm {
    static constexpr bool PERM = true;
    const float* xin; float* out; const float* gate; float* slab; bf16_t* hb; const float* g; const float* modn; float* xbuf; unsigned* cnt; bf16_t* x1b;
    __device__ __forceinline__ void operator()(f32x4 (&acc)[2][2][4][2], const Unit& u, int wr, int wc, int fr, int fq, PG8_LAS unsigned char* xl, int) const {
        const int col0 = u.pn * BM + wc * 32 + 8 * fq;
        if (u.split) {
            float* sb = slab + (size_t)(u.split - 1) * 512 * 1024;
#pragma unroll
            for (int ai = 0; ai < 2; ++ai)
#pragma unroll
                for (int m = 0; m < 4; ++m) { const size_t off = ((size_t)(u.pm - NPROMPT_TILES) * BM + ai * HALF + wr * 64 + m * 16 + fr) * 1024 + col0;
#pragma unroll
                    for (int bj = 0; bj < 2; ++bj)
#pragma unroll
                        for (int n = 0; n < 2; ++n) *(f32x4*)(sb + off + bj * HALF + n * 4) = acc[ai][bj][m][n]; }
            return;
        }
        const int lane = threadIdx.x & 63, wid = wr * 4 + wc, bb = u.pm >> 3;
        PG8_LAS float* P = (PG8_LAS float*)(xl + 4096);
        PG8_LAS float* S = P + 1024;
        {   f32x4 gv[2][2];
#pragma unroll
            for (int bj = 0; bj < 2; ++bj)
#pragma unroll
                for (int n = 0; n < 2; ++n) gv[bj][n] = *(const f32x4*)(gate + (size_t)bb * 3072 + col0 + bj * HALF + n * 4);
#pragma unroll
            for (int ai = 0; ai < 2; ++ai)
#pragma unroll
                for (int m = 0; m < 4; ++m) { const size_t off = ((size_t)u.pm * BM + ai * HALF + wr * 64 + m * 16 + fr) * 1024 + col0; float s = 0.f;
#pragma unroll
                    for (int bj = 0; bj < 2; ++bj) { f32x4 xv[2];
                        if (MODE == 0) { xv[0] = __builtin_nontemporal_load((const f32x4*)(xin + off + bj * HALF)); xv[1] = __builtin_nontemporal_load((const f32x4*)(xin + off + bj * HALF + 4)); }
                        else { const u32x4 xw = __builtin_nontemporal_load((const u32x4*)(x1b + off + bj * HALF));
                            xv[0] = (f32x4){__builtin_bit_cast(float, xw.x << 16), __builtin_bit_cast(float, xw.x & 0xffff0000u), __builtin_bit_cast(float, xw.y << 16), __builtin_bit_cast(float, xw.y & 0xffff0000u)};
                            xv[1] = (f32x4){__builtin_bit_cast(float, xw.z << 16), __builtin_bit_cast(float, xw.z & 0xffff0000u), __builtin_bit_cast(float, xw.w << 16), __builtin_bit_cast(float, xw.w & 0xffff0000u)}; }
#pragma unroll
                        for (int n = 0; n < 2; ++n) { const f32x4 a = xv[n] + gv[bj][n] * acc[ai][bj][m][n]; acc[ai][bj][m][n] = a; s += (a[0] * a[0] + a[1] * a[1]) + (a[2] * a[2] + a[3] * a[3]); } }
                    s += __shfl_xor(s, 16); s += __shfl_xor(s, 32);
                    if (fq == 0) P[(ai * HALF + wr * 64 + m * 16 + fr) * 4 + wc] = s;
                    if (m & 1) asm volatile("" ::: "memory"); } }
        asm volatile("s_waitcnt lgkmcnt(0)" ::: "memory"); __builtin_amdgcn_s_barrier(); asm volatile("" ::: "memory");
        const int row = wid * 32 + (lane & 31);
        if (lane < 32) { const float tot = (P[row * 4 + 0] + P[row * 4 + 1]) + (P[row * 4 + 2] + P[row * 4 + 3]);
            __hip_atomic_store(xbuf + ((size_t)u.pm * BM + row) * 4 + u.pn, tot, __ATOMIC_RELAXED, __HIP_MEMORY_SCOPE_AGENT); }
        asm volatile("s_waitcnt vmcnt(0)" ::: "memory");
        if (lane == 0) __hip_atomic_fetch_add(cnt + 64 * u.pm, 1u, __ATOMIC_RELAXED, __HIP_MEMORY_SCOPE_AGENT);
        if (wid == 0) { unsigned sp = 0;
            while ((unsigned)__builtin_amdgcn_readfirstlane((int)__hip_atomic_load(cnt + 64 * u.pm, __ATOMIC_RELAXED, __HIP_MEMORY_SCOPE_AGENT)) < 32u) { __builtin_amdgcn_s_sleep(2); if (++sp > (1u << 20)) break; }
            __builtin_amdgcn_fence(__ATOMIC_ACQUIRE, "agent"); }
        asm volatile("s_waitcnt vmcnt(0) lgkmcnt(0)" ::: "memory"); __builtin_amdgcn_s_barrier(); asm volatile("" ::: "memory");
        if (lane < 32) { const float* sl = xbuf + ((size_t)u.pm * BM + row) * 4; float t = 0.f;
#pragma unroll
            for (int q = 0; q < 4; ++q) t += __hip_atomic_load(sl + q, __ATOMIC_RELAXED, __HIP_MEMORY_SCOPE_AGENT);
            S[row] = 1.0f / sqrtf(t * (1.0f / 1024.0f) + 1e-6f); }
        asm volatile("s_waitcnt lgkmcnt(0)" ::: "memory"); __builtin_amdgcn_s_barrier(); asm volatile("" ::: "memory");
#pragma unroll
        for (int bj = 0; bj < 2; ++bj) { const int col = col0 + bj * HALF;
            f32x4 gm[2], sh[2];
#pragma unroll
            for (int n = 0; n < 2; ++n) { gm[n] = *(const f32x4*)(g + col + 4 * n); sh[n] = (f32x4){0.f, 0.f, 0.f, 0.f};
                if (MODE == 0) { gm[n] = gm[n] * (*(const f32x4*)(modn + (size_t)bb * 3072 + 1024 + col + 4 * n) + 1.0f); sh[n] = *(const f32x4*)(modn + (size_t)bb * 3072 + col + 4 * n); } }
#pragma unroll
            for (int ai = 0; ai < 2; ++ai)
#pragma unroll
                for (int m = 0; m < 4; ++m) { const int r = ai * HALF + wr * 64 + m * 16 + fr; const float rs = S[r]; const size_t off = ((size_t)u.pm * BM + r) * 1024 + col; const f32x4 a0 = acc[ai][bj][m][0], a1 = acc[ai][bj][m][1];
                    if (MODE == 0) { u32x4 xw; xw.x = cvt_pk_bf16(a0[0], a0[1]); xw.y = cvt_pk_bf16(a0[2], a0[3]); xw.z = cvt_pk_bf16(a1[0], a1[1]); xw.w = cvt_pk_bf16(a1[2], a1[3]); __builtin_nontemporal_store(xw, (u32x4*)(x1b + off));
                        const f32x4 h0 = a0 * rs * gm[0] + sh[0], h1 = a1 * rs * gm[1] + sh[1]; u32x4 w; w.x = cvt_pk_bf16(h0[0], h0[1]); w.y = cvt_pk_bf16(h0[2], h0[3]); w.z = cvt_pk_bf16(h1[0], h1[1]); w.w = cvt_pk_bf16(h1[2], h1[3]); *(u32x4*)(hb + off) = w; }
                    else { __builtin_nontemporal_store(a0 * rs * gm[0], (f32x4*)(out + off)); __builtin_nontemporal_store(a1 * rs * gm[1], (f32x4*)(out + off + 4)); } } }
    }
};

struct EpiQKV {
    static constexpr bool PERM = true;
    bf16_t *Qb, *Kb, *Vb, *Zb; float *okp, *oks, *ovp, *ovs, *olp, *ols; const float* bf; float c2;
    __device__ __forceinline__ void operator()(f32x4 (&acc)[2][2][4][2], const Unit& u, int wr, int wc, int fr, int fq, PG8_LAS unsigned char*, int) const {
        const int t = u.pn >> 2; const bool samp = u.pm >= NPROMPT_TILES;
        const size_t row0 = (size_t)u.pm * BM + wr * 64 + fr;
        if (t == 4) {
            if (wc == 0 && fq < 2) {
                float* ob = samp ? ols - (size_t)PROMPT_ROWS * 16 : olp;
#pragma unroll
                for (int n = 0; n < 2; ++n) { const f32x4 bv = *(const f32x4*)(bf + 8 * fq + 4 * n);
#pragma unroll
                    for (int ai = 0; ai < 2; ++ai)
#pragma unroll
                        for (int m = 0; m < 4; ++m) { const f32x4 a = acc[ai][0][m][n] + bv; f32x4 lf;
#pragma unroll
                            for (int i = 0; i < 4; ++i) lf[i] = fminf(a[i], 0.f) - log1pf(expf(-fabsf(a[i])));
                            *(f32x4*)(ob + (row0 + ai * HALF + m * 16) * 16 + 8 * fq + 4 * n) = lf; } }
            }
            return;
        }
        const int col0 = (u.pn & 3) * BM + wc * 32 + 8 * fq;
        bf16_t* bo = t == 0 ? Qb : t == 1 ? Kb : t == 2 ? Vb : Zb;
        float* fo = t == 1 ? (samp ? oks - (size_t)PROMPT_ROWS * 1024 : okp) : (samp ? ovs - (size_t)PROMPT_ROWS * 1024 : ovp);
#pragma unroll
        for (int ai = 0; ai < 2; ++ai)
#pragma unroll
            for (int m = 0; m < 4; ++m) { const size_t off = (row0 + ai * HALF + m * 16) * 1024 + col0;
#pragma unroll
                for (int bj = 0; bj < 2; ++bj) { f32x4 v0 = acc[ai][bj][m][0], v1 = acc[ai][bj][m][1];
                    if ((t == 1 || t == 2) && samp) { __builtin_nontemporal_store(v0, (f32x4*)(fo + off + bj * HALF)); __builtin_nontemporal_store(v1, (f32x4*)(fo + off + bj * HALF + 4)); }
                    if (t == 0) { v0 = v0 * c2; v1 = v1 * c2; }
                    if (t == 3) {
#pragma unroll
                        for (int i = 0; i < 4; ++i) { v0[i] = silu_f(v0[i]); v1[i] = silu_f(v1[i]); } }
                    u32x4 w; w.x = cvt_pk_bf16(v0[0], v0[1]); w.y = cvt_pk_bf16(v0[2], v0[3]); w.z = cvt_pk_bf16(v1[0], v1[1]); w.w = cvt_pk_bf16(v1[2], v1[3]);
                    *(u32x4*)(bo + off + bj * HALF) = w; } }
    }
};
template <class Epi, class Sched, bool ALIGN_EPI = false, bool SP2 = false>
__device__ __forceinline__ void gemm_phase(PG8_LAS unsigned char* lds, PG8_LAS unsigned char* xlds, const Gemm g, const Sched& S, const Epi& E) {
    const int tid = threadIdx.x, wid = __builtin_amdgcn_readfirstlane(tid >> 6), lane = tid & 63, wr = wid >> 2, wc = wid & 3, fr = lane & 15, fq = lane >> 4;
    const int K = g.K; int nt;
    unsigned voffA[2], voffB[2];
#pragma unroll
    for (int i = 0; i < 2; ++i) { int R, C; stage_rc(tid * 16 + i * 8192, R, C); const int Rb = Epi::PERM ? ((R & ~31) + perm32(R & 31)) : R;
        voffA[i] = (unsigned)(R * K + C) * 2u; voffB[i] = (unsigned)(Rb * K + C) * 2u; }
    const size_t kstep = (size_t)(BK * 2);
    const size_t hstep = (size_t)HALF * K * 2;
    const size_t tstep = 2 * hstep;
    const unsigned ldsw = (unsigned)wid * 1024u;
    const int aoff = lds_byte(wr * 64 + fr, fq * 8), boff = lds_byte(wc * 32 + fr, fq * 8);
#define PG8_SA(b, h) (((b) * 2 + (h)) * HTB)
#define PG8_SB(b, h) ((4 + (b) * 2 + (h)) * HTB)
#define PG8_STAGE(bufoff, gbase, voff) do { _Pragma("unroll") for (int _i = 0; _i < 2; ++_i) \
        __builtin_amdgcn_global_load_lds((const unsigned*)((const char*)(gbase) + (voff)[_i]), (PG8_LAS unsigned*)(lds + (bufoff) + ldsw + _i * 8192), 16, 0, 0); } while (0)
#define PG8_LDA(dst, b, h) do { _Pragma("unroll") for (int m = 0; m < 4; ++m) _Pragma("unroll") for (int k = 0; k < 2; ++k) dst[m][k] = *(const PG8_LAS bf16x8*)(lds + PG8_SA(b, h) + aoff + m * 2048 + k * 1024); } while (0)
#define PG8_LDB(dst, b, h) do { _Pragma("unroll") for (int n = 0; n < 2; ++n) _Pragma("unroll") for (int k = 0; k < 2; ++k) dst[n][k] = *(const PG8_LAS bf16x8*)(lds + PG8_SB(b, h) + boff + n * 2048 + k * 1024); } while (0)
#define PG8_MMA(ai, bj, At, Bt) do { __builtin_amdgcn_s_setprio(1); _Pragma("unroll") for (int m = 0; m < 4; ++m) _Pragma("unroll") for (int n = 0; n < 2; ++n) _Pragma("unroll") for (int k = 0; k < 2; ++k) \
        acc[ai][bj][m][n] = __builtin_amdgcn_mfma_f32_16x16x32_bf16(Bt[n][k], At[m][k], acc[ai][bj][m][n], 0, 0, 0); __builtin_amdgcn_s_setprio(0); } while (0)
#define PG8_WAIT_V(n) asm volatile("s_waitcnt vmcnt(" #n ")" ::: "memory")
#define PG8_WAIT_L(n) asm volatile("s_waitcnt lgkmcnt(" #n ")" ::: "memory")
#define PG8_BAR __builtin_amdgcn_s_barrier()
#define PG8_SCHED __builtin_amdgcn_sched_barrier(0)
    Unit cur, nxt; int ui = 0;
    if (!S.next(0, cur)) return;
    nt = cur.nt;
    f32x4 acc[2][2][4][2];
#pragma unroll
    for (int a = 0; a < 2; ++a)
#pragma unroll
        for (int b = 0; b < 2; ++b)
#pragma unroll
            for (int m = 0; m < 4; ++m)
#pragma unroll
                for (int n = 0; n < 2; ++n) acc[a][b][m][n] = (f32x4){0.f, 0.f, 0.f, 0.f};
    bf16x8 At[4][2], B0[2][2], B1[2][2];
    const char* cA = (const char*)g.A + (size_t)cur.pm * tstep + (size_t)cur.k0 * 2; const char* cB = (const char*)g.Bt + (size_t)cur.pn * tstep + (size_t)cur.k0 * 2;
    if constexpr (SP2) {
        PG8_STAGE(PG8_SB(0, 0), cB, voffB); PG8_STAGE(PG8_SB(0, 1), cB + hstep, voffB); PG8_STAGE(PG8_SA(0, 0), cA, voffA); PG8_STAGE(PG8_SA(0, 1), cA + hstep, voffA);
        if (wr == 1) PG8_BAR;
        PG8_WAIT_V(2); PG8_BAR;
        PG8_STAGE(PG8_SB(1, 0), cB + kstep, voffB); PG8_STAGE(PG8_SA(1, 0), cA + kstep, voffA); PG8_STAGE(PG8_SB(1, 1), cB + hstep + kstep, voffB);
        PG8_WAIT_V(6); PG8_BAR;
    } else {
        PG8_STAGE(PG8_SB(0, 0), cB, voffB); PG8_STAGE(PG8_SA(0, 0), cA, voffA); PG8_STAGE(PG8_SB(0, 1), cB + hstep, voffB); PG8_STAGE(PG8_SA(0, 1), cA + hstep, voffA);
        if (wr == 1) PG8_BAR;
        PG8_WAIT_V(4); PG8_BAR;
        PG8_STAGE(PG8_SB(1, 0), cB + kstep, voffB); PG8_STAGE(PG8_SA(1, 0), cA + kstep, voffA); PG8_STAGE(PG8_SB(1, 1), cB + hstep + kstep, voffB);
        PG8_WAIT_V(6); PG8_BAR;
    }
    for (;;) {
        const bool has_next = S.next(ui + 1, nxt);
        const char* nA = has_next ? (const char*)g.A + (size_t)nxt.pm * tstep + (size_t)nxt.k0 * 2 : cA; const char* nB = has_next ? (const char*)g.Bt + (size_t)nxt.pn * tstep + (size_t)nxt.k0 * 2 : cB;
        for (int t = 0; t < nt; t += 2) {
            const bool last = (t == nt - 2);
            const char* a1 = cA + (size_t)(t + 1) * kstep;
            const char* a2 = last ? nA : cA + (size_t)(t + 2) * kstep; const char* b2 = last ? nB : cB + (size_t)(t + 2) * kstep;
            const char* a3 = a2 + kstep; const char* b3 = b2 + kstep;
            if constexpr (SP2) {
            PG8_LDB(B0, 0, 0); PG8_LDB(B1, 0, 1); PG8_SCHED; PG8_LDA(At, 0, 0); PG8_STAGE(PG8_SA(1, 1), a1 + hstep, voffA);
            PG8_WAIT_V(8); PG8_WAIT_L(0); PG8_BAR; PG8_MMA(0, 0, At, B0); PG8_MMA(0, 1, At, B1); PG8_BAR; PG8_SCHED;
            PG8_LDA(At, 0, 1); PG8_STAGE(PG8_SB(0, 0), b2, voffB); PG8_STAGE(PG8_SB(0, 1), b2 + hstep, voffB); PG8_STAGE(PG8_SA(0, 0), a2, voffA);
            PG8_WAIT_V(8); PG8_WAIT_L(0); PG8_BAR; PG8_MMA(1, 0, At, B0); PG8_MMA(1, 1, At, B1); PG8_BAR; PG8_SCHED;
            PG8_LDB(B0, 1, 0); PG8_LDB(B1, 1, 1); PG8_SCHED; PG8_LDA(At, 1, 0); PG8_STAGE(PG8_SA(0, 1), a2 + hstep, voffA);
            PG8_WAIT_V(8); PG8_WAIT_L(0); PG8_BAR; PG8_MMA(0, 0, At, B0); PG8_MMA(0, 1, At, B1); PG8_BAR; PG8_SCHED;
            PG8_LDA(At, 1, 1); PG8_STAGE(PG8_SB(1, 0), b3, voffB); PG8_STAGE(PG8_SB(1, 1), b3 + hstep, voffB); PG8_STAGE(PG8_SA(1, 0), a3, voffA);
            PG8_WAIT_V(8); PG8_WAIT_L(0); PG8_BAR; PG8_MMA(1, 0, At, B0); PG8_MMA(1, 1, At, B1); PG8_BAR; PG8_SCHED;
            } else {
            PG8_LDB(B0, 0, 0); PG8_SCHED; PG8_LDA(At, 0, 0); PG8_STAGE(PG8_SA(1, 1), a1 + hstep, voffA);
            PG8_WAIT_L(8); PG8_BAR; PG8_WAIT_L(0); PG8_MMA(0, 0, At, B0); PG8_BAR; PG8_SCHED;
            PG8_LDB(B1, 0, 1); PG8_STAGE(PG8_SB(0, 0), b2, voffB);
            PG8_BAR; PG8_WAIT_L(0); PG8_MMA(0, 1, At, B1); PG8_BAR;
            PG8_LDA(At, 0, 1); PG8_STAGE(PG8_SA(0, 0), a2, voffA);
            PG8_BAR; PG8_WAIT_L(0); PG8_MMA(1, 0, At, B0); PG8_BAR; PG8_SCHED;
            PG8_STAGE(PG8_SB(0, 1), b2 + hstep, voffB);
            PG8_WAIT_V(6); PG8_BAR; PG8_MMA(1, 1, At, B1); PG8_BAR;
            PG8_LDB(B0, 1, 0); PG8_SCHED; PG8_LDA(At, 1, 0); PG8_STAGE(PG8_SA(0, 1), a2 + hstep, voffA);
            PG8_WAIT_L(8); PG8_BAR; PG8_WAIT_L(0); PG8_MMA(0, 0, At, B0); PG8_BAR; PG8_SCHED;
            PG8_LDB(B1, 1, 1); PG8_STAGE(PG8_SB(1, 0), b3, voffB);
            PG8_BAR; PG8_WAIT_L(0); PG8_MMA(0, 1, At, B1); PG8_BAR;
            PG8_LDA(At, 1, 1); PG8_STAGE(PG8_SA(1, 0), a3, voffA);
            PG8_BAR; PG8_WAIT_L(0); PG8_MMA(1, 0, At, B0); PG8_BAR; PG8_SCHED;
            PG8_STAGE(PG8_SB(1, 1), b3 + hstep, voffB);
            PG8_WAIT_V(6); PG8_BAR; PG8_MMA(1, 1, At, B1); PG8_BAR;
            }
        }
        if constexpr (ALIGN_EPI) { if (wr == 0) PG8_BAR; }
        E(acc, cur, wr, wc, fr, fq, xlds, ui);
        if (!has_next) break;
#pragma unroll
        for (int a = 0; a < 2; ++a)
#pragma unroll
            for (int b = 0; b < 2; ++b)
#pragma unroll
                for (int m = 0; m < 4; ++m)
#pragma unroll
                    for (int n = 0; n < 2; ++n) acc[a][b][m][n] = (f32x4){0.f, 0.f, 0.f, 0.f};
        cur = nxt; cA = nA; cB = nB; ++ui; nt = cur.nt;
        if constexpr (ALIGN_EPI) { if (wr == 1) PG8_BAR; }
    }
    PG8_WAIT_V(0);
    if constexpr (!ALIGN_EPI) { if (wr == 0) PG8_BAR; }
    PG8_BAR;
#undef PG8_SA
#undef PG8_SB
#undef PG8_STAGE
#undef PG8_LDA
#undef PG8_LDB
#undef PG8_MMA
#undef PG8_WAIT_V
#undef PG8_WAIT_L
#undef PG8_BAR
#undef PG8_SCHED
}
}
constexpr int NWAVES = 8;
constexpr int DM = 1024, NB_P = 16, SEQ = 2048, NB_S = 8, TS = 64, PAST = 1024, NH = 16, HD = 64, EW = 2048;
constexpr int MP = NB_P * SEQ, MS = NB_S * TS, MT = MP + MS;
constexpr int N1 = 4 * EW, N3 = 4352;
constexpr float RMS_EPS = 1e-6f, LOG2E = 1.4426950408889634f;
constexpr size_t O_Y = 0, O_CONVP = (size_t)MT * DM, O_KP = O_CONVP + (size_t)NB_P * 2 * EW, O_VP = O_KP + (size_t)MP * DM, O_LP = O_VP + (size_t)MP * DM,
                 O_CONVS = O_LP + (size_t)MP * NH, O_KS = O_CONVS + (size_t)NB_S * 2 * EW, O_VS = O_KS + (size_t)MS * DM, O_LS = O_VS + (size_t)MS * DM, O_END = O_LS + (size_t)MS * NH;
static_assert(O_END == 102866944, "output size");
constexpr size_t MiB = 1u << 20;
constexpr size_t WS_CTL = 0, CTL_ZERO_BYTES = 1 * MiB;
constexpr size_t WS_MOD = 128 * 1024, WS_CNT = 16 * 1024;
constexpr size_t WS_W1 = 1 * MiB, WS_W2 = 17 * MiB, WS_W3 = 21 * MiB, WS_W4 = 30 * MiB;
constexpr size_t WS_H = 32 * MiB;
constexpr size_t WS_Y = 98 * MiB;
constexpr size_t WS_Q = WS_Y, WS_K = WS_Y + 65 * MiB, WS_V = 228 * MiB, WS_Z = 293 * MiB, WS_SLAB = 358 * MiB  , WS_AO = 374 * MiB  , WS_X = 439 * MiB  , WS_X1 = 440 * MiB  , WS_END = 504 * MiB;
static_assert((size_t)MT * DM * 2 == 65 * MiB && WS_W3 + (size_t)N3 * DM * 2 <= WS_W4 && WS_W4 + 2 * MiB <= WS_H, "ws map");
constexpr int RING_BYTES = 131072, XL_OFF = RING_BYTES, LDS_BYTES = 155648;
#define LAS __attribute__((address_space(3)))
typedef unsigned short bf16;
typedef unsigned v4u __attribute__((ext_vector_type(4)));
typedef unsigned v2u __attribute__((ext_vector_type(2)));
typedef float f32x4 __attribute__((ext_vector_type(4)));
typedef short bf16x8 __attribute__((ext_vector_type(8)));
#define LDS_WAIT() asm volatile("s_waitcnt lgkmcnt(0)" ::: "memory")
__device__ __forceinline__ unsigned f2bf(float f) { unsigned u = __builtin_bit_cast(unsigned, f); return (u + 0x7fffu + ((u >> 16) & 1u)) >> 16; }
__device__ __forceinline__ unsigned pk2(float lo, float hi) { return f2bf(lo) | (f2bf(hi) << 16); }
__device__ __forceinline__ float wave_sum(float v) {
#pragma unroll
    for (int o = 1; o < 64; o <<= 1) v += __shfl_xor(v, o);
    return v;
}

template <int MODE> __device__ __forceinline__ void p0_transpose_item(const float* W, int K, int N, bf16* WT, LAS float* scr, int item, int lane) {
    const int nblk = (N + 63) / 64, kb = item / nblk, nb = item % nblk, k0 = 64 * kb, n0 = 64 * nb;
    const int ks = lane >> 4, n4 = (lane & 15) * 4, ncol = min(n0 + n4, N - 4);
    f32x4 v[16];
#pragma unroll
    for (int i = 0; i < 16; ++i) v[i] = __builtin_nontemporal_load((const f32x4*)(W + (size_t)(k0 + 4 * i + ks) * N + ncol));
#pragma unroll
    for (int i = 0; i < 16; ++i) { LAS float* d = scr + (4 * i + ks) * 65 + n4; d[0] = v[i].x; d[1] = v[i].y; d[2] = v[i].z; d[3] = v[i].w; }
    LDS_WAIT(); asm volatile("" ::: "memory");
    const int c = lane & 7;
#pragma unroll
    for (int j = 0; j < 8; ++j) { const int n = (lane >> 3) + 8 * j; const LAS float* s = scr + (8 * c) * 65 + n;
        v4u o; o.x = pk2(s[0 * 65], s[1 * 65]); o.y = pk2(s[2 * 65], s[3 * 65]); o.z = pk2(s[4 * 65], s[5 * 65]); o.w = pk2(s[6 * 65], s[7 * 65]);
        int drow = n0 + n;
        if (MODE == 1) { const int g = drow >> 11, e = drow & 2047, pn = e >> 6, ch = e & 63; drow = pn * 256 + (g >> 1) * 128 + (ch >> 4) * 32 + (g & 1) * 16 + (ch & 15); }
        *(v4u*)(WT + (size_t)drow * K + k0 + 8 * c) = o; }
    LDS_WAIT(); asm volatile("" ::: "memory");
}
__device__ __forceinline__ void ada_norm_row(const float* xrow, bf16* orow, const float* g, const float* mod, int lane, const float* slab = nullptr, const float* gate = nullptr, float* xst = nullptr) {
    const f32x4* xr = (const f32x4*)xrow + lane;
    f32x4 v[4]; float s = 0.f;
#pragma unroll
    for (int j = 0; j < 4; ++j) { v[j] = xr[64 * j];
        if (slab) { f32x4 p = ((const f32x4*)slab)[64 * j + lane];
#pragma unroll
            for (int q = 1; q < 8; ++q) p += ((const f32x4*)(slab + (size_t)q * 512 * 1024))[64 * j + lane];
            v[j] += ((const f32x4*)gate)[64 * j + lane] * p; ((f32x4*)xst)[64 * j + lane] = v[j]; }
        s += (v[j].x * v[j].x + v[j].y * v[j].y) + (v[j].z * v[j].z + v[j].w * v[j].w); }
    const float rstd = 1.f / sqrtf(wave_sum(s) * (1.f / DM) + RMS_EPS);
    unsigned long long* o8 = (unsigned long long*)orow + lane;
#pragma unroll
    for (int j = 0; j < 4; ++j) { const f32x4 gg = ((const f32x4*)g)[64 * j + lane], sh = ((const f32x4*)mod)[64 * j + lane], sc = ((const f32x4*)(mod + DM))[64 * j + lane];
        const f32x4 h = v[j] * rstd * gg * (sc + 1.0f) + sh;
        o8[64 * j] = (unsigned long long)pk2(h.x, h.y) | ((unsigned long long)pk2(h.z, h.w) << 32); }
}
__device__ __forceinline__ void ada_norm_rows(const float* x0, bf16* o0, int nrows, const float* g, const float* mod, int lane) {
    f32x4 gm[4], sh[4];
#pragma unroll
    for (int j = 0; j < 4; ++j) { gm[j] = ((const f32x4*)g)[64 * j + lane] * (((const f32x4*)(mod + DM))[64 * j + lane] + 1.0f); sh[j] = ((const f32x4*)mod)[64 * j + lane]; }
    f32x4 v[4], w[4];
#pragma unroll
    for (int j = 0; j < 4; ++j) v[j] = __builtin_nontemporal_load((const f32x4*)x0 + 64 * j + lane);
    for (int r = 0; r < nrows; ++r) {
        const float* xn = x0 + (size_t)(r + 1 < nrows ? r + 1 : r) * DM;
#pragma unroll
        for (int j = 0; j < 4; ++j) w[j] = __builtin_nontemporal_load((const f32x4*)xn + 64 * j + lane);
        float s = 0.f;
#pragma unroll
        for (int j = 0; j < 4; ++j) s += (v[j].x * v[j].x + v[j].y * v[j].y) + (v[j].z * v[j].z + v[j].w * v[j].w);
        const float rstd = 1.f / sqrtf(wave_sum(s) * (1.f / DM) + RMS_EPS);
        unsigned long long* o8 = (unsigned long long*)(o0 + (size_t)r * DM) + lane;
#pragma unroll
        for (int j = 0; j < 4; ++j) { const f32x4 h = v[j] * rstd * gm[j] + sh[j]; o8[64 * j] = (unsigned long long)pk2(h.x, h.y) | ((unsigned long long)pk2(h.z, h.w) << 32); v[j] = w[j]; }
    }
}
__device__ __forceinline__ void final_norm_row(float* xrow, const float* g, int lane, const float* slab = nullptr, const float* gate = nullptr) {
    f32x4* xr = (f32x4*)xrow + lane;
    f32x4 v[4]; float s = 0.f;
#pragma unroll
    for (int j = 0; j < 4; ++j) { v[j] = xr[64 * j];
        if (slab) { f32x4 p = ((const f32x4*)slab)[64 * j + lane];
#pragma unroll
            for (int q = 1; q < 8; ++q) p += ((const f32x4*)(slab + (size_t)q * 512 * 1024))[64 * j + lane];
            v[j] += ((const f32x4*)gate)[64 * j + lane] * p; }
        s += (v[j].x * v[j].x + v[j].y * v[j].y) + (v[j].z * v[j].z + v[j].w * v[j].w); }
    const float rstd = 1.f / sqrtf(wave_sum(s) * (1.f / DM) + RMS_EPS);
#pragma unroll
    for (int j = 0; j < 4; ++j) xr[64 * j] = v[j] * rstd * ((const f32x4*)g)[64 * j + lane];
}
__device__ __forceinline__ void block_scan4(f32x4 v, float* dst, LAS float* wtot, int tid, int nthr) {
    const int lane = tid & 63, wave = tid >> 6;
    v.y += v.x; v.z += v.y; v.w += v.z;
    float incl = v.w;
#pragma unroll
    for (int o = 1; o < 64; o <<= 1) { const float t = __builtin_bit_cast(float, __builtin_amdgcn_ds_bpermute((lane - o) << 2, __builtin_bit_cast(int, incl))); if (lane >= o) incl += t; }
    if (lane == 63) wtot[wave] = incl;
    LDS_WAIT(); __builtin_amdgcn_s_barrier(); asm volatile("" ::: "memory");
    float base = incl - v.w;
    for (int w = 0; w < wave; ++w) base += wtot[w];
    if (tid < nthr) *(f32x4*)(dst + 4 * tid) = (v + base) * (-LOG2E);
    LDS_WAIT(); __builtin_amdgcn_s_barrier(); asm volatile("" ::: "memory");
}
namespace attn_body {
using bf16=__hip_bfloat16;
using bf16x8=__attribute__((ext_vector_type(8)))short;
using s16x4=__attribute__((ext_vector_type(4)))short;
using f32x16=__attribute__((ext_vector_type(16)))float;
using u32x4=__attribute__((ext_vector_type(4)))unsigned;
using f32x4=__attribute__((ext_vector_type(4)))float;
constexpr int BATCH=16,NHEAD=16,SEQ=2048,D=64,DM=NHEAD*D;
constexpr int NW=8,QBLK=32,QB=QBLK*NW,KVBLK=64,NQB=SEQ/QB;
constexpr int ATTN_PITCH=DM, ATTN_UNIT_ROWS=QB;
__device__ __forceinline__ int crow(int r,int hi){return (r&3)+8*(r>>2)+4*hi;}
#define SBAR() __builtin_amdgcn_sched_barrier(0)
__device__ __forceinline__ void cmask(f32x16&p0,f32x16&p1,int jb,int qrel,int hi){
  const float NEG=-INFINITY; int kb=64*jb+4*hi;
  #pragma unroll
  for(int r=0;r<16;++r){int kv=kb+(r&3)+8*(r>>2); if(kv>qrel)p0[r]=NEG; if(kv+32>qrel)p1[r]=NEG;}
}

constexpr int NSLOT=3, SLOTB=8192;
constexpr int LDS_K=0, LDS_V=NSLOT*SLOTB, LDS_WS=2*NSLOT*SLOTB, LDS_OST=LDS_WS+NW*64*4, LDS_BYTES=LDS_OST+NW*4096;
constexpr float C2=0.125f*1.4426950408889634f;
__device__ __forceinline__ void glds16(const void*gsrc,unsigned lds_dst){unsigned keep;
  asm volatile("s_mov_b32 %0, m0\n\ts_mov_b32 m0, %2\n\ts_nop 0\n\tglobal_load_lds_dwordx4 %1, off\n\ts_mov_b32 m0, %0":"=&s"(keep):"v"(gsrc),"s"(lds_dst):"memory");}
__device__ __forceinline__ float max3f(float a,float b,float c){float r;asm("v_max3_f32 %0, %1, %2, %3":"=v"(r):"v"(a),"v"(b),"v"(c));return r;}
__device__ __forceinline__ float max2f(float a,float b){float r;asm("v_max_f32_e32 %0, %1, %2":"=v"(r):"v"(a),"v"(b));return r;}
__device__ __forceinline__ float fadd_s(float a,float b){float r;asm("v_add_f32_e32 %0, %1, %2":"=v"(r):"v"(a),"v"(b));return r;}
__device__ __forceinline__ float fsub_s(float a,float b){float r;asm("v_sub_f32_e32 %0, %1, %2":"=v"(r):"v"(a),"v"(b));return r;}
typedef float f32x2_t __attribute__((ext_vector_type(2))); typedef __bf16 bf16x2_t __attribute__((ext_vector_type(2)));
__device__ __forceinline__ unsigned cvtpk_s(float lo,float hi){f32x2_t v={lo,hi};bf16x2_t b=__builtin_convertvector(v,bf16x2_t);return __builtin_bit_cast(unsigned,b);}
#define WAIT_BAR(N) asm volatile("s_waitcnt vmcnt(" #N ") lgkmcnt(0)\n\ts_barrier":::"memory")

__device__ __forceinline__ void qkt(f32x16&p0,f32x16&p1,const char*Kslot,const bf16x8*qr,int r32,int hi){
  const char*kb=Kslot+hi*1024+r32*16;
  #pragma unroll
  for(int d0=0;d0<4;++d0){
    const bf16x8 b0=*reinterpret_cast<const bf16x8*>(kb+d0*2048);
    const bf16x8 b1=*reinterpret_cast<const bf16x8*>(kb+d0*2048+512);
    {p0=__builtin_amdgcn_mfma_f32_32x32x16_bf16(b0,qr[d0],p0,0,0,0);p1=__builtin_amdgcn_mfma_f32_32x32x16_bf16(b1,qr[d0],p1,0,0,0);}}
}
typedef __attribute__((address_space(3))) const char* lds_cptr;
typedef short v4i16_t __attribute__((ext_vector_type(4)));
__device__ __forceinline__ void kload8(bf16x8*kf,lds_cptr kp){
  kf[0]=*(const __attribute__((address_space(3))) bf16x8*)(kp);      kf[1]=*(const __attribute__((address_space(3))) bf16x8*)(kp+512);
  kf[2]=*(const __attribute__((address_space(3))) bf16x8*)(kp+2048); kf[3]=*(const __attribute__((address_space(3))) bf16x8*)(kp+2560);
  kf[4]=*(const __attribute__((address_space(3))) bf16x8*)(kp+4096); kf[5]=*(const __attribute__((address_space(3))) bf16x8*)(kp+4608);
  kf[6]=*(const __attribute__((address_space(3))) bf16x8*)(kp+6144); kf[7]=*(const __attribute__((address_space(3))) bf16x8*)(kp+6656);
}
__device__ __forceinline__ void kload2(bf16x8*kf,lds_cptr kp,int j){ kf[2*j]=*(const __attribute__((address_space(3))) bf16x8*)(kp+j*2048); kf[2*j+1]=*(const __attribute__((address_space(3))) bf16x8*)(kp+j*2048+512); }
__device__ __forceinline__ s16x4 vtr(lds_cptr p){ return __builtin_bit_cast(s16x4,__builtin_amdgcn_ds_read_tr16_b64_v4i16((__attribute__((address_space(3))) v4i16_t*)p)); }
__device__ __forceinline__ float rowmax(const f32x16&p0,const f32x16&p1){
  float a=max3f(p0[0],p0[1],p1[0]),b=max3f(p0[2],p0[3],p1[1]);a=max3f(a,p1[2],p1[3]);
  #pragma unroll
  for(int r=4;r<16;r+=4){a=max3f(a,p0[r],p0[r+1]);b=max3f(b,p0[r+2],p0[r+3]);a=max3f(a,p1[r],p1[r+1]);b=max3f(b,p1[r+2],p1[r+3]);}
  const float m=max2f(a,b);
  auto rr=__builtin_amdgcn_permlane32_swap(__float_as_uint(m),__float_as_uint(m),false,false);
  return max2f(__uint_as_float(rr[0]),__uint_as_float(rr[1]));
}
__device__ __forceinline__ void pv(f32x16*o,int vb,bf16x8 pa0,bf16x8 pa1,bf16x8 pa2,bf16x8 pa3){
  #pragma unroll
  for(int d0=0;d0<2;++d0){s16x4 lo[4],hi[4];
    #pragma unroll
    for(int ks=0;ks<4;++ks){
      asm volatile("ds_read_b64_tr_b16 %0,%1 offset:%c2":"=&v"(lo[ks]):"v"(vb),"i"(d0*4096+ks*1024):"memory");
      asm volatile("ds_read_b64_tr_b16 %0,%1 offset:%c2":"=&v"(hi[ks]):"v"(vb),"i"(d0*4096+ks*1024+512):"memory");}
    asm volatile("s_waitcnt lgkmcnt(0)":::"memory");SBAR();
    #define PK(k) (bf16x8){lo[k][0],lo[k][1],lo[k][2],lo[k][3],hi[k][0],hi[k][1],hi[k][2],hi[k][3]}
    o[d0]=__builtin_amdgcn_mfma_f32_32x32x16_bf16(pa0,PK(0),o[d0],0,0,0);
    o[d0]=__builtin_amdgcn_mfma_f32_32x32x16_bf16(pa1,PK(1),o[d0],0,0,0);
    o[d0]=__builtin_amdgcn_mfma_f32_32x32x16_bf16(pa2,PK(2),o[d0],0,0,0);
    o[d0]=__builtin_amdgcn_mfma_f32_32x32x16_bf16(pa3,PK(3),o[d0],0,0,0);
    #undef PK
  }
}

#ifndef ATTN_STORE16
#define ATTN_STORE16(p,v) (*(u32x4*)(p)=(v))
#endif
template<int THRL> __device__ __forceinline__ void attn_unit(int b,int h,int qb,const bf16*Q,const bf16*__restrict__ K,const bf16*__restrict__ V,const bf16*__restrict__ Zs,bf16*O,char*shm,const float*biasL,float*Kf,float*Vf){
  int tid=threadIdx.x; asm volatile("":"+v"(tid)); const int lane=tid&63,r32=lane&31,hi=lane>>5; const int wid=__builtin_amdgcn_readfirstlane(tid>>6);
  const long rowbase=(long)b*SEQ; const int q0=qb*QB;
  const bf16*Qw=Q+(rowbase+q0+wid*QBLK)*DM+h*D;
  const bf16*Kh=K+rowbase*DM+h*D,*Vh=V+rowbase*DM+h*D;
  const unsigned lds0=(unsigned)(uintptr_t)shm;
  float*wsf=(float*)(shm+LDS_WS)+wid*64;
  const bf16*ksrc=Kh+(long)lane*DM+wid*8;
  const bf16*vsrc=Vh+(long)(16*(wid&3)+(lane>>2))*DM+(wid>>2)*32+(lane&3)*8;
  const unsigned kdst=lds0+LDS_K+wid*1024, vdst=lds0+LDS_V+wid*1024;
  #define DMA_K(t,slot) glds16(ksrc+(long)(t)*KVBLK*DM,(unsigned)__builtin_amdgcn_readfirstlane(kdst+(slot)))
  #define DMA_V(t,slot) glds16(vsrc+(long)(t)*KVBLK*DM,(unsigned)__builtin_amdgcn_readfirstlane(vdst+(slot)))
  const int vb0=(int)(lds0+LDS_V)+((lane>>4)&1)*32+(lane&3)*8+(4*hi+((lane&15)>>2))*64;
  const char*Kbase=shm+LDS_K; bf16x8 kf[8];
  const lds_cptr shm3=(lds_cptr)shm; const lds_cptr kp0=shm3+LDS_K+hi*1024+r32*16; const lds_cptr vp0=shm3+LDS_V+((lane>>4)&1)*32+(lane&3)*8+(4*hi+((lane&15)>>2))*64;
  const int NT=(q0+QB)/KVBLK;
  DMA_K(0,0);DMA_V(0,0);DMA_K(1,SLOTB);
  bf16x8 qr[4];
  #pragma unroll
  for(int d0=0;d0<4;++d0)qr[d0]=*reinterpret_cast<const bf16x8*>(&Qw[(long)r32*DM+d0*16+hi*8]);
  float mhat=0.f,l_reg=0.f;f32x16 o[2];o[0]=f32x16{};o[1]=f32x16{};
  const int qrel=wid*QBLK+r32;
  mhat=biasL[q0+qrel];
  #define BINITH(X,t,off) do{ const float*bp_=biasL+(t)*KVBLK+4*hi+(off); \
    _Pragma("unroll") for(int j_=0;j_<4;++j_){ const f32x4 a_=*(const f32x4*)(bp_+8*j_); \
      _Pragma("unroll") for(int i_=0;i_<4;++i_){ X[4*j_+i_]=a_[i_]-mhat; } } }while(0)
  #define BINIT(X0,X1,t) do{ BINITH(X0,t,0); BINITH(X1,t,32); }while(0)
  #define CMASK(P0,P1,t) do{int jb_=(t)-(NT-4); if(jb_>=0)cmask(P0,P1,jb_,qrel,hi);}while(0)
  bool resc=false;
  #define START(P0,P1) do{ const float rm=rowmax(P0,P1); resc=false; \
    { const float dl=(rm>(float)THRL)?rm:0.f; mhat=fadd_s(mhat,dl); \
      _Pragma("unroll") for(int r=0;r<16;++r){P0[r]=fsub_s(P0[r],dl);P1[r]=fsub_s(P1[r],dl);} \
      } \
    _Pragma("unroll") for(int r=0;r<16;++r)P0[r]=__builtin_amdgcn_exp2f(P0[r]); }while(0)
  #define RESC() do{ if(resc){ asm volatile("s_waitcnt lgkmcnt(0)":::"memory"); \
      _Pragma("unroll") for(int d_=0;d_<2;++d_) _Pragma("unroll") for(int r=0;r<16;++r)o[d_][r]*=wsf[crow(r,hi)]; } }while(0)
  f32x16 pA0,pA1,pB0,pB1;
  int sl_prev=0,sl_cur=0,sl_next=SLOTB;
  #define ROT() do{sl_prev=sl_cur;sl_cur=sl_next;sl_next=(sl_next==(NSLOT-1)*SLOTB)?0:sl_next+SLOTB;}while(0)
  DMA_K(2,2*SLOTB);
  WAIT_BAR(3);
  BINIT(pA0,pA1,0); qkt(pA0,pA1,Kbase,qr,r32,hi);asm volatile("s_nop 15\n\ts_nop 7":"+v"(pA0),"+v"(pA1));CMASK(pA0,pA1,0);
  START(pA0,pA1);
  BINIT(pB0,pB1,1);
  _Pragma("unroll") for(int r=0;r<16;++r)pA1[r]=__builtin_amdgcn_exp2f(pA1[r]);
  WAIT_BAR(0);
  DMA_K(3,0);DMA_V(1,SLOTB);
  ROT();
  kload8(kf,kp0+sl_cur);
  WAIT_BAR(2);
  s16x4 vlo[8],vhi[8]; u32x4 pw0,pw1,pw2,pw3;
  #define PKW(P,B) cvtpk_s(P[B],P[B+1])
  #define PAF(k) __builtin_bit_cast(bf16x8,pw##k)
  #define VFR(i) (bf16x8){vlo[i][0],vlo[i][1],vlo[i][2],vlo[i][3],vhi[i][0],vhi[i][1],vhi[i][2],vhi[i][3]}
  #define PIN(x) asm volatile("":"+v"(x))
  #define MX3(a,b,c) __builtin_fmaxf(__builtin_fmaxf((a),(b)),(c))
  #define GAPA(MF,A0,A1,A2,A3,W0,W1,PW) do{ MF; sacc+=A0; sacc+=A1; sacc+=A2; sacc+=A3; PIN(sacc); W0; W1; PIN(PW); SBAR(); }while(0)
  #define EX(v) __builtin_amdgcn_exp2f(v)
  #define GAPB(MF,X,B,GN,Y) do{ MF; X[B]=EX(X[B]); X[B+1]=EX(X[B+1]); X[B+2]=EX(X[B+2]); X[B+3]=EX(X[B+3]); PIN(X); if(GN){ Y[B]-=mhat; Y[B+1]-=mhat; Y[B+2]-=mhat; Y[B+3]-=mhat; PIN(Y); } SBAR(); }while(0)
  #define BLOAD(X0,X1,t) do{ const float*bp_=biasL+(t)*KVBLK+4*hi; \
    _Pragma("unroll") for(int j_=0;j_<4;++j_){ const f32x4 a_=*(const f32x4*)(bp_+8*j_), b_=*(const f32x4*)(bp_+32+8*j_); \
      _Pragma("unroll") for(int i_=0;i_<4;++i_){ X0[4*j_+i_]=a_[i_]; X1[4*j_+i_]=b_[i_]; } } }while(0)
  #define VRD(i) do{ vlo[i]=vtr(vp_+(((i)>>2)*4096+((i)&3)*1024)); vhi[i]=vtr(vp_+(((i)>>2)*4096+((i)&3)*1024+512)); }while(0)
  #define KRD(G,j) do{ if(G){ kload2(kf,kp0+sl_next,j); SBAR(); } }while(0)
  #define STEP(C0,C1,P0,P1,t,GK,GV,GL) do{ SBAR(); \
    const lds_cptr vp_=vp0+sl_prev; \
    VRD(0); SBAR(); float sacc=(P0[0]+P0[1]); \
    GAPA(C0=__builtin_amdgcn_mfma_f32_32x32x16_bf16(kf[0],qr[0],C0,0,0,0), P0[2],P0[3],P0[4],P0[5],     pw0[0]=PKW(P0,0), pw0[1]=PKW(P0,2), pw0); \
    VRD(4); SBAR(); GAPA(C1=__builtin_amdgcn_mfma_f32_32x32x16_bf16(kf[1],qr[0],C1,0,0,0), P0[6],P0[7],P0[8],P0[9],     pw0[2]=PKW(P0,4), pw0[3]=PKW(P0,6), pw0); \
    VRD(1); SBAR(); GAPA(C0=__builtin_amdgcn_mfma_f32_32x32x16_bf16(kf[2],qr[1],C0,0,0,0),   P0[10],P0[11],P0[12],P0[13], pw1[0]=PKW(P0,8), pw1[1]=PKW(P0,10), pw1); \
    VRD(5); SBAR(); GAPA(C1=__builtin_amdgcn_mfma_f32_32x32x16_bf16(kf[3],qr[1],C1,0,0,0),   P0[14],P0[15],P1[0],P1[1],   pw1[2]=PKW(P0,12),pw1[3]=PKW(P0,14), pw1); \
    VRD(2); SBAR(); GAPA(C0=__builtin_amdgcn_mfma_f32_32x32x16_bf16(kf[4],qr[2],C0,0,0,0),   P1[2],P1[3],P1[4],P1[5],     pw2[0]=PKW(P1,0), pw2[1]=PKW(P1,2), pw2); \
    VRD(6); SBAR(); GAPA(C1=__builtin_amdgcn_mfma_f32_32x32x16_bf16(kf[5],qr[2],C1,0,0,0),   P1[6],P1[7],P1[8],P1[9],     pw2[2]=PKW(P1,4), pw2[3]=PKW(P1,6), pw2); \
    VRD(3); SBAR(); GAPA(C0=__builtin_amdgcn_mfma_f32_32x32x16_bf16(kf[6],qr[3],C0,0,0,0),   P1[10],P1[11],P1[12],P1[13], pw3[0]=PKW(P1,8), pw3[1]=PKW(P1,10), pw3); \
    VRD(7); SBAR(); GAPA(C1=__builtin_amdgcn_mfma_f32_32x32x16_bf16(kf[7],qr[3],C1,0,0,0),   P1[14],P1[15],0.f,0.f,       pw3[2]=PKW(P1,12),pw3[3]=PKW(P1,14), pw3); \
    l_reg+=sacc; \
    if(GK){DMA_K((t)+3,sl_cur);} if(GV){DMA_V((t)+1,sl_next);} \
    CMASK(C0,C1,t); \
    { float a=MX3(C0[0],C0[1],C1[0]),b=MX3(C0[2],C0[3],C1[1]); a=MX3(a,C1[2],C1[3]); \
      _Pragma("unroll") for(int r=4;r<16;r+=4){a=MX3(a,C0[r],C0[r+1]);b=MX3(b,C0[r+2],C0[r+3]);a=MX3(a,C1[r],C1[r+1]);b=MX3(b,C1[r+2],C1[r+3]);} \
      float rm=__builtin_fmaxf(a,b); { auto rr=__builtin_amdgcn_permlane32_swap(__float_as_uint(rm),__float_as_uint(rm),false,false); rm=__builtin_fmaxf(__uint_as_float(rr[0]),__uint_as_float(rr[1])); } \
      resc=false; \
      if(__builtin_expect(__any(rm>(float)THRL),0)){ const float dl=__builtin_fmaxf(rm,0.f); mhat+=dl; \
        _Pragma("unroll") for(int r=0;r<16;++r){C0[r]-=dl;C1[r]-=dl;} \
        const float f=__builtin_amdgcn_exp2f(-dl); l_reg*=f; if(hi==0)wsf[r32]=f; resc=true; } } \
    SBAR(); if(GL){ BLOAD(P0,P1,(t)+1); } SBAR(); \
    GAPB(o[0]=__builtin_amdgcn_mfma_f32_32x32x16_bf16(PAF(0),VFR(0),o[0],0,0,0), C0,0,GL,P0); \
    GAPB(o[1]=__builtin_amdgcn_mfma_f32_32x32x16_bf16(PAF(0),VFR(4),o[1],0,0,0), C0,4,GL,P0); \
    KRD(GL,0); GAPB(o[0]=__builtin_amdgcn_mfma_f32_32x32x16_bf16(PAF(1),VFR(1),o[0],0,0,0), C0,8,GL,P0); \
    KRD(GL,1); GAPB(o[1]=__builtin_amdgcn_mfma_f32_32x32x16_bf16(PAF(1),VFR(5),o[1],0,0,0), C0,12,GL,P0); \
    KRD(GL,2); GAPB(o[0]=__builtin_amdgcn_mfma_f32_32x32x16_bf16(PAF(2),VFR(2),o[0],0,0,0), C1,0,GL,P1); \
    KRD(GL,3); GAPB(o[1]=__builtin_amdgcn_mfma_f32_32x32x16_bf16(PAF(2),VFR(6),o[1],0,0,0), C1,4,GL,P1); \
    GAPB(o[0]=__builtin_amdgcn_mfma_f32_32x32x16_bf16(PAF(3),VFR(3),o[0],0,0,0), C1,8,GL,P1); \
    GAPB(o[1]=__builtin_amdgcn_mfma_f32_32x32x16_bf16(PAF(3),VFR(7),o[1],0,0,0), C1,12,GL,P1); \
    }while(0)
  int t=1;
  #undef CMASK
  #define CMASK(P0,P1,t) do{}while(0)
  for(;t+5<NT;t+=2){
    STEP(pB0,pB1,pA0,pA1,t,true,true,true);     WAIT_BAR(2); RESC(); ROT();
    STEP(pA0,pA1,pB0,pB1,t+1,true,true,true);   WAIT_BAR(2); RESC(); ROT();
  }
  #undef CMASK
  #define CMASK(P0,P1,t) do{int jb_=(t)-(NT-4); if(jb_>=0)cmask(P0,P1,jb_,qrel,hi);}while(0)
  #define ENDW(tt) do{ if((tt)+3<NT){WAIT_BAR(2);} else if((tt)+2<NT){WAIT_BAR(1);} else {WAIT_BAR(0);} }while(0)
  for(;t+1<NT;t+=2){
    STEP(pB0,pB1,pA0,pA1,t,(t+3<NT),(t+1<NT),(t+1<NT));       ENDW(t);   RESC(); ROT();
    STEP(pA0,pA1,pB0,pB1,t+1,(t+4<NT),(t+2<NT),(t+2<NT));     ENDW(t+1); RESC(); ROT();
  }
  STEP(pB0,pB1,pA0,pA1,NT-1,false,false,false); RESC();
  u32x4 kcv[4],vcv[4]; { const bf16*Kw=K+(rowbase+q0+wid*QBLK)*DM+h*D; const bf16*Vw=V+(rowbase+q0+wid*QBLK)*DM+h*D;
    _Pragma("unroll") for(int i=0;i<4;++i){ const int row=i*8+(lane>>3),ch=lane&7; kcv[i]=*(const u32x4*)(Kw+(long)row*DM+ch*8); vcv[i]=*(const u32x4*)(Vw+(long)row*DM+ch*8); } }
  u32x4 zpre[4]; { const bf16*Zw=Zs+(rowbase+q0+wid*QBLK)*DM+h*D;
    _Pragma("unroll") for(int i=0;i<4;++i){ const int row=i*8+(lane>>3),ch=lane&7; zpre[i]=*(const u32x4*)(Zw+(long)row*DM+ch*8); } }
  { float sacc=pB0[0]+pB0[1]; _Pragma("unroll") for(int r=2;r<16;++r)sacc+=pB0[r]; _Pragma("unroll") for(int r=0;r<16;++r)sacc+=pB1[r]; l_reg+=sacc;
    pw0=(u32x4){PKW(pB0,0),PKW(pB0,2),PKW(pB0,4),PKW(pB0,6)};pw1=(u32x4){PKW(pB0,8),PKW(pB0,10),PKW(pB0,12),PKW(pB0,14)};pw2=(u32x4){PKW(pB1,0),PKW(pB1,2),PKW(pB1,4),PKW(pB1,6)};pw3=(u32x4){PKW(pB1,8),PKW(pB1,10),PKW(pB1,12),PKW(pB1,14)};
    SBAR(); pv(o,vb0+sl_cur,PAF(0),PAF(1),PAF(2),PAF(3)); }
  #undef PKW
  #undef PAF
  #undef VFR
  #undef PIN
  #undef MX3
  #undef GAPA
  #undef GAPB
  #undef BLOAD
  #undef EX
  #undef VRD
  #undef KRD
  #undef STEP
  #undef ENDW
  {auto rr=__builtin_amdgcn_permlane32_swap(__float_as_uint(l_reg),__float_as_uint(l_reg),false,false);l_reg=__uint_as_float(rr[0])+__uint_as_float(rr[1]);}
  if(hi==0)wsf[32+r32]=l_reg;asm volatile("s_waitcnt lgkmcnt(0)":::"memory");
  float rli[16];
  #pragma unroll
  for(int r=0;r<16;++r)rli[r]=__builtin_amdgcn_rcpf(wsf[32+crow(r,hi)]);
  bf16*Ow=O+(rowbase+q0+wid*QBLK)*DM+h*D;
  { bf16*stg=(bf16*)(shm+LDS_OST)+wid*2048;
    #pragma unroll
    for(int r=0;r<16;++r){const int orow=crow(r,hi);
      #pragma unroll
      for(int d0=0;d0<2;++d0)stg[orow*64+d0*32+r32]=__float2bfloat16(o[d0][r]*rli[r]);}
    asm volatile("s_waitcnt lgkmcnt(0)":::"memory");
    int lane_e=lane; asm volatile("":"+v"(lane_e));
    #pragma unroll
    for(int i=0;i<4;++i){const int lane=lane_e; const bf16*Zw=Zs+(rowbase+q0+wid*QBLK)*DM+h*D; const int row=i*8+(lane>>3),ch=lane&7; const u32x4 v=*(const u32x4*)(stg+row*64+ch*8); const u32x4 z=zpre[i]; u32x4 w;
      _Pragma("unroll") for(int e=0;e<4;++e){ const float a0=__uint_as_float(v[e]<<16)*__uint_as_float(z[e]<<16), a1=__uint_as_float(v[e]&0xffff0000u)*__uint_as_float(z[e]&0xffff0000u); w[e]=cvtpk_s(a0,a1); }
      ATTN_STORE16(Ow+(long)row*DM+ch*8,w);
      { float*kd=Kf+(rowbase+q0+wid*QBLK+row)*DM+h*D+ch*8; float*vd=Vf+(rowbase+q0+wid*QBLK+row)*DM+h*D+ch*8; const u32x4 kw=kcv[i],vw=vcv[i];
        __builtin_nontemporal_store((f32x4){__uint_as_float(kw[0]<<16),__uint_as_float(kw[0]&0xffff0000u),__uint_as_float(kw[1]<<16),__uint_as_float(kw[1]&0xffff0000u)},(f32x4*)kd);
        __builtin_nontemporal_store((f32x4){__uint_as_float(kw[2]<<16),__uint_as_float(kw[2]&0xffff0000u),__uint_as_float(kw[3]<<16),__uint_as_float(kw[3]&0xffff0000u)},(f32x4*)(kd+4));
        __builtin_nontemporal_store((f32x4){__uint_as_float(vw[0]<<16),__uint_as_float(vw[0]&0xffff0000u),__uint_as_float(vw[1]<<16),__uint_as_float(vw[1]&0xffff0000u)},(f32x4*)vd);
        __builtin_nontemporal_store((f32x4){__uint_as_float(vw[2]<<16),__uint_as_float(vw[2]&0xffff0000u),__uint_as_float(vw[3]<<16),__uint_as_float(vw[3]&0xffff0000u)},(f32x4*)(vd+4)); } } }
  asm volatile("s_waitcnt lgkmcnt(0)\n\ts_barrier":::"memory");
  #undef DMA_K
  #undef DMA_V
  #undef CMASK
  #undef START
  #undef RESC
  #undef BINIT
  #undef BINITH
  #undef ROT
}
constexpr int ATTN_LDS_BYTES=LDS_BYTES;
__device__ __forceinline__ void sample_unit(int b,int h,int qblk,const bf16*Q,const bf16*Kb,const bf16*Vb,const bf16*Zs,bf16*O,
    const float*__restrict__ ck,const float*__restrict__ cv,const float*__restrict__ clf,const float*__restrict__ lfs,char*shm){
  int tid=threadIdx.x; asm volatile("":"+v"(tid)); const int lane=tid&63,r32=lane&31,hi=lane>>5; const int wid=__builtin_amdgcn_readfirstlane(tid>>6);
  constexpr int S_V=0,S_O=65536,S_ML=131072,S_BIAS=133120,S_WT=137728; constexpr long SROW0=32768;
  float*biasS=(float*)(shm+S_BIAS);
  { f32x4 v=(f32x4){0.f,0.f,0.f,0.f};
    if(tid<272){
      #pragma unroll
      for(int i=0;i<4;++i){const int p=4*tid+i; v[i]= p<1024 ? clf[((size_t)b*1024+p)*16+h] : lfs[((size_t)b*64+(p-1024))*16+h];} }
    block_scan4(v,biasS,(LAS float*)(shm+S_WT),tid,272); }
  const bf16*Qw=Q+(SROW0+b*64+qblk*32)*DM+h*D;
  bf16x8 qr[4];
  #pragma unroll
  for(int d0=0;d0<4;++d0)qr[d0]=*reinterpret_cast<const bf16x8*>(&Qw[(long)r32*DM+d0*16+hi*8]);
  f32x16 P[3][2];
  #define SU_BIAS(acc,t,hf) do{ const float*bp=biasS+64*(t)+32*(hf)+4*hi; \
      _Pragma("unroll") for(int j=0;j<4;++j){ const f32x4 a=*(const f32x4*)(bp+8*j); _Pragma("unroll") for(int e=0;e<4;++e)acc[4*j+e]=a[e]; } }while(0)
  #pragma unroll
  for(int i=0;i<2;++i){ const int t=wid+8*i;
    #pragma unroll
    for(int hf=0;hf<2;++hf){
      bf16x8 kf[4];
      const float*kp=ck+(((size_t)b*1024+64*t+32*hf+r32)*16+h)*64+hi*8;
      #pragma unroll
      for(int d0=0;d0<4;++d0){ const f32x4 a=*(const f32x4*)(kp+d0*16),c=*(const f32x4*)(kp+d0*16+4);
        u32x4 w; w[0]=cvtpk_s(a[0],a[1]); w[1]=cvtpk_s(a[2],a[3]); w[2]=cvtpk_s(c[0],c[1]); w[3]=cvtpk_s(c[2],c[3]); kf[d0]=__builtin_bit_cast(bf16x8,w);}
      f32x16 acc; SU_BIAS(acc,t,hf);
      #pragma unroll
      for(int d0=0;d0<4;++d0)acc=__builtin_amdgcn_mfma_f32_32x32x16_bf16(kf[d0],qr[d0],acc,0,0,0);
      P[i][hf]=acc; } }
  if(wid==0){
    #pragma unroll
    for(int hf=0;hf<2;++hf){
      bf16x8 kf[4]; const bf16*kp=Kb+(SROW0+b*64+32*hf+r32)*DM+h*D+hi*8;
      #pragma unroll
      for(int d0=0;d0<4;++d0)kf[d0]=*reinterpret_cast<const bf16x8*>(kp+d0*16);
      f32x16 acc; SU_BIAS(acc,16,hf);
      #pragma unroll
      for(int d0=0;d0<4;++d0)acc=__builtin_amdgcn_mfma_f32_32x32x16_bf16(kf[d0],qr[d0],acc,0,0,0);
      #pragma unroll
      for(int r=0;r<16;++r){ if(crow(r,hi)+32*hf>32*qblk+r32)acc[r]=-INFINITY; }
      P[2][hf]=acc; }
  } else {
    #pragma unroll
    for(int hf=0;hf<2;++hf){
      #pragma unroll
      for(int r=0;r<16;++r)P[2][hf][r]=-INFINITY; }
  }
  #undef SU_BIAS
  float m=-INFINITY;
  #pragma unroll
  for(int i=0;i<3;++i){
    #pragma unroll
    for(int hf=0;hf<2;++hf){
      #pragma unroll
      for(int r=0;r<16;++r)m=fmaxf(m,P[i][hf][r]); } }
  m=fmaxf(m,__shfl_xor(m,32));
  float l=0.f;
  #pragma unroll
  for(int i=0;i<3;++i){
    #pragma unroll
    for(int hf=0;hf<2;++hf){
      #pragma unroll
      for(int r=0;r<16;++r){ const float p=__builtin_amdgcn_exp2f(P[i][hf][r]-m); P[i][hf][r]=p; l+=p; } } }
  l+=__shfl_xor(l,32);
  f32x16 o[2]; o[0]=f32x16{}; o[1]=f32x16{};
  const unsigned lds0=(unsigned)(uintptr_t)shm;
  char*vslot=shm+S_V+wid*8192;
  const int vb=(int)(lds0+S_V+wid*8192)+((lane>>4)&1)*32+(lane&3)*8+(4*hi+((lane&15)>>2))*64;
  #pragma unroll
  for(int i=0;i<3;++i){ const int t=wid+8*i;
    if(i<2||wid==0){
      #pragma unroll
      for(int j=0;j<8;++j){ const int k=8*j+(lane>>3),c8=lane&7; u32x4 w;
        if(i<2){ const float*vp=cv+(((size_t)b*1024+64*t+k)*16+h)*64+c8*8; const f32x4 a=*(const f32x4*)vp,c=*(const f32x4*)(vp+4);
          w[0]=cvtpk_s(a[0],a[1]); w[1]=cvtpk_s(a[2],a[3]); w[2]=cvtpk_s(c[0],c[1]); w[3]=cvtpk_s(c[2],c[3]); }
        else{ w=*reinterpret_cast<const u32x4*>(Vb+(SROW0+b*64+k)*DM+h*D+c8*8); }
        *reinterpret_cast<u32x4*>(vslot+(((c8>>2)*4+(k>>4))*1024+(k&15)*64+(c8&3)*16))=w; }
      asm volatile("s_waitcnt lgkmcnt(0)":::"memory");
      u32x4 pw0,pw1,pw2,pw3;
      #define PKW(X,B) cvtpk_s(X[B],X[B+1])
      pw0=(u32x4){PKW(P[i][0],0),PKW(P[i][0],2),PKW(P[i][0],4),PKW(P[i][0],6)}; pw1=(u32x4){PKW(P[i][0],8),PKW(P[i][0],10),PKW(P[i][0],12),PKW(P[i][0],14)};
      pw2=(u32x4){PKW(P[i][1],0),PKW(P[i][1],2),PKW(P[i][1],4),PKW(P[i][1],6)}; pw3=(u32x4){PKW(P[i][1],8),PKW(P[i][1],10),PKW(P[i][1],12),PKW(P[i][1],14)};
      #undef PKW
      SBAR(); pv(o,vb,__builtin_bit_cast(bf16x8,pw0),__builtin_bit_cast(bf16x8,pw1),__builtin_bit_cast(bf16x8,pw2),__builtin_bit_cast(bf16x8,pw3)); SBAR();
    }
  }
  { float*Op=(float*)(shm+S_O)+wid*2048;
    #pragma unroll
    for(int d0=0;d0<2;++d0){
      #pragma unroll
      for(int r=0;r<16;++r)Op[crow(r,hi)*64+d0*32+r32]=o[d0][r]; }
    float*ml=(float*)(shm+S_ML)+wid*64; if(hi==0){ml[r32]=m;ml[32+r32]=l;} }
  asm volatile("s_waitcnt lgkmcnt(0)\n\ts_barrier":::"memory");
  { const int q=tid>>4,d4=(tid&15)*4; const float*mlb=(const float*)(shm+S_ML); const float*Ob=(const float*)(shm+S_O);
    float M=-INFINITY;
    #pragma unroll
    for(int w=0;w<8;++w)M=fmaxf(M,mlb[w*64+q]);
    f32x4 num=(f32x4){0.f,0.f,0.f,0.f}; float den=0.f;
    #pragma unroll
    for(int w=0;w<8;++w){ const float f=__builtin_amdgcn_exp2f(mlb[w*64+q]-M); den+=f*mlb[w*64+32+q]; num+=*(const f32x4*)(Ob+w*2048+q*64+d4)*f; }
    const float inv=1.0f/den; const long row=SROW0+b*64+qblk*32+q;
    typedef unsigned u32x2_t __attribute__((ext_vector_type(2)));
    const u32x2_t z=*reinterpret_cast<const u32x2_t*>(Zs+row*DM+h*D+d4); u32x2_t w;
    w[0]=cvtpk_s(num[0]*inv*__uint_as_float(z[0]<<16),num[1]*inv*__uint_as_float(z[0]&0xffff0000u));
    w[1]=cvtpk_s(num[2]*inv*__uint_as_float(z[1]<<16),num[3]*inv*__uint_as_float(z[1]&0xffff0000u));
    *reinterpret_cast<u32x2_t*>(O+row*DM+h*D+d4)=w; }
  asm volatile("s_waitcnt lgkmcnt(0)\n\ts_barrier":::"memory");
}
#undef SBAR
#undef WAIT_BAR
}
typedef __attribute__((address_space(1))) unsigned gu32;
#define XB_TMO      128
#define XB_XCNT(j)  (256  + 64 * (j))
#define XB_XSUB(j)  (1280 + 64 * (j))
#define XB_XGEN(j)  (2304 + 64 * (j))
#define XB_TOP      3328
#define XB_TOPGEN   3392
#define XCD_BAR_WORDS 3456
#define XB_SPIN_CAP (1u << 18)

__device__ __forceinline__ unsigned xb_ld(unsigned* p)              { return __hip_atomic_load(p, __ATOMIC_RELAXED, __HIP_MEMORY_SCOPE_AGENT); }
__device__ __forceinline__ unsigned xb_add(unsigned* p, unsigned v) { return __hip_atomic_fetch_add(p, v, __ATOMIC_RELAXED, __HIP_MEMORY_SCOPE_AGENT); }
__device__ __forceinline__ unsigned xb_xcc_id() { return (unsigned)__builtin_amdgcn_s_getreg((3 << 11) | 20) & 0xFu; }
#define XB_SPIN(cond, bar) do { unsigned _sp = 0; while (cond) { __builtin_amdgcn_s_sleep(1); \
    if ((++_sp & 255u) == 0u) { if (xb_ld(&(bar)[XB_TMO])) break; if (_sp > XB_SPIN_CAP) { atomicAdd(&(bar)[XB_TMO], 1u); break; } } } } while (0)

struct XcdBarrier {
    unsigned* bar; unsigned x;
    volatile LAS unsigned* st;
};

__device__ __forceinline__ XcdBarrier xcd_barrier_post(unsigned* bar, volatile LAS unsigned* st) {
    XcdBarrier b; b.bar = bar; b.x = xb_xcc_id(); b.st = st;
    if (threadIdx.x == 0) (void)xb_add(&bar[XB_XCNT(b.x)], 1u);
    return b;
}
__device__ __forceinline__ void xcd_barrier_complete(unsigned* bar, unsigned x, unsigned& nloc, unsigned& nx) {
    const unsigned G = gridDim.x * gridDim.y * gridDim.z;
    unsigned sum, cnt, mine, sp = 0u;
    for (;;) {
        sum = 0u; cnt = 0u; mine = 0u;
#pragma unroll
        for (unsigned j = 0; j < 16; ++j) { const unsigned c = xb_ld(&bar[XB_XCNT(j)]); sum += c; cnt += (c > 0u) ? 1u : 0u; mine = (j == x) ? c : mine; }
        if (sum == G) break;
        __builtin_amdgcn_s_sleep(1);
        if ((++sp & 255u) == 0u) { if (xb_ld(&bar[XB_TMO])) break; if (sp > XB_SPIN_CAP) { atomicAdd(&bar[XB_TMO], 1u); break; } }
    }
    nloc = mine > 0u ? mine : 1u; nx = cnt > 0u ? cnt : 1u;
}

__device__ __forceinline__ void xcd_barrier(const XcdBarrier& b) {
    asm volatile("s_waitcnt vmcnt(0)" ::: "memory");
    __syncthreads();
    if (threadIdx.x == 0) {
        unsigned* bar = b.bar;
        __builtin_amdgcn_s_waitcnt(0);
        unsigned nloc = b.st[0], nx = b.st[1];
        if (nloc == 0u) { xcd_barrier_complete(bar, b.x, nloc, nx); b.st[0] = nloc; b.st[1] = nx; }
        const unsigned old = xb_add(&bar[XB_XSUB(b.x)], 1u);
        const unsigned gen = old / nloc;
        if (old + 1u == (gen + 1u) * nloc) {
            __builtin_amdgcn_fence(__ATOMIC_RELEASE, "agent");
            asm volatile("s_waitcnt vmcnt(0)" ::: "memory");
            const unsigned og = xb_add(&bar[XB_TOP], 1u);
            const unsigned tg = og / nx;
            if (og + 1u == (tg + 1u) * nx) xb_add(&bar[XB_TOPGEN], 1u);
            else XB_SPIN(xb_ld(&bar[XB_TOPGEN]) == tg, bar);
            __builtin_amdgcn_fence(__ATOMIC_ACQUIRE, "agent");
            xb_add(&bar[XB_XGEN(b.x)], 1u);
            asm volatile("s_waitcnt vmcnt(0)" ::: "memory");
        } else {
            XB_SPIN(xb_ld(&bar[XB_XGEN(b.x)]) == gen, bar);
            __builtin_amdgcn_fence(__ATOMIC_ACQUIRE, "agent");
            asm volatile("s_waitcnt vmcnt(0)" ::: "memory");
        }
    }
    __syncthreads();
}

#ifndef SKIPMASK
#define SKIPMASK 0
#endif
#ifndef MK_N_LAUNCHES
#define MK_N_LAUNCHES 1
#endif
constexpr int N_PHASES = 9;
struct Args { const float* in[18]; float* out; unsigned char* ws; int ph_lo, ph_hi; };
enum { I_XP = 0, I_XS, I_CP, I_CS, I_STATE, I_CK, I_CV, I_CLF, I_NORMG, I_ADAW, I_ADAB, I_W1, I_CONVK, I_W2, I_W3, I_BF, I_W4, I_FG };

__global__ void __launch_bounds__(NWAVES * 64, 2) hybrid_fwd(Args args) {
    extern __shared__ __attribute__((aligned(16))) unsigned char lds[];
    LAS unsigned char* L = (LAS unsigned char*)lds;
    const int tid0 = threadIdx.x, wave = __builtin_amdgcn_readfirstlane(tid0 >> 6);
#define PHASE_TID() int tid = tid0; asm volatile("" : "+v"(tid)); const int lane = tid & 63; (void)lane
    const int G = gridDim.x; const int bx = blockIdx.x; const int vcu = (G % 8 == 0) ? (bx % 8) * (G / 8) + bx / 8 : bx;
    const int gw = vcu * NWAVES + wave, NGW = G * NWAVES;
    unsigned char* ws = args.ws; float* out = args.out;
    float* mod = (float*)(ws + WS_MOD);
    bf16* W1t = (bf16*)(ws + WS_W1); bf16* W2t = (bf16*)(ws + WS_W2); bf16* W3t = (bf16*)(ws + WS_W3); bf16* W4t = (bf16*)(ws + WS_W4);
    float* slab = (float*)(ws + WS_SLAB); bf16* AOb = (bf16*)(ws + WS_AO);
    bf16* Hb = (bf16*)(ws + WS_H); bf16* Yb = (bf16*)(ws + WS_Y); bf16* Qb = (bf16*)(ws + WS_Q); bf16* Kb = (bf16*)(ws + WS_K); bf16* Vb = (bf16*)(ws + WS_V); bf16* Zb = (bf16*)(ws + WS_Z);
    const int lo = args.ph_lo, hi = args.ph_hi;
#define IN(k) (lo <= (k) && (k) < hi)
#define SEAM(k) do { if (IN(k) && IN((k) + 1)) { xcd_barrier(bar); } } while (0)
    volatile LAS unsigned* MISC = (volatile LAS unsigned*)(L + XL_OFF + 12288);
    if (tid0 < 64) MISC[tid0] = 0u;
    __syncthreads();
    XcdBarrier bar = xcd_barrier_post((unsigned*)(ws + WS_CTL), MISC + 8);
    if (args.ph_lo < 0) cg::this_grid().sync();

    if (IN(0) && !(SKIPMASK & (1 << 0))) { PHASE_TID();
        LAS float* scr = (LAS float*)(L + wave * 16640);
        const int it = wave * G + vcu;
        if (it < 1536) {
            const int l = it / 768, rem = it % 768, cb = rem >> 4, kc = rem & 15, k0 = 64 * kc;
#pragma unroll
            for (int bb = 0; bb < 24; ++bb) { const float c = bb < 16 ? args.in[I_CP][bb * 1024 + k0 + lane] : args.in[I_CS][(bb - 16) * 1024 + k0 + lane]; scr[bb * 64 + lane] = c / (1.0f + expf(-c)); }
            const float* W = args.in[I_ADAW] + (size_t)l * 1024 * 3072 + (size_t)k0 * 3072 + cb * 64 + lane;
            float a[24];
#pragma unroll
            for (int bb = 0; bb < 24; ++bb) a[bb] = 0.f;
            LDS_WAIT(); asm volatile("" ::: "memory");
#pragma unroll 4
            for (int k4 = 0; k4 < 16; ++k4) { const int k = 4 * k4;
                const float w0 = W[(size_t)k * 3072], w1 = W[(size_t)(k + 1) * 3072], w2 = W[(size_t)(k + 2) * 3072], w3 = W[(size_t)(k + 3) * 3072];
#pragma unroll
                for (int bb = 0; bb < 24; ++bb) { const f32x4 s = *(const LAS f32x4*)(scr + bb * 64 + k); a[bb] += (s.x * w0 + s.y * w1) + (s.z * w2 + s.w * w3); } }
            float* mo = mod + (size_t)l * 24 * 3072 + cb * 64 + lane;
            const float bias = kc == 0 ? args.in[I_ADAB][l * 3072 + cb * 64 + lane] : 0.f;
#pragma unroll
            for (int bb = 0; bb < 24; ++bb) __hip_atomic_fetch_add(mo + (size_t)bb * 3072, a[bb] + bias, __ATOMIC_RELAXED, __HIP_MEMORY_SCOPE_AGENT);
            LDS_WAIT(); asm volatile("" ::: "memory");
        }
        for (int t = gw; t < 16 * 128; t += NGW) p0_transpose_item<1>(args.in[I_W1], 1024, N1, W1t, scr, t, lane);
    }
    SEAM(0);
    if (IN(1) && !(SKIPMASK & (1 << 1))) { PHASE_TID();
        for (int c = gw; c < MP / 16; c += NGW) ada_norm_rows(args.in[I_XP] + (size_t)c * 16 * DM, Hb + (size_t)c * 16 * DM, 16, args.in[I_NORMG], mod + (size_t)(c >> 7) * 3072, lane);
        for (int m = gw; m < MS; m += NGW) ada_norm_row(args.in[I_XS] + (size_t)m * DM, Hb + (size_t)(MP + m) * DM, args.in[I_NORMG], mod + (size_t)(16 + (m >> 6)) * 3072, lane);
    }
    SEAM(1);
    if (IN(2) && !(SKIPMASK & (1 << 2))) { PHASE_TID();
        pg8::Gemm g{Hb, W1t, MT, N1, DM}; pg8::ConvOrder S; S.init(G, vcu);
        pg8::EpiConv E{Yb, args.in[I_CONVK], args.in[I_STATE], out + O_CONVP, out + O_CONVS};
        pg8::gemm_phase<pg8::EpiConv, pg8::ConvOrder, true, true>(L, L + XL_OFF, g, S, E);
        {
            const bool part = (G == 256);
            if (!part || vcu >= 64) {
                LAS float* scr = (LAS float*)(L + wave * 16640);
                constexpr int I2 = 32 * 16, I3 = 16 * 65, I4 = 16 * 16;
                const int w0 = part ? (vcu - 64) * NWAVES + wave : gw, nw = part ? (G - 64) * NWAVES : NGW;
                for (int t = w0; t < I2 + I3 + I4; t += nw) {
                    int r = t;
                    if (r < I2) { p0_transpose_item<0>(args.in[I_W2], 2048, 1024, W2t, scr, r, lane); continue; } r -= I2;
                    if (r < I3) { p0_transpose_item<0>(args.in[I_W3], 1024, 4112, W3t, scr, r, lane); continue; } r -= I3;
                    p0_transpose_item<0>(args.in[I_W4], 1024, 1024, W4t, scr, r, lane);
                }
            }
        }
    }
    SEAM(2);
    if (IN(3) && !(SKIPMASK & (1 << 3))) { PHASE_TID();
        pg8::Gemm g{Yb, W2t, MT, DM, EW}; pg8::PanelOrder S; S.init(EW, G, vcu);
        pg8::EpiResNorm<0> E{args.in[I_XP], out + O_Y, mod + 2048, slab, Hb, args.in[I_NORMG] + DM, mod + (size_t)24 * 3072, (float*)(ws + WS_X), (unsigned*)(ws + WS_CNT), (bf16*)(ws + WS_X1)};
        pg8::gemm_phase<pg8::EpiResNorm<0>, pg8::PanelOrder, true, true>(L, L + XL_OFF, g, S, E);
    }
    SEAM(3);
    if (IN(4) && !(SKIPMASK & (1 << 4))) { PHASE_TID();
        for (int m = MP + gw; m < MT; m += NGW) { const int bb = 16 + ((m - MP) >> 6);
            ada_norm_row(args.in[I_XS] + (size_t)(m - MP) * DM, Hb + (size_t)m * DM, args.in[I_NORMG] + DM, mod + (size_t)(24 + bb) * 3072, lane, slab + (size_t)(m - MP) * DM, mod + (size_t)bb * 3072 + 2048, out + O_Y + (size_t)m * DM); }
    }
    SEAM(4);
    if (IN(5) && !(SKIPMASK & (1 << 5))) { PHASE_TID();
        pg8::Gemm g{Hb, W3t, MT, N3, DM}; pg8::StaticOrder S; S.init(MT, N3, DM, G, bx);
        pg8::EpiQKV E{Qb, Kb, Vb, Zb, out + O_KP, out + O_KS, out + O_VP, out + O_VS, out + O_LP, out + O_LS, args.in[I_BF], attn_body::C2};
        pg8::gemm_phase<pg8::EpiQKV, pg8::StaticOrder, true, true>(L, L + XL_OFF, g, S, E);
    }
    SEAM(5);
    if (IN(6) && !(SKIPMASK & (1 << 6))) { PHASE_TID();
        char* shm = (char*)lds; float* biasL = (float*)(shm + 86016);
        typedef attn_body::bf16 abf;
        for (int bh = vcu; bh < NB_P * NH; bh += G) { const int b = bh >> 4, h = bh & 15;
            f32x4 v; int tq = tid; asm volatile("" : "+v"(tq));
#pragma unroll
            for (int i = 0; i < 4; ++i) v[i] = out[O_LP + ((size_t)b * SEQ + 4 * tq + i) * NH + h];
            block_scan4(v, biasL, (LAS float*)(L + 96 * 1024), tq, 512);
#ifndef NO_PROMPT_ATT
            for (int i = 0; i < SEQ / 256; ++i) { const int qb = (vcu + 8 - i) & 7;
                attn_body::attn_unit<64>(b, h, qb, (const abf*)Qb, (const abf*)Kb, (const abf*)Vb, (const abf*)Zb, (abf*)AOb, shm, biasL, out + O_KP, out + O_VP); }
#endif
        }
#ifndef NO_SAMPLE_ATT
        for (int su = vcu; su < NB_S * NH * 2; su += G)
            attn_body::sample_unit(su >> 5, (su >> 1) & 15, su & 1, (const abf*)Qb, (const abf*)Kb, (const abf*)Vb, (const abf*)Zb, (abf*)AOb, args.in[I_CK], args.in[I_CV], args.in[I_CLF], out + O_LS, shm);
#endif
    }
    SEAM(6);
    if (IN(7) && !(SKIPMASK & (1 << 7))) { PHASE_TID();
        pg8::Gemm g{AOb, W4t, MT, DM, DM}; pg8::PanelOrder S; S.init(DM, G, vcu);
        pg8::EpiResNorm<1> E{out + O_Y, out + O_Y, mod + (size_t)24 * 3072 + 2048, slab, nullptr, args.in[I_FG], nullptr, (float*)(ws + WS_X + 512 * 1024), (unsigned*)(ws + WS_CNT + 32 * 1024), (bf16*)(ws + WS_X1)};
        pg8::gemm_phase<pg8::EpiResNorm<1>, pg8::PanelOrder, true, true>(L, L + XL_OFF, g, S, E);
    }
    SEAM(7);
    if (IN(8) && !(SKIPMASK & (1 << 8))) { PHASE_TID();
        for (int m = MP + gw; m < MT; m += NGW) final_norm_row(out + O_Y + (size_t)m * DM, args.in[I_FG], lane, slab + (size_t)(m - MP) * DM, mod + (size_t)(24 + 16 + ((m - MP) >> 6)) * 3072 + 2048);
    }
#undef IN
#undef SEAM
}

extern "C" void kernel_launch(void* const* d_in, const int* in_sizes, int n_in, void* d_out, int out_size, void* d_ws, size_t ws_size, hipStream_t stream) {
    static int grid = 0;
    if (grid == 0) {
        if (n_in != 18 || (size_t)out_size != O_END || ws_size < WS_END) { fprintf(stderr, "kernel_launch: unexpected shapes (n_in %d out %d ws %zu)\n", n_in, out_size, ws_size); grid = -1; return; }
        int dev = 0, cus = 0, per_cu = 0;
        if (hipGetDevice(&dev) != hipSuccess || hipDeviceGetAttribute(&cus, hipDeviceAttributeMultiprocessorCount, dev) != hipSuccess) { grid = -1; return; }
        if (hipFuncSetAttribute((const void*)hybrid_fwd, hipFuncAttributeMaxDynamicSharedMemorySize, LDS_BYTES) != hipSuccess) { fprintf(stderr, "kernel_launch: hipFuncSetAttribute failed\n"); grid = -1; return; }
        if (hipOccupancyMaxActiveBlocksPerMultiprocessor(&per_cu, (const void*)hybrid_fwd, NWAVES * 64, LDS_BYTES) != hipSuccess || per_cu < 1) { fprintf(stderr, "kernel_launch: occupancy query says %d\n", per_cu); (void)hipGetLastError(); per_cu = 1; }
        grid = cus * 1;
        (void)per_cu;
    }
    if (grid < 0) return;
    if (hipMemsetAsync((char*)d_ws + WS_CTL, 0, CTL_ZERO_BYTES, stream) != hipSuccess) { fprintf(stderr, "kernel_launch: memset failed\n"); return; }
    Args a{};
    for (int i = 0; i < 18; ++i) a.in[i] = (const float*)d_in[i];
    a.out = (float*)d_out; a.ws = (unsigned char*)d_ws;
    if (MK_N_LAUNCHES == 1) {
        a.ph_lo = 0; a.ph_hi = N_PHASES;
        void* kargs[] = {&a};
        hipError_t e = hipLaunchCooperativeKernel((const void*)hybrid_fwd, dim3(grid), dim3(NWAVES * 64), kargs, LDS_BYTES, stream);
        if (e != hipSuccess) fprintf(stderr, "kernel_launch: cooperative launch failed: %s (grid %d)\n", hipGetErrorString(e), grid);
    } else {
        for (int p = 0; p < N_PHASES; ++p) { a.ph_lo = p; a.ph_hi = p + 1; hipLaunchKernelGGL(hybrid_fwd, dim3(grid), dim3(NWAVES * 64), LDS_BYTES, stream, a); }
    }
}
```

```cpp
#include <hip/hip_runtime.h>
#include <hip/hip_cooperative_groups.h>
#include <hip/hip_bf16.h>
#include <cstdio>
#include <cstdint>
#include <cmath>
namespace cg = cooperative_groups;

namespace pg8 {
#define PG8_LAS __attribute__((address_space(3)))
typedef unsigned short bf16_t;
typedef short bf16x8 __attribute__((ext_vector_type(8)));
typedef float f32x4 __attribute__((ext_vector_type(4)));
typedef unsigned u32x4 __attribute__((ext_vector_type(4)));
typedef unsigned u32x2 __attribute__((ext_vector_type(2)));
constexpr int BM = 256, BK = 64, HALF = 128, HTB = HALF * BK * 2  , STAGE_BYTES = 8 * HTB, NXCD = 8, WGM = 4;

__host__ __device__ __forceinline__ int lds_byte(int r, int c) { const int st = (r >> 4) * 2 + (c >> 5), rr = r & 15, cc = c & 31, ob = rr * 64 + cc * 2; return st * 1024 + (ob ^ (((ob >> 9) & 1) << 5)); }
__host__ __device__ __forceinline__ void stage_rc(int b, int& R, int& C) { const int st = b / 1024, sb = b % 1024, swz = sb ^ (((sb >> 9) & 1) << 5); R = (st >> 1) * 16 + swz / 64; C = (st & 1) * 32 + (swz % 64) / 2; }
__host__ __device__ __forceinline__ int perm32(int rho) { const int n = rho >> 4, i = rho & 15; return 8 * (i >> 2) + 4 * n + (i & 3); }

struct Unit { int pm, pn, k0, nt, split; };
struct Gemm { const bf16_t* A; const bf16_t* Bt; int M, N, K; };

struct StaticOrder {
    int nM, nN, nwg, G, c, ntk;
    __host__ __device__ void init(int M, int N, int K, int G_, int c_) { nM = M / BM; nN = N / BM; nwg = nM * nN; G = G_; c = c_; ntk = K / BK; }
    __host__ __device__ bool next(int i, Unit& u) const {
        const long L = (long)i * G + c; if (L >= nwg) return false;
        int wgid = (int)L; { const int q = nwg / NXCD, r = nwg % NXCD, xcd = wgid % NXCD, off = wgid / NXCD; wgid = (xcd < r ? xcd * (q + 1) : r * (q + 1) + (xcd - r) * q) + off; }
        const int nig = WGM * nN, gid = wgid / nig, fm = gid * WGM, gsz = (nM - fm) < WGM ? (nM - fm) : WGM;
        u.pm = fm + ((wgid % nig) % gsz); u.pn = (wgid % nig) / gsz; u.k0 = 0; u.nt = ntk; u.split = 0; return true;
    }
};
struct ConvOrder {
    int vcu, G, nsup;
    __device__ void init(int G_, int vcu_) { G = G_; vcu = vcu_; nsup = vcu < 512 ? (512 - vcu + G - 1) / G : 0; }
    __device__ bool next(int i, Unit& u) const {
        u.k0 = 0; u.nt = 16; u.split = 0;
        if (i < 8 * nsup) { const int s = vcu + G * (i >> 3), j = i & 7, combo = s >> 5, y = s & 31; const int b = (combo >> 2) * 4 + (y >> 3); u.pn = (combo & 3) * 8 + (y & 7); u.pm = b * 8 + j; return true; }
        const int su = vcu + G * (i - 8 * nsup); if (su >= 64) return false;
        u.pm = 128 + (su >> 5); u.pn = su & 31; return true;
    }
};

constexpr int NSPLIT = 8;
struct PanelOrder {
    int vcu, G, npr, ntk;
    __device__ void init(int K, int G_, int vcu_) { G = G_; vcu = vcu_; ntk = K / BK; npr = vcu < 512 ? (512 - vcu + G - 1) / G : 0; }
    __device__ bool next(int i, Unit& u) const {
        if (i < npr) { const int L = vcu + G * i; u.pm = L >> 2; u.pn = L & 3; u.k0 = 0; u.nt = ntk; u.split = 0; return true; }
        const int s = vcu + G * (i - npr); if (s >= 8 * NSPLIT) return false;
        const int tile = s / NSPLIT, ch = s % NSPLIT; u.pm = 128 + (tile >> 2); u.pn = tile & 3; u.nt = ntk / NSPLIT; u.k0 = ch * u.nt * BK; u.split = ch + 1; return true;
    }
};

__device__ __forceinline__ unsigned cvt_pk_bf16(float lo, float hi) { unsigned r; asm volatile("v_cvt_pk_bf16_f32 %0, %1, %2" : "=v"(r) : "v"(lo), "v"(hi)); return r; }
__device__ __forceinline__ float silu_f(float z) { return z * __builtin_amdgcn_rcpf(1.0f + __builtin_amdgcn_exp2f(-1.4426950408889634f * z)); }
__device__ __forceinline__ float shfl_i(float v, int srcb) { return __builtin_bit_cast(float, __builtin_amdgcn_ds_bpermute(srcb, __builtin_bit_cast(int, v))); }

constexpr int NPROMPT_TILES = 128, PROMPT_ROWS = 32768;

struct EpiConv {
    static constexpr bool PERM = false;
    bf16_t* Y; const float* convk; const float* state; float* outp; float* outs;
    __device__ __forceinline__ void operator()(f32x4 (&acc)[2][2][4][2], const Unit& u, int wr, int wc, int fr, int fq, PG8_LAS unsigned char* xl, int ui) const {
        const int lane = threadIdx.x & 63;
        const int chl = wc * 16 + fq * 4, e0 = u.pn * 64 + chl;
        const bool samp = u.pm >= NPROMPT_TILES;
        PG8_LAS float* tail = (PG8_LAS float*)xl + (ui & 1) * 512;
        PG8_LAS float* tailp = (PG8_LAS float*)xl + ((ui & 1) ^ 1) * 512;
#pragma unroll
        for (int ai = 0; ai < 2; ++ai)
#pragma unroll
            for (int m = 0; m < 4; ++m) acc[ai][0][m][1] = acc[ai][0][m][1] * acc[ai][1][m][0];
        if (fr >= 14) {
#pragma unroll
            for (int ai = 0; ai < 2; ++ai) *(PG8_LAS f32x4*)(tail + ((2 * ai + wr) * 2 + (fr - 14)) * 64 + chl) = acc[ai][0][3][1];
        }
        asm volatile("s_waitcnt lgkmcnt(0)" ::: "memory"); __builtin_amdgcn_s_barrier(); asm volatile("" ::: "memory");
        const f32x4 k0 = *(const f32x4*)(convk + e0), k1 = *(const f32x4*)(convk + 2048 + e0), k2 = *(const f32x4*)(convk + 4096 + e0);
        const int src1 = ((lane & 48) | ((lane - 1) & 15)) << 2, src2 = ((lane & 48) | ((lane - 2) & 15)) << 2;
#pragma unroll
        for (int ai = 0; ai < 2; ++ai) {
            const int g = 2 * ai + wr;
            f32x4 p1, p2;
            if (samp) { const int bs = (u.pm - NPROMPT_TILES) * 4 + g; p2 = *(const f32x4*)(state + (size_t)(bs * 2 + 0) * 2048 + e0); p1 = *(const f32x4*)(state + (size_t)(bs * 2 + 1) * 2048 + e0); }
            else if (g == 0) { if ((u.pm & 7) == 0) { p1 = (f32x4){0.f, 0.f, 0.f, 0.f}; p2 = p1; } else { p2 = *(PG8_LAS f32x4*)(tailp + (3 * 2 + 0) * 64 + chl); p1 = *(PG8_LAS f32x4*)(tailp + (3 * 2 + 1) * 64 + chl); } }
            else { p2 = *(PG8_LAS f32x4*)(tail + ((g - 1) * 2 + 0) * 64 + chl); p1 = *(PG8_LAS f32x4*)(tail + ((g - 1) * 2 + 1) * 64 + chl); }
            f32x4 r1p = p1, r2p = (fr == 0) ? p2 : p1;
#pragma unroll
            for (int m = 0; m < 4; ++m) {
                const f32x4 uu = acc[ai][0][m][1];
                f32x4 r1, r2;
#pragma unroll
                for (int i = 0; i < 4; ++i) { r1[i] = shfl_i(uu[i], src1); r2[i] = shfl_i(uu[i], src2); }
                const f32x4 um1 = (fr >= 1) ? r1 : r1p, um2 = (fr >= 2) ? r2 : r2p;
                const f32x4 cv = k2 * uu + k1 * um1 + k0 * um2;
                const f32x4 bg = acc[ai][0][m][0], z = acc[ai][1][m][1];
                f32x4 y;
#pragma unroll
                for (int i = 0; i < 4; ++i) y[i] = bg[i] * cv[i] * silu_f(z[i]);
                const size_t row = (size_t)u.pm * BM + ai * HALF + wr * 64 + m * 16 + fr;
                u32x2 w; w.x = cvt_pk_bf16(y[0], y[1]); w.y = cvt_pk_bf16(y[2], y[3]);
                *(u32x2*)(Y + row * 2048 + e0) = w;
                r1p = r1; r2p = r2;
            }
            if (fr >= 14) {
                if (samp) { const int bs = (u.pm - NPROMPT_TILES) * 4 + g; *(f32x4*)(outs + (size_t)(bs * 2 + (fr - 14)) * 2048 + e0) = acc[ai][0][3][1]; }
                else if ((u.pm & 7) == 7 && g == 3) { *(f32x4*)(outp + (size_t)((u.pm >> 3) * 2 + (fr - 14)) * 2048 + e0) = acc[ai][0][3][1]; }
            }
        }
    }
};

struct EpiRes {
    static constexpr bool PERM = false;
    const float* xp; const float* xs; float* out; const float* gate; float* slab;
    __device__ __forceinline__ void operator()(f32x4 (&acc)[2][2][4][2], const Unit& u, int wr, int wc, int fr, int fq, PG8_LAS unsigned char*, int) const {
        const bool samp = u.pm >= NPROMPT_TILES;
        const float* xb = samp ? xs : xp;
        const int col0 = u.pn * BM + wc * 32 + 4 * fq;
        if (u.split) {
            float* sb = slab + (size_t)(u.split - 1) * 512 * 1024;
#pragma unroll
            for (int ai = 0; ai < 2; ++ai)
#pragma unroll
                for (int m = 0; m < 4; ++m) { const size_t off = ((size_t)(u.pm - NPROMPT_TILES) * BM + ai * HALF + wr * 64 + m * 16 + fr) * 1024 + col0;
#pragma unroll
                    for (int bj = 0; bj < 2; ++bj)
#pragma unroll
                        for (int n = 0; n < 2; ++n) *(f32x4*)(sb + off + bj * HALF + n * 16) = acc[ai][bj][m][n]; }
            return;
        }
#pragma unroll
        for (int ai = 0; ai < 2; ++ai) {
            const int bb = samp ? 16 + (u.pm - NPROMPT_TILES) * 4 + 2 * ai + wr : (u.pm >> 3);
            f32x4 gv[2][2];
#pragma unroll
            for (int bj = 0; bj < 2; ++bj)
#pragma unroll
                for (int n = 0; n < 2; ++n) gv[bj][n] = *(const f32x4*)(gate + (size_t)bb * 3072 + col0 + bj * HALF + n * 16);
#pragma unroll
            for (int m = 0; m < 4; ++m) {
                const size_t off = ((size_t)u.pm * BM + ai * HALF + wr * 64 + m * 16 + fr) * 1024 + col0;
#pragma unroll
                for (int bj = 0; bj < 2; ++bj)
#pragma unroll
                    for (int n = 0; n < 2; ++n) { const f32x4 xv = *(const f32x4*)(xb + off + bj * HALF + n * 16); *(f32x4*)(out + off + bj * HALF + n * 16) = xv + gv[bj][n] * acc[ai][bj][m][n]; }
                if (m & 1) asm volatile("" ::: "memory");
            }
        }
    }
};

template <int MODE> struct EpiResNorm {
    static constexpr bool PERM = true;
    const float* xin; float* out; const float* gate; float* slab; bf16_t* hb; const float* g; const float* modn; float* xbuf; unsigned* cnt; bf16_t* x1b;
    __device__ __forceinline__ void operator()(f32x4 (&acc)[2][2][4][2], const Unit& u, int wr, int wc, int fr, int fq, PG8_LAS unsigned char* xl, int) const {
        const int col0 = u.pn * BM + wc * 32 + 8 * fq;
        if (u.split) {
            float* sb = slab + (size_t)(u.split - 1) * 512 * 1024;
#pragma unroll
            for (int ai = 0; ai < 2; ++ai)
#pragma unroll
                for (int m = 0; m < 4; ++m) { const size_t off = ((size_t)(u.pm - NPROMPT_TILES) * BM + ai * HALF + wr * 64 + m * 16 + fr) * 1024 + col0;
#pragma unroll
                    for (int bj = 0; bj < 2; ++bj)
#pragma unroll
                        for (int n = 0; n < 2; ++n) *(f32x4*)(sb + off + bj * HALF + n * 4) = acc[ai][bj][m][n]; }
            return;
        }
        const int lane = threadIdx.x & 63, wid = wr * 4 + wc, bb = u.pm >> 3;
        PG8_LAS float* P = (PG8_LAS float*)(xl + 4096);
        PG8_LAS float* S = P + 1024;
        {   f32x4 gv[2][2];
#pragma unroll
            for (int bj = 0; bj < 2; ++bj)
#pragma unroll
                for (int n = 0; n < 2; ++n) gv[bj][n] = *(const f32x4*)(gate + (size_t)bb * 3072 + col0 + bj * HALF + n * 4);
#pragma unroll
            for (int ai = 0; ai < 2; ++ai)
#pragma unroll
                for (int m = 0; m < 4; ++m) { const size_t off = ((size_t)u.pm * BM + ai * HALF + wr * 64 + m * 16 + fr) * 1024 + col0; float s = 0.f;
#pragma unroll
                    for (int bj = 0; bj < 2; ++bj) { f32x4 xv[2];
                        if (MODE == 0) { xv[0] = __builtin_nontemporal_load((const f32x4*)(xin + off + bj * HALF)); xv[1] = __builtin_nontemporal_load((const f32x4*)(xin + off + bj * HALF + 4)); }
                        else { const u32x4 xw = __builtin_nontemporal_load((const u32x4*)(x1b + off + bj * HALF));
                            xv[0] = (f32x4){__builtin_bit_cast(float, xw.x << 16), __builtin_bit_cast(float, xw.x & 0xffff0000u), __builtin_bit_cast(float, xw.y << 16), __builtin_bit_cast(float, xw.y & 0xffff0000u)};
                            xv[1] = (f32x4){__builtin_bit_cast(float, xw.z << 16), __builtin_bit_cast(float, xw.z & 0xffff0000u), __builtin_bit_cast(float, xw.w << 16), __builtin_bit_cast(float, xw.w & 0xffff0000u)}; }
#pragma unroll
                        for (int n = 0; n < 2; ++n) { const f32x4 a = xv[n] + gv[bj][n] * acc[ai][bj][m][n]; acc[ai][bj][m][n] = a; s += (a[0] * a[0] + a[1] * a[1]) + (a[2] * a[2] + a[3] * a[3]); } }
                    s += __shfl_xor(s, 16); s += __shfl_xor(s, 32);
                    if (fq == 0) P[(ai * HALF + wr * 64 + m * 16 + fr) * 4 + wc] = s;
                    if (m & 1) asm volatile("" ::: "memory"); } }
        asm volatile("s_waitcnt lgkmcnt(0)" ::: "memory"); __builtin_amdgcn_s_barrier(); asm volatile("" ::: "memory");
        const int row = wid * 32 + (lane & 31);
        if (lane < 32) { const float tot = (P[row * 4 + 0] + P[row * 4 + 1]) + (P[row * 4 + 2] + P[row * 4 + 3]);
            __hip_atomic_store(xbuf + ((size_t)u.pm * BM + row) * 4 + u.pn, tot, __ATOMIC_RELAXED, __HIP_MEMORY_SCOPE_AGENT); }
        asm volatile("s_waitcnt vmcnt(0)" ::: "memory");
        if (lane == 0) __hip_atomic_fetch_add(cnt + 64 * u.pm, 1u, __ATOMIC_RELAXED, __HIP_MEMORY_SCOPE_AGENT);
        if (wid == 0) { unsigned sp = 0;
            while ((unsigned)__builtin_amdgcn_readfirstlane((int)__hip_atomic_load(cnt + 64 * u.pm, __ATOMIC_RELAXED, __HIP_MEMORY_SCOPE_AGENT)) < 32u) { __builtin_amdgcn_s_sleep(2); if (++sp > (1u << 20)) break; }
            __builtin_amdgcn_fence(__ATOMIC_ACQUIRE, "agent"); }
        asm volatile("s_waitcnt vmcnt(0) lgkmcnt(0)" ::: "memory"); __builtin_amdgcn_s_barrier(); asm volatile("" ::: "memory");
        if (lane < 32) { const float* sl = xbuf + ((size_t)u.pm * BM + row) * 4; float t = 0.f;
#pragma unroll
            for (int q = 0; q < 4; ++q) t += __hip_atomic_load(sl + q, __ATOMIC_RELAXED, __HIP_MEMORY_SCOPE_AGENT);
            S[row] = 1.0f / sqrtf(t * (1.0f / 1024.0f) + 1e-6f); }
        asm volatile("s_waitcnt lgkmcnt(0)" ::: "memory"); __builtin_amdgcn_s_barrier(); asm volatile("" ::: "memory");
#pragma unroll
        for (int bj = 0; bj < 2; ++bj) { const int col = col0 + bj * HALF;
            f32x4 gm[2], sh[2];
#pragma unroll
            for (int n = 0; n < 2; ++n) { gm[n] = *(const f32x4*)(g + col + 4 * n); sh[n] = (f32x4){0.f, 0.f, 0.f, 0.f};
                if (MODE == 0) { gm[n] = gm[n] * (*(const f32x4*)(modn + (size_t)bb * 3072 + 1024 + col + 4 * n) + 1.0f); sh[n] = *(const f32x4*)(modn + (size_t)bb * 3072 + col + 4 * n); } }
#pragma unroll
            for (int ai = 0; ai < 2; ++ai)
#pragma unroll
                for (int m = 0; m < 4; ++m) { const int r = ai * HALF + wr * 64 + m * 16 + fr; const float rs = S[r]; const size_t off = ((size_t)u.pm * BM + r) * 1024 + col; const f32x4 a0 = acc[ai][bj][m][0], a1 = acc[ai][bj][m][1];
                    if (MODE == 0) { u32x4 xw; xw.x = cvt_pk_bf16(a0[0], a0[1]); xw.y = cvt_pk_bf16(a0[2], a0[3]); xw.z = cvt_pk_bf16(a1[0], a1[1]); xw.w = cvt_pk_bf16(a1[2], a1[3]); __builtin_nontemporal_store(xw, (u32x4*)(x1b + off));
                        const f32x4 h0 = a0 * rs * gm[0] + sh[0], h1 = a1 * rs * gm[1] + sh[1]; u32x4 w; w.x = cvt_pk_bf16(h0[0], h0[1]); w.y = cvt_pk_bf16(h0[2], h0[3]); w.z = cvt_pk_bf16(h1[0], h1[1]); w.w = cvt_pk_bf16(h1[2], h1[3]); *(u32x4*)(hb + off) = w; }
                    else { __builtin_nontemporal_store(a0 * rs * gm[0], (f32x4*)(out + off)); __builtin_nontemporal_store(a1 * rs * gm[1], (f32x4*)(out + off + 4)); } } }
    }
};

struct EpiQKV {
    static constexpr bool PERM = true;
    bf16_t *Qb, *Kb, *Vb, *Zb; float *okp, *oks, *ovp, *ovs, *olp, *ols; const float* bf; float c2;
    __device__ __forceinline__ void operator()(f32x4 (&acc)[2][2][4][2], const Unit& u, int wr, int wc, int fr, int fq, PG8_LAS unsigned char*, int) const {
        const int t = u.pn >> 2; const bool samp = u.pm >= NPROMPT_TILES;
        const size_t row0 = (size_t)u.pm * BM + wr * 64 + fr;
        if (t == 4) {
            if (wc == 0 && fq < 2) {
                float* ob = samp ? ols - (size_t)PROMPT_ROWS * 16 : olp;
#pragma unroll
                for (int n = 0; n < 2; ++n) { const f32x4 bv = *(const f32x4*)(bf + 8 * fq + 4 * n);
#pragma unroll
                    for (int ai = 0; ai < 2; ++ai)
#pragma unroll
                        for (int m = 0; m < 4; ++m) { const f32x4 a = acc[ai][0][m][n] + bv; f32x4 lf;
#pragma unroll
                            for (int i = 0; i < 4; ++i) lf[i] = fminf(a[i], 0.f) - log1pf(expf(-fabsf(a[i])));
                            *(f32x4*)(ob + (row0 + ai * HALF + m * 16) * 16 + 8 * fq + 4 * n) = lf; } }
            }
            return;
        }
        const int col0 = (u.pn & 3) * BM + wc * 32 + 8 * fq;
        bf16_t* bo = t == 0 ? Qb : t == 1 ? Kb : t == 2 ? Vb : Zb;
        float* fo = t == 1 ? (samp ? oks - (size_t)PROMPT_ROWS * 1024 : okp) : (samp ? ovs - (size_t)PROMPT_ROWS * 1024 : ovp);
#pragma unroll
        for (int ai = 0; ai < 2; ++ai)
#pragma unroll
            for (int m = 0; m < 4; ++m) { const size_t off = (row0 + ai * HALF + m * 16) * 1024 + col0;
#pragma unroll
                for (int bj = 0; bj < 2; ++bj) { f32x4 v0 = acc[ai][bj][m][0], v1 = acc[ai][bj][m][1];
                    if ((t == 1 || t == 2) && samp) { __builtin_nontemporal_store(v0, (f32x4*)(fo + off + bj * HALF)); __builtin_nontemporal_store(v1, (f32x4*)(fo + off + bj * HALF + 4)); }
                    if (t == 0) { v0 = v0 * c2; v1 = v1 * c2; }
                    if (t == 3) {
#pragma unroll
                        for (int i = 0; i < 4; ++i) { v0[i] = silu_f(v0[i]); v1[i] = silu_f(v1[i]); } }
                    u32x4 w; w.x = cvt_pk_bf16(v0[0], v0[1]); w.y = cvt_pk_bf16(v0[2], v0[3]); w.z = cvt_pk_bf16(v1[0], v1[1]); w.w = cvt_pk_bf16(v1[2], v1[3]);
                    *(u32x4*)(bo + off + bj * HALF) = w; } }
    }
};
template <class Epi, class Sched, bool ALIGN_EPI = false, bool SP2 = false>
__device__ __forceinline__ void gemm_phase(PG8_LAS unsigned char* lds, PG8_LAS unsigned char* xlds, const Gemm g, const Sched& S, const Epi& E) {
    const int tid = threadIdx.x, wid = __builtin_amdgcn_readfirstlane(tid >> 6), lane = tid & 63, wr = wid >> 2, wc = wid & 3, fr = lane & 15, fq = lane >> 4;
    const int K = g.K; int nt;
    unsigned voffA[2], voffB[2];
#pragma unroll
    for (int i = 0; i < 2; ++i) { int R, C; stage_rc(tid * 16 + i * 8192, R, C); const int Rb = Epi::PERM ? ((R & ~31) + perm32(R & 31)) : R;
        voffA[i] = (unsigned)(R * K + C) * 2u; voffB[i] = (unsigned)(Rb * K + C) * 2u; }
    const size_t kstep = (size_t)(BK * 2);
    const size_t hstep = (size_t)HALF * K * 2;
    const size_t tstep = 2 * hstep;
    const unsigned ldsw = (unsigned)wid * 1024u;
    const int aoff = lds_byte(wr * 64 + fr, fq * 8), boff = lds_byte(wc * 32 + fr, fq * 8);
#define PG8_SA(b, h) (((b) * 2 + (h)) * HTB)
#define PG8_SB(b, h) ((4 + (b) * 2 + (h)) * HTB)
#define PG8_STAGE(bufoff, gbase, voff) do { _Pragma("unroll") for (int _i = 0; _i < 2; ++_i) \
        __builtin_amdgcn_global_load_lds((const unsigned*)((const char*)(gbase) + (voff)[_i]), (PG8_LAS unsigned*)(lds + (bufoff) + ldsw + _i * 8192), 16, 0, 0); } while (0)
#define PG8_LDA(dst, b, h) do { _Pragma("unroll") for (int m = 0; m < 4; ++m) _Pragma("unroll") for (int k = 0; k < 2; ++k) dst[m][k] = *(const PG8_LAS bf16x8*)(lds + PG8_SA(b, h) + aoff + m * 2048 + k * 1024); } while (0)
#define PG8_LDB(dst, b, h) do { _Pragma("unroll") for (int n = 0; n < 2; ++n) _Pragma("unroll") for (int k = 0; k < 2; ++k) dst[n][k] = *(const PG8_LAS bf16x8*)(lds + PG8_SB(b, h) + boff + n * 2048 + k * 1024); } while (0)
#define PG8_MMA(ai, bj, At, Bt) do { __builtin_amdgcn_s_setprio(1); _Pragma("unroll") for (int m = 0; m < 4; ++m) _Pragma("unroll") for (int n = 0; n < 2; ++n) _Pragma("unroll") for (int k = 0; k < 2; ++k) \
        acc[ai][bj][m][n] = __builtin_amdgcn_mfma_f32_16x16x32_bf16(Bt[n][k], At[m][k], acc[ai][bj][m][n], 0, 0, 0); __builtin_amdgcn_s_setprio(0); } while (0)
#define PG8_WAIT_V(n) asm volatile("s_waitcnt vmcnt(" #n ")" ::: "memory")
#define PG8_WAIT_L(n) asm volatile("s_waitcnt lgkmcnt(" #n ")" ::: "memory")
#define PG8_BAR __builtin_amdgcn_s_barrier()
#define PG8_SCHED __builtin_amdgcn_sched_barrier(0)
    Unit cur, nxt; int ui = 0;
    if (!S.next(0, cur)) return;
    nt = cur.nt;
    f32x4 acc[2][2][4][2];
#pragma unroll
    for (int a = 0; a < 2; ++a)
#pragma unroll
        for (int b = 0; b < 2; ++b)
#pragma unroll
            for (int m = 0; m < 4; ++m)
#pragma unroll
                for (int n = 0; n < 2; ++n) acc[a][b][m][n] = (f32x4){0.f, 0.f, 0.f, 0.f};
    bf16x8 At[4][2], B0[2][2], B1[2][2];
    const char* cA = (const char*)g.A + (size_t)cur.pm * tstep + (size_t)cur.k0 * 2; const char* cB = (const char*)g.Bt + (size_t)cur.pn * tstep + (size_t)cur.k0 * 2;
    if constexpr (SP2) {
        PG8_STAGE(PG8_SB(0, 0), cB, voffB); PG8_STAGE(PG8_SB(0, 1), cB + hstep, voffB); PG8_STAGE(PG8_SA(0, 0), cA, voffA); PG8_STAGE(PG8_SA(0, 1), cA + hstep, voffA);
        if (wr == 1) PG8_BAR;
        PG8_WAIT_V(2); PG8_BAR;
        PG8_STAGE(PG8_SB(1, 0), cB + kstep, voffB); PG8_STAGE(PG8_SA(1, 0), cA + kstep, voffA); PG8_STAGE(PG8_SB(1, 1), cB + hstep + kstep, voffB);
        PG8_WAIT_V(6); PG8_BAR;
    } else {
        PG8_STAGE(PG8_SB(0, 0), cB, voffB); PG8_STAGE(PG8_SA(0, 0), cA, voffA); PG8_STAGE(PG8_SB(0, 1), cB + hstep, voffB); PG8_STAGE(PG8_SA(0, 1), cA + hstep, voffA);
        if (wr == 1) PG8_BAR;
        PG8_WAIT_V(4); PG8_BAR;
        PG8_STAGE(PG8_SB(1, 0), cB + kstep, voffB); PG8_STAGE(PG8_SA(1, 0), cA + kstep, voffA); PG8_STAGE(PG8_SB(1, 1), cB + hstep + kstep, voffB);
        PG8_WAIT_V(6); PG8_BAR;
    }
    for (;;) {
        const bool has_next = S.next(ui + 1, nxt);
        const char* nA = has_next ? (const char*)g.A + (size_t)nxt.pm * tstep + (size_t)nxt.k0 * 2 : cA; const char* nB = has_next ? (const char*)g.Bt + (size_t)nxt.pn * tstep + (size_t)nxt.k0 * 2 : cB;
        for (int t = 0; t < nt; t += 2) {
            const bool last = (t == nt - 2);
            const char* a1 = cA + (size_t)(t + 1) * kstep;
            const char* a2 = last ? nA : cA + (size_t)(t + 2) * kstep; const char* b2 = last ? nB : cB + (size_t)(t + 2) * kstep;
            const char* a3 = a2 + kstep; const char* b3 = b2 + kstep;
            if constexpr (SP2) {
            PG8_LDB(B0, 0, 0); PG8_LDB(B1, 0, 1); PG8_SCHED; PG8_LDA(At, 0, 0); PG8_STAGE(PG8_SA(1, 1), a1 + hstep, voffA);
            PG8_WAIT_V(8); PG8_WAIT_L(0); PG8_BAR; PG8_MMA(0, 0, At, B0); PG8_MMA(0, 1, At, B1); PG8_BAR; PG8_SCHED;
            PG8_LDA(At, 0, 1); PG8_STAGE(PG8_SB(0, 0), b2, voffB); PG8_STAGE(PG8_SB(0, 1), b2 + hstep, voffB); PG8_STAGE(PG8_SA(0, 0), a2, voffA);
            PG8_WAIT_V(8); PG8_WAIT_L(0); PG8_BAR; PG8_MMA(1, 0, At, B0); PG8_MMA(1, 1, At, B1); PG8_BAR; PG8_SCHED;
            PG8_LDB(B0, 1, 0); PG8_LDB(B1, 1, 1); PG8_SCHED; PG8_LDA(At, 1, 0); PG8_STAGE(PG8_SA(0, 1), a2 + hstep, voffA);
            PG8_WAIT_V(8); PG8_WAIT_L(0); PG8_BAR; PG8_MMA(0, 0, At, B0); PG8_MMA(0, 1, At, B1); PG8_BAR; PG8_SCHED;
            PG8_LDA(At, 1, 1); PG8_STAGE(PG8_SB(1, 0), b3, voffB); PG8_STAGE(PG8_SB(1, 1), b3 + hstep, voffB); PG8_STAGE(PG8_SA(1, 0), a3, voffA);
            PG8_WAIT_V(8); PG8_WAIT_L(0); PG8_BAR; PG8_MMA(1, 0, At, B0); PG8_MMA(1, 1, At, B1); PG8_BAR; PG8_SCHED;
            } else {
            PG8_LDB(B0, 0, 0); PG8_SCHED; PG8_LDA(At, 0, 0); PG8_STAGE(PG8_SA(1, 1), a1 + hstep, voffA);
            PG8_WAIT_L(8); PG8_BAR; PG8_WAIT_L(0); PG8_MMA(0, 0, At, B0); PG8_BAR; PG8_SCHED;
            PG8_LDB(B1, 0, 1); PG8_STAGE(PG8_SB(0, 0), b2, voffB);
            PG8_BAR; PG8_WAIT_L(0); PG8_MMA(0, 1, At, B1); PG8_BAR;
            PG8_LDA(At, 0, 1); PG8_STAGE(PG8_SA(0, 0), a2, voffA);
            PG8_BAR; PG8_WAIT_L(0); PG8_MMA(1, 0, At, B0); PG8_BAR; PG8_SCHED;
            PG8_STAGE(PG8_SB(0, 1), b2 + hstep, voffB);
            PG8_WAIT_V(6); PG8_BAR; PG8_MMA(1, 1, At, B1); PG8_BAR;
            PG8_LDB(B0, 1, 0); PG8_SCHED; PG8_LDA(At, 1, 0); PG8_STAGE(PG8_SA(0, 1), a2 + hstep, voffA);
            PG8_WAIT_L(8); PG8_BAR; PG8_WAIT_L(0); PG8_MMA(0, 0, At, B0); PG8_BAR; PG8_SCHED;
            PG8_LDB(B1, 1, 1); PG8_STAGE(PG8_SB(1, 0), b3, voffB);
            PG8_BAR; PG8_WAIT_L(0); PG8_MMA(0, 1, At, B1); PG8_BAR;
            PG8_LDA(At, 1, 1); PG8_STAGE(PG8_SA(1, 0), a3, voffA);
            PG8_BAR; PG8_WAIT_L(0); PG8_MMA(1, 0, At, B0); PG8_BAR; PG8_SCHED;
            PG8_STAGE(PG8_SB(1, 1), b3 + hstep, voffB);
            PG8_WAIT_V(6); PG8_BAR; PG8_MMA(1, 1, At, B1); PG8_BAR;
            }
        }
        if constexpr (ALIGN_EPI) { if (wr == 0) PG8_BAR; }
        E(acc, cur, wr, wc, fr, fq, xlds, ui);
        if (!has_next) break;
#pragma unroll
        for (int a = 0; a < 2; ++a)
#pragma unroll
            for (int b = 0; b < 2; ++b)
#pragma unroll
                for (int m = 0; m < 4; ++m)
#pragma unroll
                    for (int n = 0; n < 2; ++n) acc[a][b][m][n] = (f32x4){0.f, 0.f, 0.f, 0.f};
        cur = nxt; cA = nA; cB = nB; ++ui; nt = cur.nt;
        if constexpr (ALIGN_EPI) { if (wr == 1) PG8_BAR; }
    }
    PG8_WAIT_V(0);
    if constexpr (!ALIGN_EPI) { if (wr == 0) PG8_BAR; }
    PG8_BAR;
#undef PG8_SA
#undef PG8_SB
#undef PG8_STAGE
#undef PG8_LDA
#undef PG8_LDB
#undef PG8_MMA
#undef PG8_WAIT_V
#undef PG8_WAIT_L
#undef PG8_BAR
#undef PG8_SCHED
}
}
constexpr int NWAVES = 8;
constexpr int DM = 1024, NB_P = 16, SEQ = 2048, NB_S = 8, TS = 64, PAST = 1024, NH = 16, HD = 64, EW = 2048;
constexpr int MP = NB_P * SEQ, MS = NB_S * TS, MT = MP + MS;
constexpr int N1 = 4 * EW, N3 = 4352;
constexpr float RMS_EPS = 1e-6f, LOG2E = 1.4426950408889634f;
constexpr size_t O_Y = 0, O_CONVP = (size_t)MT * DM, O_KP = O_CONVP + (size_t)NB_P * 2 * EW, O_VP = O_KP + (size_t)MP * DM, O_LP = O_VP + (size_t)MP * DM,
                 O_CONVS = O_LP + (size_t)MP * NH, O_KS = O_CONVS + (size_t)NB_S * 2 * EW, O_VS = O_KS + (size_t)MS * DM, O_LS = O_VS + (size_t)MS * DM, O_END = O_LS + (size_t)MS * NH;
static_assert(O_END == 102866944, "output size");
constexpr size_t MiB = 1u << 20;
constexpr size_t WS_CTL = 0, CTL_ZERO_BYTES = 1 * MiB;
constexpr size_t WS_MOD = 128 * 1024, WS_CNT = 16 * 1024;
constexpr size_t WS_W1 = 1 * MiB, WS_W2 = 17 * MiB, WS_W3 = 21 * MiB, WS_W4 = 30 * MiB;
constexpr size_t WS_H = 32 * MiB;
constexpr size_t WS_Y = 98 * MiB;
constexpr size_t WS_Q = WS_Y, WS_K = WS_Y + 65 * MiB, WS_V = 228 * MiB, WS_Z = 293 * MiB, WS_SLAB = 358 * MiB  , WS_AO = 374 * MiB  , WS_X = 439 * MiB  , WS_X1 = 440 * MiB  , WS_END = 504 * MiB;
static_assert((size_t)MT * DM * 2 == 65 * MiB && WS_W3 + (size_t)N3 * DM * 2 <= WS_W4 && WS_W4 + 2 * MiB <= WS_H, "ws map");
constexpr int RING_BYTES = 131072, XL_OFF = RING_BYTES, LDS_BYTES = 155648;
#define LAS __attribute__((address_space(3)))
typedef unsigned short bf16;
typedef unsigned v4u __attribute__((ext_vector_type(4)));
typedef unsigned v2u __attribute__((ext_vector_type(2)));
typedef float f32x4 __attribute__((ext_vector_type(4)));
typedef short bf16x8 __attribute__((ext_vector_type(8)));
#define LDS_WAIT() asm volatile("s_waitcnt lgkmcnt(0)" ::: "memory")
__device__ __forceinline__ unsigned f2bf(float f) { unsigned u = __builtin_bit_cast(unsigned, f); return (u + 0x7fffu + ((u >> 16) & 1u)) >> 16; }
__device__ __forceinline__ unsigned pk2(float lo, float hi) { return f2bf(lo) | (f2bf(hi) << 16); }
__device__ __forceinline__ float wave_sum(float v) {
#pragma unroll
    for (int o = 1; o < 64; o <<= 1) v += __shfl_xor(v, o);
    return v;
}

template <int MODE> __device__ __forceinline__ void p0_transpose_item(const float* W, int K, int N, bf16* WT, LAS float* scr, int item, int lane) {
    const int nblk = (N + 63) / 64, kb = item / nblk, nb = item % nblk, k0 = 64 * kb, n0 = 64 * nb;
    const int ks = lane >> 4, n4 = (lane & 15) * 4, ncol = min(n0 + n4, N - 4);
    f32x4 v[16];
#pragma unroll
    for (int i = 0; i < 16; ++i) v[i] = __builtin_nontemporal_load((const f32x4*)(W + (size_t)(k0 + 4 * i + ks) * N + ncol));
#pragma unroll
    for (int i = 0; i < 16; ++i) { LAS float* d = scr + (4 * i + ks) * 65 + n4; d[0] = v[i].x; d[1] = v[i].y; d[2] = v[i].z; d[3] = v[i].w; }
    LDS_WAIT(); asm volatile("" ::: "memory");
    const int c = lane & 7;
#pragma unroll
    for (int j = 0; j < 8; ++j) { const int n = (lane >> 3) + 8 * j; const LAS float* s = scr + (8 * c) * 65 + n;
        v4u o; o.x = pk2(s[0 * 65], s[1 * 65]); o.y = pk2(s[2 * 65], s[3 * 65]); o.z = pk2(s[4 * 65], s[5 * 65]); o.w = pk2(s[6 * 65], s[7 * 65]);
        int drow = n0 + n;
        if (MODE == 1) { const int g = drow >> 11, e = drow & 2047, pn = e >> 6, ch = e & 63; drow = pn * 256 + (g >> 1) * 128 + (ch >> 4) * 32 + (g & 1) * 16 + (ch & 15); }
        *(v4u*)(WT + (size_t)drow * K + k0 + 8 * c) = o; }
    LDS_WAIT(); asm volatile("" ::: "memory");
}
__device__ __forceinline__ void ada_norm_row(const float* xrow, bf16* orow, const float* g, const float* mod, int lane, const float* slab = nullptr, const float* gate = nullptr, float* xst = nullptr) {
    const f32x4* xr = (const f32x4*)xrow + lane;
    f32x4 v[4]; float s = 0.f;
#pragma unroll
    for (int j = 0; j < 4; ++j) { v[j] = xr[64 * j];
        if (slab) { f32x4 p = ((const f32x4*)slab)[64 * j + lane];
#pragma unroll
            for (int q = 1; q < 8; ++q) p += ((const f32x4*)(slab + (size_t)q * 512 * 1024))[64 * j + lane];
            v[j] += ((const f32x4*)gate)[64 * j + lane] * p; ((f32x4*)xst)[64 * j + lane] = v[j]; }
        s += (v[j].x * v[j].x + v[j].y * v[j].y) + (v[j].z * v[j].z + v[j].w * v[j].w); }
    const float rstd = 1.f / sqrtf(wave_sum(s) * (1.f / DM) + RMS_EPS);
    unsigned long long* o8 = (unsigned long long*)orow + lane;
#pragma unroll
    for (int j = 0; j < 4; ++j) { const f32x4 gg = ((const f32x4*)g)[64 * j + lane], sh = ((const f32x4*)mod)[64 * j + lane], sc = ((const f32x4*)(mod + DM))[64 * j + lane];
        const f32x4 h = v[j] * rstd * gg * (sc + 1.0f) + sh;
        o8[64 * j] = (unsigned long long)pk2(h.x, h.y) | ((unsigned long long)pk2(h.z, h.w) << 32); }
}
__device__ __forceinline__ void ada_norm_rows(const float* x0, bf16* o0, int nrows, const float* g, const float* mod, int lane) {
    f32x4 gm[4], sh[4];
#pragma unroll
    for (int j = 0; j < 4; ++j) { gm[j] = ((const f32x4*)g)[64 * j + lane] * (((const f32x4*)(mod + DM))[64 * j + lane] + 1.0f); sh[j] = ((const f32x4*)mod)[64 * j + lane]; }
    f32x4 v[4], w[4];
#pragma unroll
    for (int j = 0; j < 4; ++j) v[j] = __builtin_nontemporal_load((const f32x4*)x0 + 64 * j + lane);
    for (int r = 0; r < nrows; ++r) {
        const float* xn = x0 + (size_t)(r + 1 < nrows ? r + 1 : r) * DM;
#pragma unroll
        for (int j = 0; j < 4; ++j) w[j] = __builtin_nontemporal_load((const f32x4*)xn + 64 * j + lane);
        float s = 0.f;
#pragma unroll
        for (int j = 0; j < 4; ++j) s += (v[j].x * v[j].x + v[j].y * v[j].y) + (v[j].z * v[j].z + v[j].w * v[j].w);
        const float rstd = 1.f / sqrtf(wave_sum(s) * (1.f / DM) + RMS_EPS);
        unsigned long long* o8 = (unsigned long long*)(o0 + (size_t)r * DM) + lane;
#pragma unroll
        for (int j = 0; j < 4; ++j) { const f32x4 h = v[j] * rstd * gm[j] + sh[j]; o8[64 * j] = (unsigned long long)pk2(h.x, h.y) | ((unsigned long long)pk2(h.z, h.w) << 32); v[j] = w[j]; }
    }
}
__device__ __forceinline__ void final_norm_row(float* xrow, const float* g, int lane, const float* slab = nullptr, const float* gate = nullptr) {
    f32x4* xr = (f32x4*)xrow + lane;
    f32x4 v[4]; float s = 0.f;
#pragma unroll
    for (int j = 0; j < 4; ++j) { v[j] = xr[64 * j];
        if (slab) { f32x4 p = ((const f32x4*)slab)[64 * j + lane];
#pragma unroll
            for (int q = 1; q < 8; ++q) p += ((const f32x4*)(slab + (size_t)q * 512 * 1024))[64 * j + lane];
            v[j] += ((const f32x4*)gate)[64 * j + lane] * p; }
        s += (v[j].x * v[j].x + v[j].y * v[j].y) + (v[j].z * v[j].z + v[j].w * v[j].w); }
    const float rstd = 1.f / sqrtf(wave_sum(s) * (1.f / DM) + RMS_EPS);
#pragma unroll
    for (int j = 0; j < 4; ++j) xr[64 * j] = v[j] * rstd * ((const f32x4*)g)[64 * j + lane];
}
__device__ __forceinline__ void block_scan4(f32x4 v, float* dst, LAS float* wtot, int tid, int nthr) {
    const int lane = tid & 63, wave = tid >> 6;
    v.y += v.x; v.z += v.y; v.w += v.z;
    float incl = v.w;
#pragma unroll
    for (int o = 1; o < 64; o <<= 1) { const float t = __builtin_bit_cast(float, __builtin_amdgcn_ds_bpermute((lane - o) << 2, __builtin_bit_cast(int, incl))); if (lane >= o) incl += t; }
    if (lane == 63) wtot[wave] = incl;
    LDS_WAIT(); __builtin_amdgcn_s_barrier(); asm volatile("" ::: "memory");
    float base = incl - v.w;
    for (int w = 0; w < wave; ++w) base += wtot[w];
    if (tid < nthr) *(f32x4*)(dst + 4 * tid) = (v + base) * (-LOG2E);
    LDS_WAIT(); __builtin_amdgcn_s_barrier(); asm volatile("" ::: "memory");
}
namespace attn_body {
using bf16=__hip_bfloat16;
using bf16x8=__attribute__((ext_vector_type(8)))short;
using s16x4=__attribute__((ext_vector_type(4)))short;
using f32x16=__attribute__((ext_vector_type(16)))float;
using u32x4=__attribute__((ext_vector_type(4)))unsigned;
using f32x4=__attribute__((ext_vector_type(4)))float;
constexpr int BATCH=16,NHEAD=16,SEQ=2048,D=64,DM=NHEAD*D;
constexpr int NW=8,QBLK=32,QB=QBLK*NW,KVBLK=64,NQB=SEQ/QB;
constexpr int ATTN_PITCH=DM, ATTN_UNIT_ROWS=QB;
__device__ __forceinline__ int crow(int r,int hi){return (r&3)+8*(r>>2)+4*hi;}
#define SBAR() __builtin_amdgcn_sched_barrier(0)
__device__ __forceinline__ void cmask(f32x16&p0,f32x16&p1,int jb,int qrel,int hi){
  const float NEG=-INFINITY; int kb=64*jb+4*hi;
  #pragma unroll
  for(int r=0;r<16;++r){int kv=kb+(r&3)+8*(r>>2); if(kv>qrel)p0[r]=NEG; if(kv+32>qrel)p1[r]=NEG;}
}

constexpr int NSLOT=3, SLOTB=8192;
constexpr int LDS_K=0, LDS_V=NSLOT*SLOTB, LDS_WS=2*NSLOT*SLOTB, LDS_OST=LDS_WS+NW*64*4, LDS_BYTES=LDS_OST+NW*4096;
constexpr float C2=0.125f*1.4426950408889634f;
__device__ __forceinline__ void glds16(const void*gsrc,unsigned lds_dst){unsigned keep;
  asm volatile("s_mov_b32 %0, m0\n\ts_mov_b32 m0, %2\n\ts_nop 0\n\tglobal_load_lds_dwordx4 %1, off\n\ts_mov_b32 m0, %0":"=&s"(keep):"v"(gsrc),"s"(lds_dst):"memory");}
__device__ __forceinline__ float max3f(float a,float b,float c){float r;asm("v_max3_f32 %0, %1, %2, %3":"=v"(r):"v"(a),"v"(b),"v"(c));return r;}
__device__ __forceinline__ float max2f(float a,float b){float r;asm("v_max_f32_e32 %0, %1, %2":"=v"(r):"v"(a),"v"(b));return r;}
__device__ __forceinline__ float fadd_s(float a,float b){float r;asm("v_add_f32_e32 %0, %1, %2":"=v"(r):"v"(a),"v"(b));return r;}
__device__ __forceinline__ float fsub_s(float a,float b){float r;asm("v_sub_f32_e32 %0, %1, %2":"=v"(r):"v"(a),"v"(b));return r;}
typedef float f32x2_t __attribute__((ext_vector_type(2))); typedef __bf16 bf16x2_t __attribute__((ext_vector_type(2)));
__device__ __forceinline__ unsigned cvtpk_s(float lo,float hi){f32x2_t v={lo,hi};bf16x2_t b=__builtin_convertvector(v,bf16x2_t);return __builtin_bit_cast(unsigned,b);}
#define WAIT_BAR(N) asm volatile("s_waitcnt vmcnt(" #N ") lgkmcnt(0)\n\ts_barrier":::"memory")

__device__ __forceinline__ void qkt(f32x16&p0,f32x16&p1,const char*Kslot,const bf16x8*qr,int r32,int hi){
  const char*kb=Kslot+hi*1024+r32*16;
  #pragma unroll
  for(int d0=0;d0<4;++d0){
    const bf16x8 b0=*reinterpret_cast<const bf16x8*>(kb+d0*2048);
    const bf16x8 b1=*reinterpret_cast<const bf16x8*>(kb+d0*2048+512);
    {p0=__builtin_amdgcn_mfma_f32_32x32x16_bf16(b0,qr[d0],p0,0,0,0);p1=__builtin_amdgcn_mfma_f32_32x32x16_bf16(b1,qr[d0],p1,0,0,0);}}
}
typedef __attribute__((address_space(3))) const char* lds_cptr;
typedef short v4i16_t __attribute__((ext_vector_type(4)));
__device__ __forceinline__ void kload8(bf16x8*kf,lds_cptr kp){
  kf[0]=*(const __attribute__((address_space(3))) bf16x8*)(kp);      kf[1]=*(const __attribute__((address_space(3))) bf16x8*)(kp+512);
  kf[2]=*(const __attribute__((address_space(3))) bf16x8*)(kp+2048); kf[3]=*(const __attribute__((address_space(3))) bf16x8*)(kp+2560);
  kf[4]=*(const __attribute__((address_space(3))) bf16x8*)(kp+4096); kf[5]=*(const __attribute__((address_space(3))) bf16x8*)(kp+4608);
  kf[6]=*(const __attribute__((address_space(3))) bf16x8*)(kp+6144); kf[7]=*(const __attribute__((address_space(3))) bf16x8*)(kp+6656);
}
__device__ __forceinline__ void kload2(bf16x8*kf,lds_cptr kp,int j){ kf[2*j]=*(const __attribute__((address_space(3))) bf16x8*)(kp+j*2048); kf[2*j+1]=*(const __attribute__((address_space(3))) bf16x8*)(kp+j*2048+512); }
__device__ __forceinline__ s16x4 vtr(lds_cptr p){ return __builtin_bit_cast(s16x4,__builtin_amdgcn_ds_read_tr16_b64_v4i16((__attribute__((address_space(3))) v4i16_t*)p)); }
__device__ __forceinline__ float rowmax(const f32x16&p0,const f32x16&p1){
  float a=max3f(p0[0],p0[1],p1[0]),b=max3f(p0[2],p0[3],p1[1]);a=max3f(a,p1[2],p1[3]);
  #pragma unroll
  for(int r=4;r<16;r+=4){a=max3f(a,p0[r],p0[r+1]);b=max3f(b,p0[r+2],p0[r+3]);a=max3f(a,p1[r],p1[r+1]);b=max3f(b,p1[r+2],p1[r+3]);}
  const float m=max2f(a,b);
  auto rr=__builtin_amdgcn_permlane32_swap(__float_as_uint(m),__float_as_uint(m),false,false);
  return max2f(__uint_as_float(rr[0]),__uint_as_float(rr[1]));
}
__device__ __forceinline__ void pv(f32x16*o,int vb,bf16x8 pa0,bf16x8 pa1,bf16x8 pa2,bf16x8 pa3){
  #pragma unroll
  for(int d0=0;d0<2;++d0){s16x4 lo[4],hi[4];
    #pragma unroll
    for(int ks=0;ks<4;++ks){
      asm volatile("ds_read_b64_tr_b16 %0,%1 offset:%c2":"=&v"(lo[ks]):"v"(vb),"i"(d0*4096+ks*1024):"memory");
      asm volatile("ds_read_b64_tr_b16 %0,%1 offset:%c2":"=&v"(hi[ks]):"v"(vb),"i"(d0*4096+ks*1024+512):"memory");}
    asm volatile("s_waitcnt lgkmcnt(0)":::"memory");SBAR();
    #define PK(k) (bf16x8){lo[k][0],lo[k][1],lo[k][2],lo[k][3],hi[k][0],hi[k][1],hi[k][2],hi[k][3]}
    o[d0]=__builtin_amdgcn_mfma_f32_32x32x16_bf16(pa0,PK(0),o[d0],0,0,0);
    o[d0]=__builtin_amdgcn_mfma_f32_32x32x16_bf16(pa1,PK(1),o[d0],0,0,0);
    o[d0]=__builtin_amdgcn_mfma_f32_32x32x16_bf16(pa2,PK(2),o[d0],0,0,0);
    o[d0]=__builtin_amdgcn_mfma_f32_32x32x16_bf16(pa3,PK(3),o[d0],0,0,0);
    #undef PK
  }
}

#ifndef ATTN_STORE16
#define ATTN_STORE16(p,v) (*(u32x4*)(p)=(v))
#endif
template<int THRL> __device__ __forceinline__ void attn_unit(int b,int h,int qb,const bf16*Q,const bf16*__restrict__ K,const bf16*__restrict__ V,const bf16*__restrict__ Zs,bf16*O,char*shm,const float*biasL,float*Kf,float*Vf){
  int tid=threadIdx.x; asm volatile("":"+v"(tid)); const int lane=tid&63,r32=lane&31,hi=lane>>5; const int wid=__builtin_amdgcn_readfirstlane(tid>>6);
  const long rowbase=(long)b*SEQ; const int q0=qb*QB;
  const bf16*Qw=Q+(rowbase+q0+wid*QBLK)*DM+h*D;
  const bf16*Kh=K+rowbase*DM+h*D,*Vh=V+rowbase*DM+h*D;
  const unsigned lds0=(unsigned)(uintptr_t)shm;
  float*wsf=(float*)(shm+LDS_WS)+wid*64;
  const bf16*ksrc=Kh+(long)lane*DM+wid*8;
  const bf16*vsrc=Vh+(long)(16*(wid&3)+(lane>>2))*DM+(wid>>2)*32+(lane&3)*8;
  const unsigned kdst=lds0+LDS_K+wid*1024, vdst=lds0+LDS_V+wid*1024;
  #define DMA_K(t,slot) glds16(ksrc+(long)(t)*KVBLK*DM,(unsigned)__builtin_amdgcn_readfirstlane(kdst+(slot)))
  #define DMA_V(t,slot) glds16(vsrc+(long)(t)*KVBLK*DM,(unsigned)__builtin_amdgcn_readfirstlane(vdst+(slot)))
  const int vb0=(int)(lds0+LDS_V)+((lane>>4)&1)*32+(lane&3)*8+(4*hi+((lane&15)>>2))*64;
  const char*Kbase=shm+LDS_K; bf16x8 kf[8];
  const lds_cptr shm3=(lds_cptr)shm; const lds_cptr kp0=shm3+LDS_K+hi*1024+r32*16; const lds_cptr vp0=shm3+LDS_V+((lane>>4)&1)*32+(lane&3)*8+(4*hi+((lane&15)>>2))*64;
  const int NT=(q0+QB)/KVBLK;
  DMA_K(0,0);DMA_V(0,0);DMA_K(1,SLOTB);
  bf16x8 qr[4];
  #pragma unroll
  for(int d0=0;d0<4;++d0)qr[d0]=*reinterpret_cast<const bf16x8*>(&Qw[(long)r32*DM+d0*16+hi*8]);
  float mhat=0.f,l_reg=0.f;f32x16 o[2];o[0]=f32x16{};o[1]=f32x16{};
  const int qrel=wid*QBLK+r32;
  mhat=biasL[q0+qrel];
  #define BINITH(X,t,off) do{ const float*bp_=biasL+(t)*KVBLK+4*hi+(off); \
    _Pragma("unroll") for(int j_=0;j_<4;++j_){ const f32x4 a_=*(const f32x4*)(bp_+8*j_); \
      _Pragma("unroll") for(int i_=0;i_<4;++i_){ X[4*j_+i_]=a_[i_]-mhat; } } }while(0)
  #define BINIT(X0,X1,t) do{ BINITH(X0,t,0); BINITH(X1,t,32); }while(0)
  #define CMASK(P0,P1,t) do{int jb_=(t)-(NT-4); if(jb_>=0)cmask(P0,P1,jb_,qrel,hi);}while(0)
  bool resc=false;
  #define START(P0,P1) do{ const float rm=rowmax(P0,P1); resc=false; \
    { const float dl=(rm>(float)THRL)?rm:0.f; mhat=fadd_s(mhat,dl); \
      _Pragma("unroll") for(int r=0;r<16;++r){P0[r]=fsub_s(P0[r],dl);P1[r]=fsub_s(P1[r],dl);} \
      } \
    _Pragma("unroll") for(int r=0;r<16;++r)P0[r]=__builtin_amdgcn_exp2f(P0[r]); }while(0)
  #define RESC() do{ if(resc){ asm volatile("s_waitcnt lgkmcnt(0)":::"memory"); \
      _Pragma("unroll") for(int d_=0;d_<2;++d_) _Pragma("unroll") for(int r=0;r<16;++r)o[d_][r]*=wsf[crow(r,hi)]; } }while(0)
  f32x16 pA0,pA1,pB0,pB1;
  int sl_prev=0,sl_cur=0,sl_next=SLOTB;
  #define ROT() do{sl_prev=sl_cur;sl_cur=sl_next;sl_next=(sl_next==(NSLOT-1)*SLOTB)?0:sl_next+SLOTB;}while(0)
  DMA_K(2,2*SLOTB);
  WAIT_BAR(3);
  BINIT(pA0,pA1,0); qkt(pA0,pA1,Kbase,qr,r32,hi);asm volatile("s_nop 15\n\ts_nop 7":"+v"(pA0),"+v"(pA1));CMASK(pA0,pA1,0);
  START(pA0,pA1);
  BINIT(pB0,pB1,1);
  _Pragma("unroll") for(int r=0;r<16;++r)pA1[r]=__builtin_amdgcn_exp2f(pA1[r]);
  WAIT_BAR(0);
  DMA_K(3,0);DMA_V(1,SLOTB);
  ROT();
  kload8(kf,kp0+sl_cur);
  WAIT_BAR(2);
  s16x4 vlo[8],vhi[8]; u32x4 pw0,pw1,pw2,pw3;
  #define PKW(P,B) cvtpk_s(P[B],P[B+1])
  #define PAF(k) __builtin_bit_cast(bf16x8,pw##k)
  #define VFR(i) (bf16x8){vlo[i][0],vlo[i][1],vlo[i][2],vlo[i][3],vhi[i][0],vhi[i][1],vhi[i][2],vhi[i][3]}
  #define PIN(x) asm volatile("":"+v"(x))
  #define MX3(a,b,c) __builtin_fmaxf(__builtin_fmaxf((a),(b)),(c))
  #define GAPA(MF,A0,A1,A2,A3,W0,W1,PW) do{ MF; sacc+=A0; sacc+=A1; sacc+=A2; sacc+=A3; PIN(sacc); W0; W1; PIN(PW); SBAR(); }while(0)
  #define EX(v) __builtin_amdgcn_exp2f(v)
  #define GAPB(MF,X,B,GN,Y) do{ MF; X[B]=EX(X[B]); X[B+1]=EX(X[B+1]); X[B+2]=EX(X[B+2]); X[B+3]=EX(X[B+3]); PIN(X); if(GN){ Y[B]-=mhat; Y[B+1]-=mhat; Y[B+2]-=mhat; Y[B+3]-=mhat; PIN(Y); } SBAR(); }while(0)
  #define BLOAD(X0,X1,t) do{ const float*bp_=biasL+(t)*KVBLK+4*hi; \
    _Pragma("unroll") for(int j_=0;j_<4;++j_){ const f32x4 a_=*(const f32x4*)(bp_+8*j_), b_=*(const f32x4*)(bp_+32+8*j_); \
      _Pragma("unroll") for(int i_=0;i_<4;++i_){ X0[4*j_+i_]=a_[i_]; X1[4*j_+i_]=b_[i_]; } } }while(0)
  #define VRD(i) do{ vlo[i]=vtr(vp_+(((i)>>2)*4096+((i)&3)*1024)); vhi[i]=vtr(vp_+(((i)>>2)*4096+((i)&3)*1024+512)); }while(0)
  #define KRD(G,j) do{ if(G){ kload2(kf,kp0+sl_next,j); SBAR(); } }while(0)
  #define STEP(C0,C1,P0,P1,t,GK,GV,GL) do{ SBAR(); \
    const lds_cptr vp_=vp0+sl_prev; \
    VRD(0); SBAR(); float sacc=(P0[0]+P0[1]); \
    GAPA(C0=__builtin_amdgcn_mfma_f32_32x32x16_bf16(kf[0],qr[0],C0,0,0,0), P0[2],P0[3],P0[4],P0[5],     pw0[0]=PKW(P0,0), pw0[1]=PKW(P0,2), pw0); \
    VRD(4); SBAR(); GAPA(C1=__builtin_amdgcn_mfma_f32_32x32x16_bf16(kf[1],qr[0],C1,0,0,0), P0[6],P0[7],P0[8],P0[9],     pw0[2]=PKW(P0,4), pw0[3]=PKW(P0,6), pw0); \
    VRD(1); SBAR(); GAPA(C0=__builtin_amdgcn_mfma_f32_32x32x16_bf16(kf[2],qr[1],C0,0,0,0),   P0[10],P0[11],P0[12],P0[13], pw1[0]=PKW(P0,8), pw1[1]=PKW(P0,10), pw1); \
    VRD(5); SBAR(); GAPA(C1=__builtin_amdgcn_mfma_f32_32x32x16_bf16(kf[3],qr[1],C1,0,0,0),   P0[14],P0[15],P1[0],P1[1],   pw1[2]=PKW(P0,12),pw1[3]=PKW(P0,14), pw1); \
    VRD(2); SBAR(); GAPA(C0=__builtin_amdgcn_mfma_f32_32x32x16_bf16(kf[4],qr[2],C0,0,0,0),   P1[2],P1[3],P1[4],P1[5],     pw2[0]=PKW(P1,0), pw2[1]=PKW(P1,2), pw2); \
    VRD(6); SBAR(); GAPA(C1=__builtin_amdgcn_mfma_f32_32x32x16_bf16(kf[5],qr[2],C1,0,0,0),   P1[6],P1[7],P1[8],P1[9],     pw2[2]=PKW(P1,4), pw2[3]=PKW(P1,6), pw2); \
    VRD(3); SBAR(); GAPA(C0=__builtin_amdgcn_mfma_f32_32x32x16_bf16(kf[6],qr[3],C0,0,0,0),   P1[10],P1[11],P1[12],P1[13], pw3[0]=PKW(P1,8), pw3[1]=PKW(P1,10), pw3); \
    VRD(7); SBAR(); GAPA(C1=__builtin_amdgcn_mfma_f32_32x32x16_bf16(kf[7],qr[3],C1,0,0,0),   P1[14],P1[15],0.f,0.f,       pw3[2]=PKW(P1,12),pw3[3]=PKW(P1,14), pw3); \
    l_reg+=sacc; \
    if(GK){DMA_K((t)+3,sl_cur);} if(GV){DMA_V((t)+1,sl_next);} \
    CMASK(C0,C1,t); \
    { float a=MX3(C0[0],C0[1],C1[0]),b=MX3(C0[2],C0[3],C1[1]); a=MX3(a,C1[2],C1[3]); \
      _Pragma("unroll") for(int r=4;r<16;r+=4){a=MX3(a,C0[r],C0[r+1]);b=MX3(b,C0[r+2],C0[r+3]);a=MX3(a,C1[r],C1[r+1]);b=MX3(b,C1[r+2],C1[r+3]);} \
      float rm=__builtin_fmaxf(a,b); { auto rr=__builtin_amdgcn_permlane32_swap(__float_as_uint(rm),__float_as_uint(rm),false,false); rm=__builtin_fmaxf(__uint_as_float(rr[0]),__uint_as_float(rr[1])); } \
      resc=false; \
      if(__builtin_expect(__any(rm>(float)THRL),0)){ const float dl=__builtin_fmaxf(rm,0.f); mhat+=dl; \
        _Pragma("unroll") for(int r=0;r<16;++r){C0[r]-=dl;C1[r]-=dl;} \
        const float f=__builtin_amdgcn_exp2f(-dl); l_reg*=f; if(hi==0)wsf[r32]=f; resc=true; } } \
    SBAR(); if(GL){ BLOAD(P0,P1,(t)+1); } SBAR(); \
    GAPB(o[0]=__builtin_amdgcn_mfma_f32_32x32x16_bf16(PAF(0),VFR(0),o[0],0,0,0), C0,0,GL,P0); \
    GAPB(o[1]=__builtin_amdgcn_mfma_f32_32x32x16_bf16(PAF(0),VFR(4),o[1],0,0,0), C0,4,GL,P0); \
    KRD(GL,0); GAPB(o[0]=__builtin_amdgcn_mfma_f32_32x32x16_bf16(PAF(1),VFR(1),o[0],0,0,0), C0,8,GL,P0); \
    KRD(GL,1); GAPB(o[1]=__builtin_amdgcn_mfma_f32_32x32x16_bf16(PAF(1),VFR(5),o[1],0,0,0), C0,12,GL,P0); \
    KRD(GL,2); GAPB(o[0]=__builtin_amdgcn_mfma_f32_32x32x16_bf16(PAF(2),VFR(2),o[0],0,0,0), C1,0,GL,P1); \
    KRD(GL,3); GAPB(o[1]=__builtin_amdgcn_mfma_f32_32x32x16_bf16(PAF(2),VFR(6),o[1],0,0,0), C1,4,GL,P1); \
    GAPB(o[0]=__builtin_amdgcn_mfma_f32_32x32x16_bf16(PAF(3),VFR(3),o[0],0,0,0), C1,8,GL,P1); \
    GAPB(o[1]=__builtin_amdgcn_mfma_f32_32x32x16_bf16(PAF(3),VFR(7),o[1],0,0,0), C1,12,GL,P1); \
    }while(0)
  int t=1;
  #undef CMASK
  #define CMASK(P0,P1,t) do{}while(0)
  for(;t+5<NT;t+=2){
    STEP(pB0,pB1,pA0,pA1,t,true,true,true);     WAIT_BAR(2); RESC(); ROT();
    STEP(pA0,pA1,pB0,pB1,t+1,true,true,true);   WAIT_BAR(2); RESC(); ROT();
  }
  #undef CMASK
  #define CMASK(P0,P1,t) do{int jb_=(t)-(NT-4); if(jb_>=0)cmask(P0,P1,jb_,qrel,hi);}while(0)
  #define ENDW(tt) do{ if((tt)+3<NT){WAIT_BAR(2);} else if((tt)+2<NT){WAIT_BAR(1);} else {WAIT_BAR(0);} }while(0)
  for(;t+1<NT;t+=2){
    STEP(pB0,pB1,pA0,pA1,t,(t+3<NT),(t+1<NT),(t+1<NT));       ENDW(t);   RESC(); ROT();
    STEP(pA0,pA1,pB0,pB1,t+1,(t+4<NT),(t+2<NT),(t+2<NT));     ENDW(t+1); RESC(); ROT();
  }
  STEP(pB0,pB1,pA0,pA1,NT-1,false,false,false); RESC();
  u32x4 kcv[4],vcv[4]; { const bf16*Kw=K+(rowbase+q0+wid*QBLK)*DM+h*D; const bf16*Vw=V+(rowbase+q0+wid*QBLK)*DM+h*D;
    _Pragma("unroll") for(int i=0;i<4;++i){ const int row=i*8+(lane>>3),ch=lane&7; kcv[i]=*(const u32x4*)(Kw+(long)row*DM+ch*8); vcv[i]=*(const u32x4*)(Vw+(long)row*DM+ch*8); } }
  u32x4 zpre[4]; { const bf16*Zw=Zs+(rowbase+q0+wid*QBLK)*DM+h*D;
    _Pragma("unroll") for(int i=0;i<4;++i){ const int row=i*8+(lane>>3),ch=lane&7; zpre[i]=*(const u32x4*)(Zw+(long)row*DM+ch*8); } }
  { float sacc=pB0[0]+pB0[1]; _Pragma("unroll") for(int r=2;r<16;++r)sacc+=pB0[r]; _Pragma("unroll") for(int r=0;r<16;++r)sacc+=pB1[r]; l_reg+=sacc;
    pw0=(u32x4){PKW(pB0,0),PKW(pB0,2),PKW(pB0,4),PKW(pB0,6)};pw1=(u32x4){PKW(pB0,8),PKW(pB0,10),PKW(pB0,12),PKW(pB0,14)};pw2=(u32x4){PKW(pB1,0),PKW(pB1,2),PKW(pB1,4),PKW(pB1,6)};pw3=(u32x4){PKW(pB1,8),PKW(pB1,10),PKW(pB1,12),PKW(pB1,14)};
    SBAR(); pv(o,vb0+sl_cur,PAF(0),PAF(1),PAF(2),PAF(3)); }
  #undef PKW
  #undef PAF
  #undef VFR
  #undef PIN
  #undef MX3
  #undef GAPA
  #undef GAPB
  #undef BLOAD
  #undef EX
  #undef VRD
  #undef KRD
  #undef STEP
  #undef ENDW
  {auto rr=__builtin_amdgcn_permlane32_swap(__float_as_uint(l_reg),__float_as_uint(l_reg),false,false);l_reg=__uint_as_float(rr[0])+__uint_as_float(rr[1]);}
  if(hi==0)wsf[32+r32]=l_reg;asm volatile("s_waitcnt lgkmcnt(0)":::"memory");
  float rli[16];
  #pragma unroll
  for(int r=0;r<16;++r)rli[r]=__builtin_amdgcn_rcpf(wsf[32+crow(r,hi)]);
  bf16*Ow=O+(rowbase+q0+wid*QBLK)*DM+h*D;
  { bf16*stg=(bf16*)(shm+LDS_OST)+wid*2048;
    #pragma unroll
    for(int r=0;r<16;++r){const int orow=crow(r,hi);
      #pragma unroll
      for(int d0=0;d0<2;++d0)stg[orow*64+d0*32+r32]=__float2bfloat16(o[d0][r]*rli[r]);}
    asm volatile("s_waitcnt lgkmcnt(0)":::"memory");
    int lane_e=lane; asm volatile("":"+v"(lane_e));
    #pragma unroll
    for(int i=0;i<4;++i){const int lane=lane_e; const bf16*Zw=Zs+(rowbase+q0+wid*QBLK)*DM+h*D; const int row=i*8+(lane>>3),ch=lane&7; const u32x4 v=*(const u32x4*)(stg+row*64+ch*8); const u32x4 z=zpre[i]; u32x4 w;
      _Pragma("unroll") for(int e=0;e<4;++e){ const float a0=__uint_as_float(v[e]<<16)*__uint_as_float(z[e]<<16), a1=__uint_as_float(v[e]&0xffff0000u)*__uint_as_float(z[e]&0xffff0000u); w[e]=cvtpk_s(a0,a1); }
      ATTN_STORE16(Ow+(long)row*DM+ch*8,w);
      { float*kd=Kf+(rowbase+q0+wid*QBLK+row)*DM+h*D+ch*8; float*vd=Vf+(rowbase+q0+wid*QBLK+row)*DM+h*D+ch*8; const u32x4 kw=kcv[i],vw=vcv[i];
        __builtin_nontemporal_store((f32x4){__uint_as_float(kw[0]<<16),__uint_as_float(kw[0]&0xffff0000u),__uint_as_float(kw[1]<<16),__uint_as_float(kw[1]&0xffff0000u)},(f32x4*)kd);
        __builtin_nontemporal_store((f32x4){__uint_as_float(kw[2]<<16),__uint_as_float(kw[2]&0xffff0000u),__uint_as_float(kw[3]<<16),__uint_as_float(kw[3]&0xffff0000u)},(f32x4*)(kd+4));
        __builtin_nontemporal_store((f32x4){__uint_as_float(vw[0]<<16),__uint_as_float(vw[0]&0xffff0000u),__uint_as_float(vw[1]<<16),__uint_as_float(vw[1]&0xffff0000u)},(f32x4*)vd);
        __builtin_nontemporal_store((f32x4){__uint_as_float(vw[2]<<16),__uint_as_float(vw[2]&0xffff0000u),__uint_as_float(vw[3]<<16),__uint_as_float(vw[3]&0xffff0000u)},(f32x4*)(vd+4)); } } }
  asm volatile("s_waitcnt lgkmcnt(0)\n\ts_barrier":::"memory");
  #undef DMA_K
  #undef DMA_V
  #undef CMASK
  #undef START
  #undef RESC
  #undef BINIT
  #undef BINITH
  #undef ROT
}
constexpr int ATTN_LDS_BYTES=LDS_BYTES;
__device__ __forceinline__ void sample_unit(int b,int h,int qblk,const bf16*Q,const bf16*Kb,const bf16*Vb,const bf16*Zs,bf16*O,
    const float*__restrict__ ck,const float*__restrict__ cv,const float*__restrict__ clf,const float*__restrict__ lfs,char*shm){
  int tid=threadIdx.x; asm volatile("":"+v"(tid)); const int lane=tid&63,r32=lane&31,hi=lane>>5; const int wid=__builtin_amdgcn_readfirstlane(tid>>6);
  constexpr int S_V=0,S_O=65536,S_ML=131072,S_BIAS=133120,S_WT=137728; constexpr long SROW0=32768;
  float*biasS=(float*)(shm+S_BIAS);
  { f32x4 v=(f32x4){0.f,0.f,0.f,0.f};
    if(tid<272){
      #pragma unroll
      for(int i=0;i<4;++i){const int p=4*tid+i; v[i]= p<1024 ? clf[((size_t)b*1024+p)*16+h] : lfs[((size_t)b*64+(p-1024))*16+h];} }
    block_scan4(v,biasS,(LAS float*)(shm+S_WT),tid,272); }
  const bf16*Qw=Q+(SROW0+b*64+qblk*32)*DM+h*D;
  bf16x8 qr[4];
  #pragma unroll
  for(int d0=0;d0<4;++d0)qr[d0]=*reinterpret_cast<const bf16x8*>(&Qw[(long)r32*DM+d0*16+hi*8]);
  f32x16 P[3][2];
  #define SU_BIAS(acc,t,hf) do{ const float*bp=biasS+64*(t)+32*(hf)+4*hi; \
      _Pragma("unroll") for(int j=0;j<4;++j){ const f32x4 a=*(const f32x4*)(bp+8*j); _Pragma("unroll") for(int e=0;e<4;++e)acc[4*j+e]=a[e]; } }while(0)
  #pragma unroll
  for(int i=0;i<2;++i){ const int t=wid+8*i;
    #pragma unroll
    for(int hf=0;hf<2;++hf){
      bf16x8 kf[4];
      const float*kp=ck+(((size_t)b*1024+64*t+32*hf+r32)*16+h)*64+hi*8;
      #pragma unroll
      for(int d0=0;d0<4;++d0){ const f32x4 a=*(const f32x4*)(kp+d0*16),c=*(const f32x4*)(kp+d0*16+4);
        u32x4 w; w[0]=cvtpk_s(a[0],a[1]); w[1]=cvtpk_s(a[2],a[3]); w[2]=cvtpk_s(c[0],c[1]); w[3]=cvtpk_s(c[2],c[3]); kf[d0]=__builtin_bit_cast(bf16x8,w);}
      f32x16 acc; SU_BIAS(acc,t,hf);
      #pragma unroll
      for(int d0=0;d0<4;++d0)acc=__builtin_amdgcn_mfma_f32_32x32x16_bf16(kf[d0],qr[d0],acc,0,0,0);
      P[i][hf]=acc; } }
  if(wid==0){
    #pragma unroll
    for(int hf=0;hf<2;++hf){
      bf16x8 kf[4]; const bf16*kp=Kb+(SROW0+b*64+32*hf+r32)*DM+h*D+hi*8;
      #pragma unroll
      for(int d0=0;d0<4;++d0)kf[d0]=*reinterpret_cast<const bf16x8*>(kp+d0*16);
      f32x16 acc; SU_BIAS(acc,16,hf);
      #pragma unroll
      for(int d0=0;d0<4;++d0)acc=__builtin_amdgcn_mfma_f32_32x32x16_bf16(kf[d0],qr[d0],acc,0,0,0);
      #pragma unroll
      for(int r=0;r<16;++r){ if(crow(r,hi)+32*hf>32*qblk+r32)acc[r]=-INFINITY; }
      P[2][hf]=acc; }
  } else {
    #pragma unroll
    for(int hf=0;hf<2;++hf){
      #pragma unroll
      for(int r=0;r<16;++r)P[2][hf][r]=-INFINITY; }
  }
  #undef SU_BIAS
  float m=-INFINITY;
  #pragma unroll
  for(int i=0;i<3;++i){
    #pragma unroll
    for(int hf=0;hf<2;++hf){
      #pragma unroll
      for(int r=0;r<16;++r)m=fmaxf(m,P[i][hf][r]); } }
  m=fmaxf(m,__shfl_xor(m,32));
  float l=0.f;
  #pragma unroll
  for(int i=0;i<3;++i){
    #pragma unroll
    for(int hf=0;hf<2;++hf){
      #pragma unroll
      for(int r=0;r<16;++r){ const float p=__builtin_amdgcn_exp2f(P[i][hf][r]-m); P[i][hf][r]=p; l+=p; } } }
  l+=__shfl_xor(l,32);
  f32x16 o[2]; o[0]=f32x16{}; o[1]=f32x16{};
  const unsigned lds0=(unsigned)(uintptr_t)shm;
  char*vslot=shm+S_V+wid*8192;
  const int vb=(int)(lds0+S_V+wid*8192)+((lane>>4)&1)*32+(lane&3)*8+(4*hi+((lane&15)>>2))*64;
  #pragma unroll
  for(int i=0;i<3;++i){ const int t=wid+8*i;
    if(i<2||wid==0){
      #pragma unroll
      for(int j=0;j<8;++j){ const int k=8*j+(lane>>3),c8=lane&7; u32x4 w;
        if(i<2){ const float*vp=cv+(((size_t)b*1024+64*t+k)*16+h)*64+c8*8; const f32x4 a=*(const f32x4*)vp,c=*(const f32x4*)(vp+4);
          w[0]=cvtpk_s(a[0],a[1]); w[1]=cvtpk_s(a[2],a[3]); w[2]=cvtpk_s(c[0],c[1]); w[3]=cvtpk_s(c[2],c[3]); }
        else{ w=*reinterpret_cast<const u32x4*>(Vb+(SROW0+b*64+k)*DM+h*D+c8*8); }
        *reinterpret_cast<u32x4*>(vslot+(((c8>>2)*4+(k>>4))*1024+(k&15)*64+(c8&3)*16))=w; }
      asm volatile("s_waitcnt lgkmcnt(0)":::"memory");
      u32x4 pw0,pw1,pw2,pw3;
      #define PKW(X,B) cvtpk_s(X[B],X[B+1])
      pw0=(u32x4){PKW(P[i][0],0),PKW(P[i][0],2),PKW(P[i][0],4),PKW(P[i][0],6)}; pw1=(u32x4){PKW(P[i][0],8),PKW(P[i][0],10),PKW(P[i][0],12),PKW(P[i][0],14)};
      pw2=(u32x4){PKW(P[i][1],0),PKW(P[i][1],2),PKW(P[i][1],4),PKW(P[i][1],6)}; pw3=(u32x4){PKW(P[i][1],8),PKW(P[i][1],10),PKW(P[i][1],12),PKW(P[i][1],14)};
      #undef PKW
      SBAR(); pv(o,vb,__builtin_bit_cast(bf16x8,pw0),__builtin_bit_cast(bf16x8,pw1),__builtin_bit_cast(bf16x8,pw2),__builtin_bit_cast(bf16x8,pw3)); SBAR();
    }
  }
  { float*Op=(float*)(shm+S_O)+wid*2048;
    #pragma unroll
    for(int d0=0;d0<2;++d0){
      #pragma unroll
      for(int r=0;r<16;++r)Op[crow(r,hi)*64+d0*32+r32]=o[d0][r]; }
    float*ml=(float*)(shm+S_ML)+wid*64; if(hi==0){ml[r32]=m;ml[32+r32]=l;} }
  asm volatile("s_waitcnt lgkmcnt(0)\n\ts_barrier":::"memory");
  { const int q=tid>>4,d4=(tid&15)*4; const float*mlb=(const float*)(shm+S_ML); const float*Ob=(const float*)(shm+S_O);
    float M=-INFINITY;
    #pragma unroll
    for(int w=0;w<8;++w)M=fmaxf(M,mlb[w*64+q]);
    f32x4 num=(f32x4){0.f,0.f,0.f,0.f}; float den=0.f;
    #pragma unroll
    for(int w=0;w<8;++w){ const float f=__builtin_amdgcn_exp2f(mlb[w*64+q]-M); den+=f*mlb[w*64+32+q]; num+=*(const f32x4*)(Ob+w*2048+q*64+d4)*f; }
    const float inv=1.0f/den; const long row=SROW0+b*64+qblk*32+q;
    typedef unsigned u32x2_t __attribute__((ext_vector_type(2)));
    const u32x2_t z=*reinterpret_cast<const u32x2_t*>(Zs+row*DM+h*D+d4); u32x2_t w;
    w[0]=cvtpk_s(num[0]*inv*__uint_as_float(z[0]<<16),num[1]*inv*__uint_as_float(z[0]&0xffff0000u));
    w[1]=cvtpk_s(num[2]*inv*__uint_as_float(z[1]<<16),num[3]*inv*__uint_as_float(z[1]&0xffff0000u));
    *reinterpret_cast<u32x2_t*>(O+row*DM+h*D+d4)=w; }
  asm volatile("s_waitcnt lgkmcnt(0)\n\ts_barrier":::"memory");
}
#undef SBAR
#undef WAIT_BAR
}
typedef __attribute__((address_space(1))) unsigned gu32;
#define XB_TMO      128
#define XB_XCNT(j)  (256  + 64 * (j))
#define XB_XSUB(j)  (1280 + 64 * (j))
#define XB_XGEN(j)  (2304 + 64 * (j))
#define XB_TOP      3328
#define XB_TOPGEN   3392
#define XCD_BAR_WORDS 3456
#define XB_SPIN_CAP (1u << 18)

__device__ __forceinline__ unsigned xb_ld(unsigned* p)              { return __hip_atomic_load(p, __ATOMIC_RELAXED, __HIP_MEMORY_SCOPE_AGENT); }
__device__ __forceinline__ unsigned xb_add(unsigned* p, unsigned v) { return __hip_atomic_fetch_add(p, v, __ATOMIC_RELAXED, __HIP_MEMORY_SCOPE_AGENT); }
__device__ __forceinline__ unsigned xb_xcc_id() { return (unsigned)__builtin_amdgcn_s_getreg((3 << 11) | 20) & 0xFu; }
#define XB_SPIN(cond, bar) do { unsigned _sp = 0; while (cond) { __builtin_amdgcn_s_sleep(1); \
    if ((++_sp & 255u) == 0u) { if (xb_ld(&(bar)[XB_TMO])) break; if (_sp > XB_SPIN_CAP) { atomicAdd(&(bar)[XB_TMO], 1u); break; } } } } while (0)

struct XcdBarrier {
    unsigned* bar; unsigned x;
    volatile LAS unsigned* st;
};

__device__ __forceinline__ XcdBarrier xcd_barrier_post(unsigned* bar, volatile LAS unsigned* st) {
    XcdBarrier b; b.bar = bar; b.x = xb_xcc_id(); b.st = st;
    if (threadIdx.x == 0) (void)xb_add(&bar[XB_XCNT(b.x)], 1u);
    return b;
}
__device__ __forceinline__ void xcd_barrier_complete(unsigned* bar, unsigned x, unsigned& nloc, unsigned& nx) {
    const unsigned G = gridDim.x * gridDim.y * gridDim.z;
    unsigned sum, cnt, mine, sp = 0u;
    for (;;) {
        sum = 0u; cnt = 0u; mine = 0u;
#pragma unroll
        for (unsigned j = 0; j < 16; ++j) { const unsigned c = xb_ld(&bar[XB_XCNT(j)]); sum += c; cnt += (c > 0u) ? 1u : 0u; mine = (j == x) ? c : mine; }
        if (sum == G) break;
        __builtin_amdgcn_s_sleep(1);
        if ((++sp & 255u) == 0u) { if (xb_ld(&bar[XB_TMO])) break; if (sp > XB_SPIN_CAP) { atomicAdd(&bar[XB_TMO], 1u); break; } }
    }
    nloc = mine > 0u ? mine : 1u; nx = cnt > 0u ? cnt : 1u;
}

__device__ __forceinline__ void xcd_barrier(const XcdBarrier& b) {
    asm volatile("s_waitcnt vmcnt(0)" ::: "memory");
    __syncthreads();
    if (threadIdx.x == 0) {
        unsigned* bar = b.bar;
        __builtin_amdgcn_s_waitcnt(0);
        unsigned nloc = b.st[0], nx = b.st[1];
        if (nloc == 0u) { xcd_barrier_complete(bar, b.x, nloc, nx); b.st[0] = nloc; b.st[1] = nx; }
        const unsigned old = xb_add(&bar[XB_XSUB(b.x)], 1u);
        const unsigned gen = old / nloc;
        if (old + 1u == (gen + 1u) * nloc) {
            __builtin_amdgcn_fence(__ATOMIC_RELEASE, "agent");
            asm volatile("s_waitcnt vmcnt(0)" ::: "memory");
            const unsigned og = xb_add(&bar[XB_TOP], 1u);
            const unsigned tg = og / nx;
            if (og + 1u == (tg + 1u) * nx) xb_add(&bar[XB_TOPGEN], 1u);
            else XB_SPIN(xb_ld(&bar[XB_TOPGEN]) == tg, bar);
            __builtin_amdgcn_fence(__ATOMIC_ACQUIRE, "agent");
            xb_add(&bar[XB_XGEN(b.x)], 1u);
            asm volatile("s_waitcnt vmcnt(0)" ::: "memory");
        } else {
            XB_SPIN(xb_ld(&bar[XB_XGEN(b.x)]) == gen, bar);
            __builtin_amdgcn_fence(__ATOMIC_ACQUIRE, "agent");
            asm volatile("s_waitcnt vmcnt(0)" ::: "memory");
        }
    }
    __syncthreads();
}

#ifndef SKIPMASK
#define SKIPMASK 0
#endif
#ifndef MK_N_LAUNCHES
#define MK_N_LAUNCHES 1
#endif
constexpr int N_PHASES = 9;
struct Args { const float* in[18]; float* out; unsigned char* ws; int ph_lo, ph_hi; };
enum { I_XP = 0, I_XS, I_CP, I_CS, I_STATE, I_CK, I_CV, I_CLF, I_NORMG, I_ADAW, I_ADAB, I_W1, I_CONVK, I_W2, I_W3, I_BF, I_W4, I_FG };

__global__ void __launch_bounds__(NWAVES * 64, 2) hybrid_fwd(Args args) {
    extern __shared__ __attribute__((aligned(16))) unsigned char lds[];
    LAS unsigned char* L = (LAS unsigned char*)lds;
    const int tid0 = threadIdx.x, wave = __builtin_amdgcn_readfirstlane(tid0 >> 6);
#define PHASE_TID() int tid = tid0; asm volatile("" : "+v"(tid)); const int lane = tid & 63; (void)lane
    const int G = gridDim.x; const int bx = blockIdx.x; const int vcu = (G % 8 == 0) ? (bx % 8) * (G / 8) + bx / 8 : bx;
    const int gw = vcu * NWAVES + wave, NGW = G * NWAVES;
    unsigned char* ws = args.ws; float* out = args.out;
    float* mod = (float*)(ws + WS_MOD);
    bf16* W1t = (bf16*)(ws + WS_W1); bf16* W2t = (bf16*)(ws + WS_W2); bf16* W3t = (bf16*)(ws + WS_W3); bf16* W4t = (bf16*)(ws + WS_W4);
    float* slab = (float*)(ws + WS_SLAB); bf16* AOb = (bf16*)(ws + WS_AO);
    bf16* Hb = (bf16*)(ws + WS_H); bf16* Yb = (bf16*)(ws + WS_Y); bf16* Qb = (bf16*)(ws + WS_Q); bf16* Kb = (bf16*)(ws + WS_K); bf16* Vb = (bf16*)(ws + WS_V); bf16* Zb = (bf16*)(ws + WS_Z);
    const int lo = args.ph_lo, hi = args.ph_hi;
#define IN(k) (lo <= (k) && (k) < hi)
#define SEAM(k) do { if (IN(k) && IN((k) + 1)) { xcd_barrier(bar); } } while (0)
    volatile LAS unsigned* MISC = (volatile LAS unsigned*)(L + XL_OFF + 12288);
    if (tid0 < 64) MISC[tid0] = 0u;
    __syncthreads();
    XcdBarrier bar = xcd_barrier_post((unsigned*)(ws + WS_CTL), MISC + 8);
    if (args.ph_lo < 0) cg::this_grid().sync();

    if (IN(0) && !(SKIPMASK & (1 << 0))) { PHASE_TID();
        LAS float* scr = (LAS float*)(L + wave * 16640);
        const int it = wave * G + vcu;
        if (it < 1536) {
            const int l = it / 768, rem = it % 768, cb = rem >> 4, kc = rem & 15, k0 = 64 * kc;
#pragma unroll
            for (int bb = 0; bb < 24; ++bb) { const float c = bb < 16 ? args.in[I_CP][bb * 1024 + k0 + lane] : args.in[I_CS][(bb - 16) * 1024 + k0 + lane]; scr[bb * 64 + lane] = c / (1.0f + expf(-c)); }
            const float* W = args.in[I_ADAW] + (size_t)l * 1024 * 3072 + (size_t)k0 * 3072 + cb * 64 + lane;
            float a[24];
#pragma unroll
            for (int bb = 0; bb < 24; ++bb) a[bb] = 0.f;
            LDS_WAIT(); asm volatile("" ::: "memory");
#pragma unroll 4
            for (int k4 = 0; k4 < 16; ++k4) { const int k = 4 * k4;
                const float w0 = W[(size_t)k * 3072], w1 = W[(size_t)(k + 1) * 3072], w2 = W[(size_t)(k + 2) * 3072], w3 = W[(size_t)(k + 3) * 3072];
#pragma unroll
                for (int bb = 0; bb < 24; ++bb) { const f32x4 s = *(const LAS f32x4*)(scr + bb * 64 + k); a[bb] += (s.x * w0 + s.y * w1) + (s.z * w2 + s.w * w3); } }
            float* mo = mod + (size_t)l * 24 * 3072 + cb * 64 + lane;
            const float bias = kc == 0 ? args.in[I_ADAB][l * 3072 + cb * 64 + lane] : 0.f;
#pragma unroll
            for (int bb = 0; bb < 24; ++bb) __hip_atomic_fetch_add(mo + (size_t)bb * 3072, a[bb] + bias, __ATOMIC_RELAXED, __HIP_MEMORY_SCOPE_AGENT);
            LDS_WAIT(); asm volatile("" ::: "memory");
        }
        for (int t = gw; t < 16 * 128; t += NGW) p0_transpose_item<1>(args.in[I_W1], 1024, N1, W1t, scr, t, lane);
    }
    SEAM(0);
    if (IN(1) && !(SKIPMASK & (1 << 1))) { PHASE_TID();
        for (int c = gw; c < MP / 16; c += NGW) ada_norm_rows(args.in[I_XP] + (size_t)c * 16 * DM, Hb + (size_t)c * 16 * DM, 16, args.in[I_NORMG], mod + (size_t)(c >> 7) * 3072, lane);
        for (int m = gw; m < MS; m += NGW) ada_norm_row(args.in[I_XS] + (size_t)m * DM, Hb + (size_t)(MP + m) * DM, args.in[I_NORMG], mod + (size_t)(16 + (m >> 6)) * 3072, lane);
    }
    SEAM(1);
    if (IN(2) && !(SKIPMASK & (1 << 2))) { PHASE_TID();
        pg8::Gemm g{Hb, W1t, MT, N1, DM}; pg8::ConvOrder S; S.init(G, vcu);
        pg8::EpiConv E{Yb, args.in[I_CONVK], args.in[I_STATE], out + O_CONVP, out + O_CONVS};
        pg8::gemm_phase<pg8::EpiConv, pg8::ConvOrder, true, true>(L, L + XL_OFF, g, S, E);
        {
            const bool part = (G == 256);
            if (!part || vcu >= 64) {
                LAS float* scr = (LAS float*)(L + wave * 16640);
                constexpr int I2 = 32 * 16, I3 = 16 * 65, I4 = 16 * 16;
                const int w0 = part ? (vcu - 64) * NWAVES + wave : gw, nw = part ? (G - 64) * NWAVES : NGW;
                for (int t = w0; t < I2 + I3 + I4; t += nw) {
                    int r = t;
                    if (r < I2) { p0_transpose_item<0>(args.in[I_W2], 2048, 1024, W2t, scr, r, lane); continue; } r -= I2;
                    if (r < I3) { p0_transpose_item<0>(args.in[I_W3], 1024, 4112, W3t, scr, r, lane); continue; } r -= I3;
                    p0_transpose_item<0>(args.in[I_W4], 1024, 1024, W4t, scr, r, lane);
                }
            }
        }
    }
    SEAM(2);
    if (IN(3) && !(SKIPMASK & (1 << 3))) { PHASE_TID();
        pg8::Gemm g{Yb, W2t, MT, DM, EW}; pg8::PanelOrder S; S.init(EW, G, vcu);
        pg8::EpiResNorm<0> E{args.in[I_XP], out + O_Y, mod + 2048, slab, Hb, args.in[I_NORMG] + DM, mod + (size_t)24 * 3072, (float*)(ws + WS_X), (unsigned*)(ws + WS_CNT), (bf16*)(ws + WS_X1)};
        pg8::gemm_phase<pg8::EpiResNorm<0>, pg8::PanelOrder, true, true>(L, L + XL_OFF, g, S, E);
    }
    SEAM(3);
    if (IN(4) && !(SKIPMASK & (1 << 4))) { PHASE_TID();
        for (int m = MP + gw; m < MT; m += NGW) { const int bb = 16 + ((m - MP) >> 6);
            ada_norm_row(args.in[I_XS] + (size_t)(m - MP) * DM, Hb + (size_t)m * DM, args.in[I_NORMG] + DM, mod + (size_t)(24 + bb) * 3072, lane, slab + (size_t)(m - MP) * DM, mod + (size_t)bb * 3072 + 2048, out + O_Y + (size_t)m * DM); }
    }
    SEAM(4);
    if (IN(5) && !(SKIPMASK & (1 << 5))) { PHASE_TID();
        pg8::Gemm g{Hb, W3t, MT, N3, DM}; pg8::StaticOrder S; S.init(MT, N3, DM, G, bx);
        pg8::EpiQKV E{Qb, Kb, Vb, Zb, out + O_KP, out + O_KS, out + O_VP, out + O_VS, out + O_LP, out + O_LS, args.in[I_BF], attn_body::C2};
        pg8::gemm_phase<pg8::EpiQKV, pg8::StaticOrder, true, true>(L, L + XL_OFF, g, S, E);
    }
    SEAM(5);
    if (IN(6) && !(SKIPMASK & (1 << 6))) { PHASE_TID();
        char* shm = (char*)lds; float* biasL = (float*)(shm + 86016);
        typedef attn_body::bf16 abf;
        for (int bh = vcu; bh < NB_P * NH; bh += G) { const int b = bh >> 4, h = bh & 15;
            f32x4 v; int tq = tid; asm volatile("" : "+v"(tq));
#pragma unroll
            for (int i = 0; i < 4; ++i) v[i] = out[O_LP + ((size_t)b * SEQ + 4 * tq + i) * NH + h];
            block_scan4(v, biasL, (LAS float*)(L + 96 * 1024), tq, 512);
#ifndef NO_PROMPT_ATT
            for (int i = 0; i < SEQ / 256; ++i) { const int qb = (vcu + 8 - i) & 7;
                attn_body::attn_unit<64>(b, h, qb, (const abf*)Qb, (const abf*)Kb, (const abf*)Vb, (const abf*)Zb, (abf*)AOb, shm, biasL, out + O_KP, out + O_VP); }
#endif
        }
#ifndef NO_SAMPLE_ATT
        for (int su = vcu; su < NB_S * NH * 2; su += G)
            attn_body::sample_unit(su >> 5, (su >> 1) & 15, su & 1, (const abf*)Qb, (const abf*)Kb, (const abf*)Vb, (const abf*)Zb, (abf*)AOb, args.in[I_CK], args.in[I_CV], args.in[I_CLF], out + O_LS, shm);
#endif
    }
    SEAM(6);
    if (IN(7) && !(SKIPMASK & (1 << 7))) { PHASE_TID();
        pg8::Gemm g{AOb, W4t, MT, DM, DM}; pg8::PanelOrder S; S.init(DM, G, vcu);
        pg8::EpiResNorm<1> E{out + O_Y, out + O_Y, mod + (size_t)24 * 3072 + 2048, slab, nullptr, args.in[I_FG], nullptr, (float*)(ws + WS_X + 512 * 1024), (unsigned*)(ws + WS_CNT + 32 * 1024), (bf16*)(ws + WS_X1)};
        pg8::gemm_phase<pg8::EpiResNorm<1>, pg8::PanelOrder, true, true>(L, L + XL_OFF, g, S, E);
    }
    SEAM(7);
    if (IN(8) && !(SKIPMASK & (1 << 8))) { PHASE_TID();
        for (int m = MP + gw; m < MT; m += NGW) final_norm_row(out + O_Y + (size_t)m * DM, args.in[I_FG], lane, slab + (size_t)(m - MP) * DM, mod + (size_t)(24 + 16 + ((m - MP) >> 6)) * 3072 + 2048);
    }
#undef IN
#undef SEAM
}

extern "C" void kernel_launch(void* const* d_in, const int* in_sizes, int n_in, void* d_out, int out_size, void* d_ws, size_t ws_size, hipStream_t stream) {
    static int grid = 0;
    if (grid == 0) {
        if (n_in != 18 || (size_t)out_size != O_END || ws_size < WS_END) { fprintf(stderr, "kernel_launch: unexpected shapes (n_in %d out %d ws %zu)\n", n_in, out_size, ws_size); grid = -1; return; }
        int dev = 0, cus = 0, per_cu = 0;
        if (hipGetDevice(&dev) != hipSuccess || hipDeviceGetAttribute(&cus, hipDeviceAttributeMultiprocessorCount, dev) != hipSuccess) { grid = -1; return; }
        if (hipFuncSetAttribute((const void*)hybrid_fwd, hipFuncAttributeMaxDynamicSharedMemorySize, LDS_BYTES) != hipSuccess) { fprintf(stderr, "kernel_launch: hipFuncSetAttribute failed\n"); grid = -1; return; }
        if (hipOccupancyMaxActiveBlocksPerMultiprocessor(&per_cu, (const void*)hybrid_fwd, NWAVES * 64, LDS_BYTES) != hipSuccess || per_cu < 1) { fprintf(stderr, "kernel_launch: occupancy query says %d\n", per_cu); (void)hipGetLastError(); per_cu = 1; }
        grid = cus * 1;
        (void)per_cu;
    }
    if (grid < 0) return;
    if (hipMemsetAsync((char*)d_ws + WS_CTL, 0, CTL_ZERO_BYTES, stream) != hipSuccess) { fprintf(stderr, "kernel_launch: memset failed\n"); return; }
    Args a{};
    for (int i = 0; i < 18; ++i) a.in[i] = (const float*)d_in[i];
    a.out = (float*)d_out; a.ws = (unsigned char*)d_ws;
    if (MK_N_LAUNCHES == 1) {
        a.ph_lo = 0; a.ph_hi = N_PHASES;
        void* kargs[] = {&a};
        hipError_t e = hipLaunchCooperativeKernel((const void*)hybrid_fwd, dim3(grid), dim3(NWAVES * 64), kargs, LDS_BYTES, stream);
        if (e != hipSuccess) fprintf(stderr, "kernel_launch: cooperative launch failed: %s (grid %d)\n", hipGetErrorString(e), grid);
    } else {
        for (int p = 0; p < N_PHASES; ++p) { a.ph_lo = p; a.ph_hi = p + 1; hipLaunchKernelGGL(hybrid_fwd, dim3(grid), dim3(NWAVES * 64), LDS_BYTES, stream, a); }
    }
}
```
